# Optimizing an MI355X kernel written in HIP

```python
import jax, jax.numpy as jnp
from jax import lax
import numpy as np

D_MODEL = 4096
BATCH = 4
SEQ = 2048
DEPTH = 1
DEC_BATCH = 128
DEC_SEQ = 4
PAST_LEN = 16384
PAGE_SIZE = 128

MIX_WIDTH = D_MODEL
D_RNN = MIX_WIDTH // 2
RG_BLOCK = 256
RG_HEADS = D_RNN // RG_BLOCK
RG_C = 8.0
D_SSM = MIX_WIDTH - D_RNN
SSD_HEADDIM = 64
SSD_HEADS = D_SSM // SSD_HEADDIM
SSD_GROUPS = 4
D_STATE = 128
SSD_CHUNK = 128
CONV_K = 4
D_XBC = D_SSM + 2 * SSD_GROUPS * D_STATE
D_FF = 3 * D_MODEL
FFN_CONV_K = 3
IN_COLS = 2 * D_RNN + D_SSM + D_XBC + SSD_HEADS
EPS = 1e-6

kernel_name = 'hybrid_rglru_ssd_convglu_step'


def rmsnorm(x, g):
    x32 = x.astype(jnp.float32)
    y = x32 * lax.rsqrt(jnp.mean(x32 * x32, axis=-1, keepdims=True) + EPS)
    return (y * g.astype(jnp.float32)).astype(x.dtype)


def causal_dwconv(u, w, b, buf):
    K = w.shape[0]
    L = u.shape[1]
    ext = jnp.concatenate([buf.astype(u.dtype), u], axis=1)
    out = b + ext[:, 0:L] * w[0]
    for k in range(1, K):
        out = out + ext[:, k:k + L] * w[k]
    return out, ext[:, L:]


def rglru(xc, h0, wa, ba, wi, bi, lam):
    b, L, Dr = xc.shape
    f32 = jnp.float32
    xh = xc.reshape(b, L, RG_HEADS, RG_BLOCK)
    gate_r = jax.nn.sigmoid(jnp.einsum('blhi,hij->blhj', xh, wa) + ba).reshape(b, L, Dr).astype(f32)
    gate_i = jax.nn.sigmoid(jnp.einsum('blhi,hij->blhj', xh, wi) + bi).reshape(b, L, Dr).astype(f32)
    log_a = -RG_C * gate_r * jax.nn.softplus(-lam.astype(f32))
    a = jnp.exp(log_a)
    bx = jnp.sqrt(-jnp.expm1(2.0 * log_a)) * (gate_i * xc.astype(f32))
    bx = bx.at[:, 0].add(a[:, 0] * h0.astype(f32))

    def combine(left, right):
        a1, b1 = left
        a2, b2 = right
        return a1 * a2, a2 * b1 + b2

    _, h = lax.associative_scan(combine, (a, bx), axis=1)
    return h, h[:, -1]


def ssd_chunked(x, dt, A, Bm, Cm, h0):
    f32 = jnp.float32
    b, L, H, P = x.shape
    G, N = Bm.shape[2], Bm.shape[3]
    R = H // G
    Q = min(SSD_CHUNK, L)
    nc = -(-L // Q)
    pad = nc * Q - L
    x = x.astype(f32)
    Bm = Bm.astype(f32)
    Cm = Cm.astype(f32)
    if pad:
        x = jnp.pad(x, ((0, 0), (0, pad), (0, 0), (0, 0)))
        dt = jnp.pad(dt, ((0, 0), (0, pad), (0, 0)))
        Bm = jnp.pad(Bm, ((0, 0), (0, pad), (0, 0), (0, 0)))
        Cm = jnp.pad(Cm, ((0, 0), (0, pad), (0, 0), (0, 0)))
    xdt = (x * dt[..., None]).reshape(b, nc, Q, G, R, P)
    Bc = Bm.reshape(b, nc, Q, G, N)
    Cc = Cm.reshape(b, nc, Q, G, N)
    cum = jnp.cumsum((dt * A).reshape(b, nc, Q, G, R), axis=2)
    seg = cum[:, :, :, None] - cum[:, :, None, :]
    causal = jnp.tril(jnp.ones((Q, Q), dtype=bool))[None, None, :, :, None, None]
    Ldec = jnp.exp(jnp.where(causal, seg, -jnp.inf))
    CB = jnp.einsum('bctgn,bcsgn->bctsg', Cc, Bc)
    y = jnp.einsum('bctsg,bctsgr,bcsgrp->bctgrp', CB, Ldec, xdt)
    decay_end = jnp.exp(cum[:, :, -1:] - cum)
    states = jnp.einsum('bcsgn,bcsgr,bcsgrp->bcgrpn', Bc, decay_end, xdt)
    chunk_decay = jnp.exp(cum[:, :, -1])

    def step(h, inp):
        st, dec = inp
        return h * dec[..., None, None] + st, h

    h_final, h_prev = lax.scan(step, h0.astype(f32).reshape(b, G, R, P, N),
                               (jnp.moveaxis(states, 1, 0), jnp.moveaxis(chunk_decay, 1, 0)))
    h_prev = jnp.moveaxis(h_prev, 0, 1)
    y = y + jnp.einsum('bctgn,bcgrpn,bctgr->bctgrp', Cc, h_prev, jnp.exp(cum))
    y = y.reshape(b, nc * Q, H, P)[:, :L]
    return y, h_final.reshape(b, H, P, N)


def layer(x, h_rg, buf_rg, h_ssm, buf_ssd, buf_ff, p):
    b, L, _ = x.shape
    f32 = jnp.float32
    h = rmsnorm(x, p['g_mix'])
    proj = h @ p['w_in']
    rg_x, rg_gate, z, xbc, dt_raw = jnp.split(
        proj, [D_RNN, 2 * D_RNN, 2 * D_RNN + D_SSM, 2 * D_RNN + D_SSM + D_XBC], axis=-1)

    rg_xc, buf_rg_new = causal_dwconv(rg_x, p['rg_conv_w'], p['rg_conv_b'], buf_rg)
    rg_h, h_rg_new = rglru(rg_xc, h_rg, p['rg_gate_a_w'], p['rg_gate_a_b'],
                           p['rg_gate_i_w'], p['rg_gate_i_b'], p['rg_lambda'])
    rg_out = rmsnorm((rg_h * jax.nn.gelu(rg_gate.astype(f32))).astype(x.dtype), p['g_rg_out'])

    xbc_c, buf_ssd_new = causal_dwconv(xbc, p['ssd_conv_w'], p['ssd_conv_b'], buf_ssd)
    xbc_c = jax.nn.silu(xbc_c)
    xs, Bm, Cm = jnp.split(xbc_c, [D_SSM, D_SSM + SSD_GROUPS * D_STATE], axis=-1)
    xs = xs.reshape(b, L, SSD_HEADS, SSD_HEADDIM)
    dt = jax.nn.softplus(dt_raw.astype(f32) + p['ssd_dt_bias'].astype(f32))
    A = -jnp.exp(p['ssd_A_log'].astype(f32))
    y, h_ssm_new = ssd_chunked(xs, dt, A, Bm.reshape(b, L, SSD_GROUPS, D_STATE),
                               Cm.reshape(b, L, SSD_GROUPS, D_STATE), h_ssm)
    y = y + p['ssd_D'].astype(f32)[:, None] * xs.astype(f32)
    u = y.reshape(b, L, D_SSM) * jax.nn.silu(z.astype(f32))
    ug = u.reshape(b, L, SSD_GROUPS, D_SSM // SSD_GROUPS)
    ug = ug * lax.rsqrt(jnp.mean(ug * ug, axis=-1, keepdims=True) + EPS)
    ssd_out = (ug.reshape(b, L, D_SSM) * p['g_ssd_norm'].astype(f32)).astype(x.dtype)

    x = x + jnp.concatenate([rg_out, ssd_out], axis=-1) @ p['w_out']

    h2 = rmsnorm(x, p['g_ffn'])
    gate, val = jnp.split(h2 @ p['w_ffn_up'], [D_FF], axis=-1)
    gate_c, buf_ff_new = causal_dwconv(gate, p['ffn_conv_w'], p['ffn_conv_b'], buf_ff)
    x = x + (jax.nn.gelu(gate_c) * val) @ p['w_ffn_down']
    dt_out = x.dtype
    return (x, h_rg_new.astype(dt_out), buf_rg_new, h_ssm_new.astype(dt_out), buf_ssd_new, buf_ff_new)


def setup_inputs(seed: int = 0) -> dict:
    key = jax.random.key(seed)
    ks = jax.random.split(key, 40)
    f32 = jnp.float32
    nrm = lambda k, s, sc: jax.random.normal(k, s, f32) * sc
    a0 = jax.random.uniform(ks[10], (DEPTH, D_RNN), f32, 0.9, 0.999)
    s0 = a0 ** (1.0 / RG_C)
    rg_lambda = jnp.log(s0 / (1.0 - s0))
    dt0 = jnp.exp(jax.random.uniform(ks[14], (DEPTH, SSD_HEADS), f32, np.log(1e-3), np.log(1e-1)))
    ssd_dt_bias = dt0 + jnp.log(-jnp.expm1(-dt0))
    return {
        'x_prompt': nrm(ks[0], (BATCH, SEQ, D_MODEL), 1.0),
        'x_sample': nrm(ks[1], (DEC_BATCH, DEC_SEQ, D_MODEL), 1.0),
        'state_rglru_h': nrm(ks[2], (DEPTH, DEC_BATCH, D_RNN), 0.5),
        'state_rglru_conv': nrm(ks[3], (DEPTH, DEC_BATCH, CONV_K - 1, D_RNN), 1.0),
        'state_ssd_h': nrm(ks[4], (DEPTH, DEC_BATCH, SSD_HEADS, SSD_HEADDIM, D_STATE), 0.1),
        'state_ssd_conv': nrm(ks[5], (DEPTH, DEC_BATCH, CONV_K - 1, D_XBC), 1.0),
        'state_ffn_conv': nrm(ks[6], (DEPTH, DEC_BATCH, FFN_CONV_K - 1, D_FF), 1.0),
        'g_mix': 1.0 + nrm(ks[7], (DEPTH, D_MODEL), 0.02),
        'w_in': nrm(ks[8], (DEPTH, D_MODEL, IN_COLS), D_MODEL ** -0.5),
        'rg_conv_w': nrm(ks[9], (DEPTH, CONV_K, D_RNN), CONV_K ** -0.5),
        'rg_conv_b': nrm(ks[11], (DEPTH, D_RNN), 0.02),
        'rg_gate_a_w': nrm(ks[12], (DEPTH, RG_HEADS, RG_BLOCK, RG_BLOCK), RG_BLOCK ** -0.5),
        'rg_gate_a_b': nrm(ks[13], (DEPTH, RG_HEADS, RG_BLOCK), 0.02),
        'rg_gate_i_w': nrm(ks[15], (DEPTH, RG_HEADS, RG_BLOCK, RG_BLOCK), RG_BLOCK ** -0.5),
        'rg_gate_i_b': nrm(ks[16], (DEPTH, RG_HEADS, RG_BLOCK), 0.02),
        'rg_lambda': rg_lambda,
        'g_rg_out': 1.0 + nrm(ks[17], (DEPTH, D_RNN), 0.02),
        'ssd_conv_w': nrm(ks[18], (DEPTH, CONV_K, D_XBC), CONV_K ** -0.5),
        'ssd_conv_b': nrm(ks[19], (DEPTH, D_XBC), 0.02),
        'ssd_dt_bias': ssd_dt_bias,
        'ssd_A_log': jnp.log(jax.random.uniform(ks[20], (DEPTH, SSD_HEADS), f32, 1.0, 16.0)),
        'ssd_D': 1.0 + nrm(ks[21], (DEPTH, SSD_HEADS), 0.02),
        'g_ssd_norm': 1.0 + nrm(ks[22], (DEPTH, D_SSM), 0.02),
        'w_out': nrm(ks[23], (DEPTH, MIX_WIDTH, D_MODEL), MIX_WIDTH ** -0.5),
        'g_ffn': 1.0 + nrm(ks[24], (DEPTH, D_MODEL), 0.02),
        'w_ffn_up': nrm(ks[25], (DEPTH, D_MODEL, 2 * D_FF), D_MODEL ** -0.5),
        'ffn_conv_w': nrm(ks[26], (DEPTH, FFN_CONV_K, D_FF), FFN_CONV_K ** -0.5),
        'ffn_conv_b': nrm(ks[27], (DEPTH, D_FF), 0.02),
        'w_ffn_down': nrm(ks[28], (DEPTH, D_FF, D_MODEL), D_FF ** -0.5),
        'g_final': 1.0 + nrm(ks[29], (D_MODEL,), 0.02),
    }


def reference(x_prompt, x_sample, state_rglru_h, state_rglru_conv, state_ssd_h, state_ssd_conv,
              state_ffn_conv, g_mix, w_in, rg_conv_w, rg_conv_b, rg_gate_a_w, rg_gate_a_b,
              rg_gate_i_w, rg_gate_i_b, rg_lambda, g_rg_out, ssd_conv_w, ssd_conv_b, ssd_dt_bias,
              ssd_A_log, ssd_D, g_ssd_norm, w_out, g_ffn, w_ffn_up, ffn_conv_w, ffn_conv_b,
              w_ffn_down, g_final):
    yp = x_prompt
    ys = x_sample
    bp = x_prompt.shape[0]
    dtp = x_prompt.dtype
    p_new = [[], [], [], [], []]
    s_new = [[], [], [], [], []]
    for l in range(DEPTH):
        p = {
            'g_mix': g_mix[l], 'w_in': w_in[l], 'rg_conv_w': rg_conv_w[l], 'rg_conv_b': rg_conv_b[l],
            'rg_gate_a_w': rg_gate_a_w[l], 'rg_gate_a_b': rg_gate_a_b[l],
            'rg_gate_i_w': rg_gate_i_w[l], 'rg_gate_i_b': rg_gate_i_b[l],
            'rg_lambda': rg_lambda[l], 'g_rg_out': g_rg_out[l],
            'ssd_conv_w': ssd_conv_w[l], 'ssd_conv_b': ssd_conv_b[l], 'ssd_dt_bias': ssd_dt_bias[l],
            'ssd_A_log': ssd_A_log[l], 'ssd_D': ssd_D[l], 'g_ssd_norm': g_ssd_norm[l],
            'w_out': w_out[l], 'g_ffn': g_ffn[l], 'w_ffn_up': w_ffn_up[l],
            'ffn_conv_w': ffn_conv_w[l], 'ffn_conv_b': ffn_conv_b[l], 'w_ffn_down': w_ffn_down[l],
        }
        outp = layer(yp,
                     jnp.zeros((bp, D_RNN), dtp),
                     jnp.zeros((bp, CONV_K - 1, D_RNN), dtp),
                     jnp.zeros((bp, SSD_HEADS, SSD_HEADDIM, D_STATE), dtp),
                     jnp.zeros((bp, CONV_K - 1, D_XBC), dtp),
                     jnp.zeros((bp, FFN_CONV_K - 1, D_FF), dtp), p)
        outs = layer(ys, state_rglru_h[l], state_rglru_conv[l], state_ssd_h[l],
                     state_ssd_conv[l], state_ffn_conv[l], p)
        yp = outp[0]
        ys = outs[0]
        for j in range(5):
            p_new[j].append(outp[j + 1])
            s_new[j].append(outs[j + 1])
    y_prompt = rmsnorm(yp, g_final)
    y_sample = rmsnorm(ys, g_final)
    return (y_prompt, y_sample,
            jnp.stack(p_new[0]), jnp.stack(p_new[1]), jnp.stack(p_new[2]), jnp.stack(p_new[3]), jnp.stack(p_new[4]),
            jnp.stack(s_new[0]), jnp.stack(s_new[1]), jnp.stack(s_new[2]), jnp.stack(s_new[3]), jnp.stack(s_new[4]))
```

```cpp
#include <hip/hip_runtime.h>
#include <cstdio>
#include <cstdint>
#include <cstddef>

#ifndef PROBE_LO
#define PROBE_LO 0
#define PROBE_HI 0
#endif

#define LAS __attribute__((address_space(3)))
#define GAS __attribute__((address_space(1)))
typedef unsigned short bf16_t;
typedef short bf16x8 __attribute__((ext_vector_type(8)));
typedef float f32x4 __attribute__((ext_vector_type(4)));
typedef float f32x2 __attribute__((ext_vector_type(2)));
typedef unsigned u32x4 __attribute__((ext_vector_type(4)));
typedef unsigned u32x2 __attribute__((ext_vector_type(2)));
typedef int i32x4 __attribute__((ext_vector_type(4)));

constexpr int DM = 4096, SEQ = 2048, NB = 4, MP = NB * SEQ, NSQ = 128, DSEQ = 4, MS = NSQ * DSEQ, M = MP + MS;
constexpr int DRNN = 2048, DSSM = 2048, NH = 32, HP = 64, NG = 4, NST = 128, DXBC = 3072, DFF = 12288, INC = 9248;
constexpr int N1P = 9472;
constexpr int C_RGX = 0, C_RGG = 2048, C_Z = 4096, C_XBC = 6144, C_DT = 9216;
constexpr float EPS = 1e-6f;
constexpr int NCH = MP / 128;

constexpr size_t O_Y = 0;
constexpr size_t O_PRGH = (size_t)M * DM;
constexpr size_t O_PRGC = O_PRGH + (size_t)NB * DRNN;
constexpr size_t O_PSH = O_PRGC + (size_t)NB * 3 * DRNN;
constexpr size_t O_PSC = O_PSH + (size_t)NB * NH * HP * NST;
constexpr size_t O_PFC = O_PSC + (size_t)NB * 3 * DXBC;
constexpr size_t O_SRGH = O_PFC + (size_t)NB * 2 * DFF;
constexpr size_t O_SRGC = O_SRGH + (size_t)NSQ * DRNN;
constexpr size_t O_SSH = O_SRGC + (size_t)NSQ * 3 * DRNN;
constexpr size_t O_SSC = O_SSH + (size_t)NSQ * NH * HP * NST;
constexpr size_t O_SFC = O_SSC + (size_t)NSQ * 3 * DXBC;
constexpr size_t O_END = O_SFC + (size_t)NSQ * 2 * DFF;

constexpr size_t al256(size_t x) { return (x + 255) & ~(size_t)255; }
constexpr size_t WS_CTL = 0, CTL_BYTES = 1u << 20;
constexpr size_t WS_BT1 = WS_CTL + CTL_BYTES;
constexpr size_t WS_BT2 = WS_BT1 + al256((size_t)N1P * DM * 2);
constexpr size_t WS_BT3 = WS_BT2 + al256((size_t)DM * DM * 2);
constexpr size_t WS_BT4 = WS_BT3 + al256((size_t)2 * DFF * DM * 2);
constexpr size_t WS_BTG = WS_BT4 + al256((size_t)DM * DFF * 2);
constexpr size_t WS_SP8 = WS_BTG + al256((size_t)16 * 256 * 256 * 2);
constexpr size_t WS_RS1 = WS_SP8 + al256((size_t)DRNN * 4);
constexpr size_t WS_HALO = WS_RS1 + al256((size_t)M * 4);
constexpr size_t WS_RF3 = WS_HALO + al256((size_t)34 * 96 * 2 * 128 * 4);
constexpr size_t WS_DTR = WS_RF3 + al256((size_t)M * 4);
constexpr size_t WS_SA4 = WS_DTR + al256((size_t)M * NH * 4);
constexpr size_t WS_SW4 = WS_SA4 + al256((size_t)M * 4);
constexpr size_t WS_HALO1 = WS_SW4 + al256((size_t)DM * 4);
constexpr size_t WS_CAT = WS_HALO1 + al256((size_t)34 * 37 * 3 * 256 * 4);
constexpr size_t WS_X1 = WS_CAT + al256((size_t)M * DM * 2);
constexpr size_t WS_X2B = WS_X1 + al256((size_t)M * DM * 2);
constexpr size_t WS_X1B = WS_X1 + al256((size_t)M * DM * 4);
constexpr size_t WS_OV = WS_X1B + al256((size_t)M * DM * 2);
constexpr size_t WS_XB = WS_OV;
constexpr size_t WS_PROJ = WS_XB + al256((size_t)M * DM * 2);
constexpr size_t WS_G2 = WS_PROJ;
constexpr size_t WS_XCB = WS_PROJ + al256((size_t)M * INC * 2);
constexpr size_t WS_AB = WS_XCB + al256((size_t)M * DRNN * 2);
constexpr size_t WS_XS = WS_AB + al256((size_t)M * DRNN * 8);
constexpr size_t WS_BC = WS_XS + al256((size_t)M * DSSM * 2);
constexpr size_t WS_XST = WS_BC + al256((size_t)M * 1024 * 2);
constexpr size_t WS_BTT = WS_XST + al256((size_t)NCH * 2048 * 128 * 2);
constexpr size_t WS_DTA = WS_BTT + al256((size_t)NCH * 512 * 128 * 2);
constexpr size_t WS_CUM = WS_DTA + al256((size_t)M * NH * 4);
constexpr size_t WS_YD = WS_CUM + al256((size_t)M * NH * 4);
constexpr size_t WS_ST = WS_YD + al256((size_t)M * DSSM * 4);
constexpr size_t WS_DEC = WS_ST + al256((size_t)NCH * NH * HP * NST * 4);
constexpr size_t WS_HPB = WS_DEC + al256((size_t)NCH * NH * 4);
constexpr size_t WS_SSQRG = WS_HPB + al256((size_t)NCH * NH * HP * NST * 2);
constexpr size_t WS_ENDA = WS_SSQRG + al256((size_t)M * 64 * 4);
constexpr size_t WS_PART = WS_OV;
constexpr size_t WS_GATE = WS_OV;
constexpr size_t WS_VAL = WS_GATE + al256((size_t)M * DFF * 2);
constexpr size_t WS_ACT = WS_VAL + al256((size_t)M * DFF * 2);
constexpr size_t WS_BT3Q = WS_VAL;
constexpr size_t WS_ACTQ = WS_ACT + al256((size_t)M * DFF * 2);
constexpr size_t WS_BT4Q = WS_ACTQ + al256((size_t)M * DFF);
constexpr size_t WS_ENDB = WS_BT4Q + al256((size_t)DM * DFF);
constexpr size_t WS_END0 = WS_ENDA > WS_ENDB ? WS_ENDA : WS_ENDB;
constexpr size_t WS_CATQ = WS_X1B + al256((size_t)M * DM);
constexpr size_t WS_BT2Q = WS_END0;
constexpr size_t WS_SA2 = WS_BT2Q + al256((size_t)DM * DM);
constexpr size_t WS_SW2 = WS_SA2 + al256((size_t)M * 4);
constexpr size_t WS_END = WS_SW2 + al256((size_t)DM * 4);
static_assert(WS_END <= (size_t)1536 * 1024 * 1024, "d_ws map exceeds the guaranteed 1536 MiB");
constexpr int CW_BAR = 1024;
constexpr int CW_SSQ1 = 20480;
constexpr int CW_SSQ2 = CW_SSQ1 + M + 64;
constexpr int CW_HFLAG = CW_SSQ2 + M + 64;
constexpr int CW_HFLAG1 = CW_HFLAG + 34 * 96 + 64;
constexpr int CW_CMAX3 = CW_HFLAG1 + 34 * 37 + 64;
constexpr int CW_CMAX4 = CW_CMAX3 + 2 * DFF;
constexpr int CW_RMAX4 = CW_CMAX4 + DM;
constexpr int CW_DUMMY = CW_RMAX4 + M + 64;
constexpr int CW_TMO = 16;
static_assert((size_t)(CW_DUMMY + M) * 4 <= CTL_BYTES && CW_BAR + 5 * 3456 <= CW_SSQ1, "ctl");
static_assert(((34 * 96) / 8) % 8 == 0 && (34 * 96) % 8 == 0, "up-GEMM unit order: every XCD chunk must start on a sequence-start row panel");

constexpr int RING_BYTES = 131072, LDS_BYTES = 163840, LDSCTL_OFF = LDS_BYTES - 256;

__device__ __forceinline__ unsigned cvt_pk_bf16(float lo, float hi) { unsigned r; asm("v_cvt_pk_bf16_f32 %0, %1, %2" : "=v"(r) : "v"(lo), "v"(hi)); return r; }
__device__ __forceinline__ float bf_lo(unsigned w) { return __uint_as_float(w << 16); }
__device__ __forceinline__ float bf_hi(unsigned w) { return __uint_as_float(w & 0xffff0000u); }
__device__ __forceinline__ float bf2f(bf16_t b) { return __uint_as_float(((unsigned)b) << 16); }
__device__ __forceinline__ f32x4 ld_bf4(const bf16_t* p) { const u32x2 w = *(const u32x2*)p; return (f32x4){bf_lo(w.x), bf_hi(w.x), bf_lo(w.y), bf_hi(w.y)}; }
__device__ __forceinline__ float frcp(float x) { return __builtin_amdgcn_rcpf(x); }
__device__ __forceinline__ float sigmoidf_(float x) { return frcp(1.0f + __expf(-x)); }
__device__ __forceinline__ float siluf_(float x) { return x * sigmoidf_(x); }
__device__ __forceinline__ float gelu_tanh(float x) { const float u = 0.7978845608028654f * (x + 0.044715f * x * x * x); return x * sigmoidf_(2.0f * u); }
__device__ __forceinline__ float softplusf_(float x) { return fmaxf(x, 0.0f) + log1pf(__expf(-fabsf(x))); }
__device__ __forceinline__ float neg_expm1_small(float x, float ehalf  ) {
    const float p = x * (1.0f + x * (0.5f + x * (0.16666667f + x * (0.041666668f + x * (0.008333334f + x * (0.0013888889f + x * 0.0001984127f))))));
    return x > -0.5f ? -p : 1.0f - ehalf * ehalf;
}
__device__ __forceinline__ float wave_sum(float v) {
#pragma unroll
    for (int o = 1; o < 64; o <<= 1) v += __shfl_xor(v, o);
    return v;
}
__device__ __forceinline__ unsigned q8_pack4(float a, float b, float c, float d, float inv) {
    const unsigned ua = __float_as_uint(fmaf(a, inv, 12582912.0f)), ub = __float_as_uint(fmaf(b, inv, 12582912.0f)), uc = __float_as_uint(fmaf(c, inv, 12582912.0f)), ud = __float_as_uint(fmaf(d, inv, 12582912.0f));
    return (ua & 255u) | ((ub & 255u) << 8) | ((uc & 255u) << 16) | (ud << 24);
}
__device__ __forceinline__ u32x4 q8_pack16(const u32x4 lo, const u32x4 hi, float inv) {
    u32x4 o; o.x = q8_pack4(bf_lo(lo.x), bf_hi(lo.x), bf_lo(lo.y), bf_hi(lo.y), inv); o.y = q8_pack4(bf_lo(lo.z), bf_hi(lo.z), bf_lo(lo.w), bf_hi(lo.w), inv);
    o.z = q8_pack4(bf_lo(hi.x), bf_hi(hi.x), bf_lo(hi.y), bf_hi(hi.y), inv); o.w = q8_pack4(bf_lo(hi.z), bf_hi(hi.z), bf_lo(hi.w), bf_hi(hi.w), inv); return o;
}
__device__ __forceinline__ void quant_rows_i8(const bf16_t* src, unsigned char* dst, const unsigned* rmax, int R, int C, size_t gt, size_t NT) {
    const size_t per = (size_t)C / 8, tot = (size_t)R * per;
    for (size_t it0 = gt; it0 < tot; it0 += 8 * NT) { u32x4 w[8]; float inv[8];
#pragma unroll
        for (int k = 0; k < 8; ++k) { const size_t it = it0 + k * NT; if (it < tot) { w[k] = __builtin_nontemporal_load((const u32x4*)(src + it * 8));
                inv[k] = 127.0f / fmaxf(__uint_as_float(rmax[(int)(it / per)]) * 1.004f, 1e-30f); } }
#pragma unroll
        for (int k = 0; k < 8; ++k) { const size_t it = it0 + k * NT; if (it < tot) { u32x2 o; o.x = q8_pack4(bf_lo(w[k].x), bf_hi(w[k].x), bf_lo(w[k].y), bf_hi(w[k].y), inv[k]); o.y = q8_pack4(bf_lo(w[k].z), bf_hi(w[k].z), bf_lo(w[k].w), bf_hi(w[k].w), inv[k]);
                *(u32x2*)(dst + it * 8) = o; } } }
}
__device__ __forceinline__ void fwht32(float (&x)[32]) {
    f32x2 v[16];
#pragma unroll
    for (int i = 0; i < 16; ++i) v[i] = (f32x2){x[2 * i] + x[2 * i + 1], x[2 * i] - x[2 * i + 1]};
#pragma unroll
    for (int h = 1; h < 16; h <<= 1) {
#pragma unroll
        for (int i = 0; i < 16; ++i) if ((i & h) == 0) { const f32x2 a = v[i], b = v[i + h]; v[i] = a + b; v[i + h] = a - b; } }
#pragma unroll
    for (int i = 0; i < 16; ++i) { x[2 * i] = v[i][0]; x[2 * i + 1] = v[i][1]; }
}
template <int NC = 6, bool RGN = false>
__device__ __forceinline__ void rotq_rows_i8(const bf16_t* src, unsigned char* dst, float* scale, int R, int gw, int NGW, int lane, const float* ssq = nullptr) {
    constexpr int RL = 2048 * NC;
    for (int r = gw; r < R; r += NGW) { const bf16_t* sr = src + (size_t)r * RL; u32x4 pk[NC][4]; float mx = 0.f;
        float sq = 0.f; if constexpr (RGN) sq = ssq[(size_t)r * 64 + lane];
#pragma unroll
        for (int i = 0; i < NC; ++i)
#pragma unroll
            for (int q = 0; q < 4; ++q) pk[i][q] = __builtin_nontemporal_load((const u32x4*)(sr + 2048 * i + 8 * (lane + 64 * q)));
#pragma unroll
        for (int i = 0; i < NC; ++i) { float x[32];
#pragma unroll
            for (int q = 0; q < 4; ++q) { const u32x4 w = pk[i][q]; x[8 * q] = bf_lo(w.x); x[8 * q + 1] = bf_hi(w.x); x[8 * q + 2] = bf_lo(w.y); x[8 * q + 3] = bf_hi(w.y); x[8 * q + 4] = bf_lo(w.z); x[8 * q + 5] = bf_hi(w.z); x[8 * q + 6] = bf_lo(w.w); x[8 * q + 7] = bf_hi(w.w); }
            fwht32(x);
            if constexpr (RGN) { if (i == 0) { const float rs = rsqrtf(wave_sum(sq) * (1.0f / DRNN) + EPS);
#pragma unroll
                    for (int e = 0; e < 32; ++e) x[e] *= rs; } }
#pragma unroll
            for (int q = 0; q < 4; ++q) { pk[i][q].x = cvt_pk_bf16(x[8 * q], x[8 * q + 1]); pk[i][q].y = cvt_pk_bf16(x[8 * q + 2], x[8 * q + 3]); pk[i][q].z = cvt_pk_bf16(x[8 * q + 4], x[8 * q + 5]); pk[i][q].w = cvt_pk_bf16(x[8 * q + 6], x[8 * q + 7]); }
#pragma unroll
            for (int e = 0; e < 32; ++e) mx = fmaxf(mx, fabsf(x[e])); }
#pragma unroll
        for (int o = 1; o < 64; o <<= 1) mx = fmaxf(mx, __shfl_xor(mx, o));
        mx = fmaxf(mx * 1.004f, 1e-30f);
        if (lane == 0) scale[r] = mx * (0.17677669529663687f / 127.0f);
        const float inv = 127.0f / mx;
#pragma unroll
        for (int i = 0; i < NC; ++i) { unsigned char* d = dst + (size_t)r * RL + 2048 * i + 8 * lane;
#pragma unroll
            for (int q = 0; q < 4; ++q) { const u32x4 w = pk[i][q]; u32x2 o; o.x = q8_pack4(bf_lo(w.x), bf_hi(w.x), bf_lo(w.y), bf_hi(w.y), inv); o.y = q8_pack4(bf_lo(w.z), bf_hi(w.z), bf_lo(w.w), bf_hi(w.w), inv);
                *(u32x2*)(d + 512 * q) = o; } } }
}
#define FULL_FENCE() do { asm volatile("" ::: "memory"); __builtin_amdgcn_sched_barrier(0); } while (0)
#define LDS_BARRIER() do { asm volatile("s_waitcnt lgkmcnt(0)" ::: "memory"); __builtin_amdgcn_s_barrier(); asm volatile("" ::: "memory"); } while (0)
#define LDS_WAIT() asm volatile("s_waitcnt lgkmcnt(0)" ::: "memory")
#define VM_WAIT() asm volatile("s_waitcnt vmcnt(0)" ::: "memory")

#define XB_TMO      128
#define XB_XCNT(j)  (256  + 64 * (j))
#define XB_XSUB(j)  (1280 + 64 * (j))
#define XB_XGEN(j)  (2304 + 64 * (j))
#define XB_TOP      3328
#define XB_TOPGEN   3392
#define XCD_BAR_WORDS 3456
#define XB_SPIN_CAP (1u << 18)
__device__ __forceinline__ unsigned xb_ld(unsigned* p)              { return __hip_atomic_load(p, __ATOMIC_RELAXED, __HIP_MEMORY_SCOPE_AGENT); }
__device__ __forceinline__ unsigned xb_add(unsigned* p, unsigned v) { return __hip_atomic_fetch_add(p, v, __ATOMIC_RELAXED, __HIP_MEMORY_SCOPE_AGENT); }
__device__ __forceinline__ unsigned xb_xcc_id() { return (unsigned)__builtin_amdgcn_s_getreg((3 << 11) | 20) & 0xFu; }
#define XB_SPIN(cond, bar) do { unsigned _sp = 0; while (cond) { __builtin_amdgcn_s_sleep(1); \
    if ((++_sp & 255u) == 0u) { if (xb_ld(&(bar)[XB_TMO])) break; if (_sp > XB_SPIN_CAP) { atomicAdd(&(bar)[XB_TMO], 1u); break; } } } } while (0)
struct XcdBarrier { unsigned* bar; unsigned x; volatile LAS unsigned* st; };
__device__ __forceinline__ XcdBarrier xcd_barrier_post(unsigned* bar, volatile LAS unsigned* st) {
    XcdBarrier b; b.bar = bar; b.x = xb_xcc_id(); b.st = st;
    if (threadIdx.x == 0) (void)xb_add(&bar[XB_XCNT(b.x)], 1u);
    return b;
}
__device__ __forceinline__ void xcd_barrier_complete(unsigned* bar, unsigned x, unsigned& nloc, unsigned& nx) {
    const unsigned G = gridDim.x * gridDim.y * gridDim.z;
    unsigned sum, cnt, mine, sp = 0u;
    for (;;) {
        sum = 0u; cnt = 0u; mine = 0u;
#pragma unroll
        for (unsigned j = 0; j < 16; ++j) { const unsigned c = xb_ld(&bar[XB_XCNT(j)]); sum += c; cnt += (c > 0u) ? 1u : 0u; mine = (j == x) ? c : mine; }
        if (sum == G) break;
        __builtin_amdgcn_s_sleep(1);
        if ((++sp & 255u) == 0u) { if (xb_ld(&bar[XB_TMO])) break; if (sp > XB_SPIN_CAP) { atomicAdd(&bar[XB_TMO], 1u); break; } }
    }
    nloc = mine > 0u ? mine : 1u; nx = cnt > 0u ? cnt : 1u;
}
__device__ __forceinline__ void xcd_barrier(const XcdBarrier& b) {
    asm volatile("s_waitcnt vmcnt(0)" ::: "memory");
    __syncthreads();
    if (threadIdx.x == 0) {
        unsigned* bar = b.bar;
        __builtin_amdgcn_s_waitcnt(0);
        unsigned nloc = b.st[0], nx = b.st[1];
        if (nloc == 0u) { xcd_barrier_complete(bar, b.x, nloc, nx); b.st[0] = nloc; b.st[1] = nx; }
        const unsigned old = xb_add(&bar[XB_XSUB(b.x)], 1u);
        const unsigned gen = old / nloc;
        if (old + 1u == (gen + 1u) * nloc) {
            __builtin_amdgcn_fence(__ATOMIC_RELEASE, "agent");
            asm volatile("s_waitcnt vmcnt(0)" ::: "memory");
            const unsigned og = xb_add(&bar[XB_TOP], 1u);
            const unsigned tg = og / nx;
            if (og + 1u == (tg + 1u) * nx) xb_add(&bar[XB_TOPGEN], 1u);
            else XB_SPIN(xb_ld(&bar[XB_TOPGEN]) == tg, bar);
            __builtin_amdgcn_fence(__ATOMIC_ACQUIRE, "agent");
            xb_add(&bar[XB_XGEN(b.x)], 1u);
            asm volatile("s_waitcnt vmcnt(0)" ::: "memory");
        } else {
            XB_SPIN(xb_ld(&bar[XB_XGEN(b.x)]) == gen, bar);
            __builtin_amdgcn_fence(__ATOMIC_ACQUIRE, "agent");
            asm volatile("s_waitcnt vmcnt(0)" ::: "memory");
        }
    }
    __syncthreads();
}

namespace pg8 {
constexpr int BM = 256, BK = 64, HALF = 128, HTB = HALF * BK * 2, STAGE_BYTES = 8 * HTB, NXCD = 8, WGM = 8;
__host__ __device__ __forceinline__ int lds_byte(int r, int c) { const int st = (r >> 4) * 2 + (c >> 5), rr = r & 15, cc = c & 31, ob = rr * 64 + cc * 2; return st * 1024 + (ob ^ (((ob >> 9) & 1) << 5)); }
__host__ __device__ __forceinline__ void stage_rc(int b, int& R, int& C) { const int st = b / 1024, sb = b % 1024, swz = sb ^ (((sb >> 9) & 1) << 5); R = (st >> 1) * 16 + swz / 64; C = (st & 1) * 32 + (swz % 64) / 2; }
__host__ __device__ __forceinline__ int perm32(int rho) { const int n = rho >> 4, i = rho & 15; return 8 * (i >> 2) + 4 * n + (i & 3); }
struct Unit { int pm, pn, ks, tl; };
struct Gemm { const bf16_t* A; const bf16_t* Bt; int M, N, K, lda, ldb; };
struct GeomPlain {
    static __device__ __forceinline__ size_t a_off(const Gemm& g, const Unit& u) { return (size_t)u.pm * 256 * g.lda * 2; }
    static __device__ __forceinline__ size_t b_off(const Gemm& g, const Unit& u) { return (size_t)u.pn * 256 * g.ldb * 2; }
};
struct GeomGates {
    static __device__ __forceinline__ size_t a_off(const Gemm& g, const Unit& u) { return ((size_t)u.pm * 256 * g.lda + (size_t)(u.pn >> 1) * 256) * 2; }
    static __device__ __forceinline__ size_t b_off(const Gemm& g, const Unit& u) { return (size_t)u.pn * 256 * g.ldb * 2; }
};
struct StaticOrder {
    int nM, nN, nwg, G, c, limit;
    __host__ __device__ void init(int M, int N, int G_, int c_) { nM = M / BM; nN = N / BM; nwg = nM * nN; G = G_; c = c_; limit = nwg; }
    __host__ __device__ void tile_of(int L, Unit& u) const {
        int wgid = L; { const int q = nwg / NXCD, r = nwg % NXCD, xcd = wgid % NXCD, off = wgid / NXCD; wgid = (xcd < r ? xcd * (q + 1) : r * (q + 1) + (xcd - r) * q) + off; }
        tile_of_wgid(wgid, u);
    }
    __host__ __device__ void tile_of_wgid(int wgid, Unit& u) const {
        const int nig = WGM * nN, gid = wgid / nig, fm = gid * WGM, gsz = (nM - fm) < WGM ? (nM - fm) : WGM;
        u.pm = fm + ((wgid % nig) % gsz); u.pn = (wgid % nig) / gsz; u.ks = 0; u.tl = 0;
    }
    __host__ __device__ bool next(int i, Unit& u) const { const long L = (long)i * G + c; if (L >= limit) return false; tile_of((int)L, u); return true; }
};
struct ChunkOrder {
    StaticOrder base; int per_lo, n_hi;
    __host__ __device__ bool next(int i, Unit& u) const {
        const int G = base.G, c = base.c; int wgid;
        if (per_lo > 0) { const int x = c & 7, j = c >> 3; wgid = i * G + x * per_lo + (x < n_hi ? x : n_hi) + j; } else wgid = i * G + c;
        if (wgid >= base.nwg) return false; base.tile_of_wgid(wgid, u); return true;
    }
};
struct SplitOrder {
    StaticOrder base; int first, nrem, c;
    __host__ __device__ bool next(int i, Unit& u) const { if (i > 0 || c >= nrem * 8) return false; base.tile_of(first + c % nrem, u); u.tl = c % nrem; u.ks = c / nrem; return true; }
};
struct GeomSplit {
    static __device__ __forceinline__ size_t a_off(const Gemm& g, const Unit& u) { return ((size_t)u.pm * 256 * g.lda + (size_t)u.ks * g.K) * 2; }
    static __device__ __forceinline__ size_t b_off(const Gemm& g, const Unit& u) { return ((size_t)u.pn * 256 * g.ldb + (size_t)u.ks * g.K) * 2; }
};

template <class Epi, class Geom, class Sched, bool ALIGN_EPI, bool I8 = false>
__device__ __forceinline__ void gemm_phase(LAS unsigned char* lds, const Gemm g, const Sched& S, const Epi& E) {
    const int tid = threadIdx.x, wid = __builtin_amdgcn_readfirstlane(tid >> 6), lane = tid & 63, wr = wid >> 2, wc = wid & 3, fr = lane & 15, fq = lane >> 4;
    const int K = g.K, nt = K / BK;
    unsigned voffA[2], voffB[2];
#pragma unroll
    for (int i = 0; i < 2; ++i) { int R, C; stage_rc(tid * 16 + i * 8192, R, C); const int Rb = Epi::PERM ? ((R & ~31) + perm32(R & 31)) : R;
        voffA[i] = (unsigned)(R * g.lda + C) * 2u; voffB[i] = (unsigned)(Rb * g.ldb + C) * 2u; }
    const size_t kstep = (size_t)(BK * 2);
    const size_t hsA = (size_t)HALF * g.lda * 2, hsB = (size_t)HALF * g.ldb * 2;
    const unsigned ldsw = (unsigned)wid * 1024u;
    const int aoff = lds_byte(wr * 64 + fr, fq * 8), boff = lds_byte(wc * 32 + fr, fq * 8);
#define PG8_SA(b, h) (((b) * 2 + (h)) * HTB)
#define PG8_SB(b, h) ((4 + (b) * 2 + (h)) * HTB)
#define PG8_STAGE(bufoff, gbase, voff) do { _Pragma("unroll") for (int _i = 0; _i < 2; ++_i) \
        __builtin_amdgcn_global_load_lds((const unsigned*)((const char*)(gbase) + (voff)[_i]), (LAS unsigned*)(lds + (bufoff) + ldsw + _i * 8192), 16, 0, 0); } while (0)
#define PG8_LDA(dst, b, h) do { _Pragma("unroll") for (int m = 0; m < 4; ++m) _Pragma("unroll") for (int k = 0; k < 2; ++k) dst[m][k] = *(const LAS bf16x8*)(lds + PG8_SA(b, h) + aoff + m * 2048 + k * 1024); } while (0)
#define PG8_LDB(dst, b, h) do { _Pragma("unroll") for (int n = 0; n < 2; ++n) _Pragma("unroll") for (int k = 0; k < 2; ++k) dst[n][k] = *(const LAS bf16x8*)(lds + PG8_SB(b, h) + boff + n * 2048 + k * 1024); } while (0)
#define PG8_MMA(ai, bj, At, Bt) do { __builtin_amdgcn_s_setprio(1); _Pragma("unroll") for (int m = 0; m < 4; ++m) _Pragma("unroll") for (int n = 0; n < 2; ++n) _Pragma("unroll") for (int k = 0; k < 2; ++k) { \
        if constexpr (I8) acc[ai][bj][m][n] = __builtin_bit_cast(f32x4, __builtin_amdgcn_mfma_i32_16x16x64_i8(__builtin_bit_cast(i32x4, Bt[n][k]), __builtin_bit_cast(i32x4, At[m][k]), __builtin_bit_cast(i32x4, acc[ai][bj][m][n]), 0, 0, 0)); \
        else acc[ai][bj][m][n] = __builtin_amdgcn_mfma_f32_16x16x32_bf16(Bt[n][k], At[m][k], acc[ai][bj][m][n], 0, 0, 0); } __builtin_amdgcn_s_setprio(0); } while (0)
#define PG8_WAIT_V(n) asm volatile("s_waitcnt vmcnt(" #n ")" ::: "memory")
#define PG8_WAIT_L(n) asm volatile("s_waitcnt lgkmcnt(" #n ")" ::: "memory")
#define PG8_BAR __builtin_amdgcn_s_barrier()
#define PG8_SCHED __builtin_amdgcn_sched_barrier(0)
    Unit cur, nxt; int ui = 0;
    if (!S.next(0, cur)) return;
    f32x4 acc[2][2][4][2];
#pragma unroll
    for (int a = 0; a < 2; ++a)
#pragma unroll
        for (int b = 0; b < 2; ++b)
#pragma unroll
            for (int m = 0; m < 4; ++m)
#pragma unroll
                for (int n = 0; n < 2; ++n) acc[a][b][m][n] = (f32x4){0.f, 0.f, 0.f, 0.f};
    bf16x8 At[4][2], B0[2][2], B1[2][2];
    const char* cA = (const char*)g.A + Geom::a_off(g, cur); const char* cB = (const char*)g.Bt + Geom::b_off(g, cur);
    PG8_STAGE(PG8_SB(0, 0), cB, voffB); PG8_STAGE(PG8_SB(0, 1), cB + hsB, voffB); PG8_STAGE(PG8_SA(0, 0), cA, voffA); PG8_STAGE(PG8_SA(0, 1), cA + hsA, voffA);
    if (wr == 1) PG8_BAR;
    PG8_WAIT_V(2); PG8_BAR;
    PG8_STAGE(PG8_SB(1, 0), cB + kstep, voffB); PG8_STAGE(PG8_SA(1, 0), cA + kstep, voffA); PG8_STAGE(PG8_SB(1, 1), cB + hsB + kstep, voffB);
    PG8_WAIT_V(6); PG8_BAR;
    for (;;) {
        const bool has_next = S.next(ui + 1, nxt);
        const char* nA = has_next ? (const char*)g.A + Geom::a_off(g, nxt) : cA; const char* nB = has_next ? (const char*)g.Bt + Geom::b_off(g, nxt) : cB;
#pragma unroll 1
        for (int t = 0; t < nt; t += 2) {
            const bool last = (t == nt - 2);
            const char* a1 = cA + (size_t)(t + 1) * kstep;
            const char* a2 = last ? nA : cA + (size_t)(t + 2) * kstep; const char* b2 = last ? nB : cB + (size_t)(t + 2) * kstep;
            const char* a3 = a2 + kstep; const char* b3 = b2 + kstep;
            PG8_LDB(B0, 0, 0); PG8_LDB(B1, 0, 1); PG8_SCHED; PG8_LDA(At, 0, 0); PG8_STAGE(PG8_SA(1, 1), a1 + hsA, voffA);
            PG8_WAIT_V(8); PG8_WAIT_L(0); PG8_BAR; PG8_MMA(0, 0, At, B0); PG8_MMA(0, 1, At, B1); PG8_BAR; PG8_SCHED;
            PG8_LDA(At, 0, 1); PG8_STAGE(PG8_SB(0, 0), b2, voffB); PG8_STAGE(PG8_SB(0, 1), b2 + hsB, voffB); PG8_STAGE(PG8_SA(0, 0), a2, voffA);
            PG8_WAIT_V(8); PG8_WAIT_L(0); PG8_BAR; PG8_MMA(1, 0, At, B0); PG8_MMA(1, 1, At, B1); PG8_BAR; PG8_SCHED;
            PG8_LDB(B0, 1, 0); PG8_LDB(B1, 1, 1); PG8_SCHED; PG8_LDA(At, 1, 0); PG8_STAGE(PG8_SA(0, 1), a2 + hsA, voffA);
            PG8_WAIT_V(8); PG8_WAIT_L(0); PG8_BAR; PG8_MMA(0, 0, At, B0); PG8_MMA(0, 1, At, B1); PG8_BAR; PG8_SCHED;
            PG8_LDA(At, 1, 1); PG8_STAGE(PG8_SB(1, 0), b3, voffB); PG8_STAGE(PG8_SB(1, 1), b3 + hsB, voffB); PG8_STAGE(PG8_SA(1, 0), a3, voffA);
            PG8_WAIT_V(8); PG8_WAIT_L(0); PG8_BAR; PG8_MMA(1, 0, At, B0); PG8_MMA(1, 1, At, B1); PG8_BAR; PG8_SCHED;
        }
        if constexpr (ALIGN_EPI) { if (wr == 0) PG8_BAR; }
        E(acc, cur, wr, wc, fr, fq);
        if (!has_next) break;
#pragma unroll
        for (int a = 0; a < 2; ++a)
#pragma unroll
            for (int b = 0; b < 2; ++b)
#pragma unroll
                for (int m = 0; m < 4; ++m)
#pragma unroll
                    for (int n = 0; n < 2; ++n) acc[a][b][m][n] = (f32x4){0.f, 0.f, 0.f, 0.f};
        cur = nxt; cA = nA; cB = nB; ++ui;
        if constexpr (ALIGN_EPI) { if (wr == 1) PG8_BAR; }
    }
    PG8_WAIT_V(0);
    if constexpr (!ALIGN_EPI) { if (wr == 0) PG8_BAR; }
    PG8_BAR;
#undef PG8_SA
#undef PG8_SB
#undef PG8_STAGE
#undef PG8_LDA
#undef PG8_LDB
#undef PG8_MMA
#undef PG8_WAIT_V
#undef PG8_WAIT_L
#undef PG8_BAR
#undef PG8_SCHED
}
}

struct Args { const float* in[30]; float* out; unsigned char* ws; int ph_lo, ph_hi, li, rep; };
struct Frame {
    LAS unsigned char* lds; int tid, lane, wave, G;
    const float* in[30]; float* out; unsigned char* ws;
};
#define WSP(T, off) ((T*)(F.ws + (off)))

__device__ __forceinline__ float dpp_ror1(float v) { return __builtin_bit_cast(float, __builtin_amdgcn_update_dpp(0, __builtin_bit_cast(int, v), 0x121, 0xf, 0xf, false)); }
__device__ __forceinline__ float dpp_ror2(float v) { return __builtin_bit_cast(float, __builtin_amdgcn_update_dpp(0, __builtin_bit_cast(int, v), 0x122, 0xf, 0xf, false)); }
__device__ __forceinline__ float dpp_ror3(float v) { return __builtin_bit_cast(float, __builtin_amdgcn_update_dpp(0, __builtin_bit_cast(int, v), 0x123, 0xf, 0xf, false)); }
struct EpiProjConv {
    static constexpr bool PERM = true;
    unsigned char* wsb; float* out; const float *rgw, *rgb, *sdw, *sdb, *dtb, *st_rg, *st_sd; LAS float* H;
    __device__ __forceinline__ void operator()(f32x4 (&acc)[2][2][4][2], const pg8::Unit& u, int wr, int wc, int fr, int fq) const {
        unsigned char* ws = wsb;
        asm volatile("" : "+v"(fr), "+v"(fq), "+s"(ws));
        const float* rs = (const float*)(ws + WS_RS1); bf16_t* G2 = (bf16_t*)(ws + WS_G2); float* DTA = (float*)(ws + WS_DTA);
        unsigned long long* HALO = (unsigned long long*)(ws + WS_HALO1); unsigned* HFLAG = (unsigned*)(ws + WS_CTL) + CW_HFLAG1; unsigned* tmo = (unsigned*)(ws + WS_CTL) + CW_TMO;
        const int row0 = u.pm * 256 + wr * 64 + fr, cl0 = wc * 32 + 8 * fq, c0 = u.pn * 256 + cl0;
        { float sc[2][4];
#pragma unroll
          for (int ai = 0; ai < 2; ++ai)
#pragma unroll
              for (int m = 0; m < 4; ++m) sc[ai][m] = rs[row0 + ai * 128 + m * 16];
#pragma unroll
          for (int ai = 0; ai < 2; ++ai)
#pragma unroll
              for (int m = 0; m < 4; ++m)
#pragma unroll
                  for (int bj = 0; bj < 2; ++bj) { acc[ai][bj][m][0] *= sc[ai][m]; acc[ai][bj][m][1] *= sc[ai][m]; } }
        const int pn = u.pn;
        if (pn >= 8 && pn < 24) {
#pragma unroll
            for (int ai = 0; ai < 2; ++ai)
#pragma unroll
                for (int m = 0; m < 4; ++m) { const int row = row0 + ai * 128 + m * 16;
#pragma unroll
                    for (int bj = 0; bj < 2; ++bj) { f32x4 v0 = acc[ai][bj][m][0], v1 = acc[ai][bj][m][1];
                        if (pn < 16) { v0 = (f32x4){gelu_tanh(v0[0]), gelu_tanh(v0[1]), gelu_tanh(v0[2]), gelu_tanh(v0[3])}; v1 = (f32x4){gelu_tanh(v1[0]), gelu_tanh(v1[1]), gelu_tanh(v1[2]), gelu_tanh(v1[3])}; }
                        else { v0 = (f32x4){siluf_(v0[0]), siluf_(v0[1]), siluf_(v0[2]), siluf_(v0[3])}; v1 = (f32x4){siluf_(v1[0]), siluf_(v1[1]), siluf_(v1[2]), siluf_(v1[3])}; }
                        u32x4 w; w.x = cvt_pk_bf16(v0[0], v0[1]); w.y = cvt_pk_bf16(v0[2], v0[3]); w.z = cvt_pk_bf16(v1[0], v1[1]); w.w = cvt_pk_bf16(v1[2], v1[3]);
                        *(u32x4*)(G2 + (size_t)row * 4096 + (c0 - C_RGG) + bj * 128) = w; } }
            return; }
        if (pn >= 36) {
            if (wc == 0) { const f32x4 b0 = *(const f32x4*)(dtb + cl0), b1 = *(const f32x4*)(dtb + cl0 + 4);
#pragma unroll
                for (int ai = 0; ai < 2; ++ai)
#pragma unroll
                    for (int m = 0; m < 4; ++m) { const int row = row0 + ai * 128 + m * 16; const f32x4 v0 = acc[ai][0][m][0] + b0, v1 = acc[ai][0][m][1] + b1;
                        float* d = DTA + (size_t)row * NH + cl0;
                        *(f32x4*)d = (f32x4){softplusf_(v0[0]), softplusf_(v0[1]), softplusf_(v0[2]), softplusf_(v0[3])}; *(f32x4*)(d + 4) = (f32x4){softplusf_(v1[0]), softplusf_(v1[1]), softplusf_(v1[2]), softplusf_(v1[3])}; } }
            return; }
        const bool is_rg = pn < 8, prompt = u.pm < MP / 256;
        const int ch0 = is_rg ? c0 : c0 - C_XBC, CW = is_rg ? DRNN : DXBC;
        const float* cw = rgw + (is_rg ? (ptrdiff_t)0 : (sdw - rgw)); const float* cb = rgb + (is_rg ? (ptrdiff_t)0 : (sdb - rgb)); const float* stp = st_rg + (is_rg ? (ptrdiff_t)0 : (st_sd - st_rg));
        if ((u.pm & 7) == 7 || !prompt) {
#pragma unroll
            for (int ai = 0; ai < 2; ++ai)
#pragma unroll
                for (int m = 0; m < 4; ++m) { const int row = row0 + ai * 128 + m * 16; int j = -1; size_t base = 0;
                    if (row < MP) { const int t = row & (SEQ - 1); if (t >= SEQ - 3) { j = t - (SEQ - 3); base = (size_t)(row >> 11) * 3; } }
                    else { const int r = row - MP, t = r & 3; if (t >= 1) { j = t - 1; base = (size_t)(r >> 2) * 3; } }
                    if (j >= 0) { const size_t oo = is_rg ? (row < MP ? O_PRGC : O_SRGC) : (row < MP ? O_PSC : O_SSC); float* so = out + oo + (base + j) * CW + ch0;
#pragma unroll
                        for (int bj = 0; bj < 2; ++bj) { *(f32x4*)(so + bj * 128) = acc[ai][bj][m][0]; *(f32x4*)(so + bj * 128 + 4) = acc[ai][bj][m][1]; } } } }
        const int tile = u.pm * 37 + u.pn;
        if (prompt) {
            if (fr >= 13) {
#pragma unroll
                for (int ai = 0; ai < 2; ++ai)
#pragma unroll
                    for (int bj = 0; bj < 2; ++bj)
#pragma unroll
                        for (int n = 0; n < 2; ++n) *(LAS f32x4*)(H + ((2 * ai + wr) * 3 + (fr - 13)) * 256 + bj * 128 + cl0 + 4 * n) = acc[ai][bj][3][n];
                if (wr == 1 && (u.pm & 7) != 7) { unsigned long long* hp = HALO + ((size_t)tile * 3 + (fr - 13)) * 128 + (cl0 >> 1);
#pragma unroll
                    for (int bj = 0; bj < 2; ++bj)
#pragma unroll
                        for (int n = 0; n < 2; ++n) { const f32x4 g = acc[1][bj][3][n];
                            __hip_atomic_store(hp + bj * 64 + 2 * n, ((unsigned long long)__float_as_uint(g[1]) << 32) | __float_as_uint(g[0]), __ATOMIC_RELAXED, __HIP_MEMORY_SCOPE_AGENT);
                            __hip_atomic_store(hp + bj * 64 + 2 * n + 1, ((unsigned long long)__float_as_uint(g[3]) << 32) | __float_as_uint(g[2]), __ATOMIC_RELAXED, __HIP_MEMORY_SCOPE_AGENT); } }
            }
            if (wr == 1 && (u.pm & 7) != 7) { asm volatile("s_waitcnt vmcnt(0)" ::: "memory");
                if (fr == 0 && fq == 0) __hip_atomic_fetch_add(HFLAG + tile, 1u, __ATOMIC_RELAXED, __HIP_MEMORY_SCOPE_AGENT); }
            asm volatile("s_waitcnt lgkmcnt(0)" ::: "memory"); __builtin_amdgcn_s_barrier(); asm volatile("" ::: "memory");
        }
        const size_t dso = is_rg ? WS_XCB : (ch0 < DSSM ? WS_XS : WS_BC); const int ld = is_rg ? DRNN : (ch0 < DSSM ? DSSM : 1024);
        bf16_t* dst = (bf16_t*)(ws + dso) + (is_rg ? ch0 : (ch0 < DSSM ? ch0 : ch0 - DSSM));
#pragma unroll
        for (int ai = 0; ai < 2; ++ai)
#pragma unroll
            for (int bj = 0; bj < 2; ++bj) {
                f32x4 hal[2];
                hal[0] = hal[1] = (f32x4){0.f, 0.f, 0.f, 0.f};
                if (prompt) { const int b = 2 * ai + wr;
                    if (b >= 1) { if (fr >= 13) {
#pragma unroll
                            for (int n = 0; n < 2; ++n) hal[n] = *(const LAS f32x4*)(H + ((b - 1) * 3 + (fr - 13)) * 256 + bj * 128 + cl0 + 4 * n); } }
                    else if ((u.pm & 7) != 0) { unsigned* fl = HFLAG + (tile - 37); unsigned sp = 0;
                        while ((unsigned)__builtin_amdgcn_readfirstlane(__hip_atomic_load(fl, __ATOMIC_RELAXED, __HIP_MEMORY_SCOPE_AGENT)) < 4u) { __builtin_amdgcn_s_sleep(2);
                            if ((++sp & 1023u) == 0u) { if (__hip_atomic_load(tmo, __ATOMIC_RELAXED, __HIP_MEMORY_SCOPE_AGENT) != 0u) break; if (sp > (1u << 22)) { __hip_atomic_store(tmo, 1u, __ATOMIC_RELAXED, __HIP_MEMORY_SCOPE_AGENT); break; } } }
                        if (fr >= 13) { const unsigned long long* hp = HALO + ((size_t)(tile - 37) * 3 + (fr - 13)) * 128 + (cl0 >> 1) + bj * 64;
#pragma unroll
                            for (int n = 0; n < 2; ++n) { const unsigned long long a2 = __hip_atomic_load(hp + 2 * n, __ATOMIC_RELAXED, __HIP_MEMORY_SCOPE_AGENT), b2 = __hip_atomic_load(hp + 2 * n + 1, __ATOMIC_RELAXED, __HIP_MEMORY_SCOPE_AGENT);
                                hal[n] = (f32x4){__uint_as_float((unsigned)a2), __uint_as_float((unsigned)(a2 >> 32)), __uint_as_float((unsigned)b2), __uint_as_float((unsigned)(b2 >> 32))}; } } } }
#pragma unroll
                for (int n = 0; n < 2; ++n) { const int ch = ch0 + bj * 128 + 4 * n;
                    const f32x4 w0 = *(const f32x4*)(cw + ch), w1 = *(const f32x4*)(cw + CW + ch), w2 = *(const f32x4*)(cw + 2 * CW + ch), w3 = *(const f32x4*)(cw + 3 * CW + ch), bb = *(const f32x4*)(cb + ch);
#pragma unroll
                    for (int m = 0; m < 4; ++m) { const int row = row0 + ai * 128 + m * 16; const f32x4 g = acc[ai][bj][m][n]; f32x4 p1, p2, p3;
                        if (prompt) { const f32x4 gp = (m == 0) ? hal[n] : acc[ai][bj][m > 0 ? m - 1 : 0][n];
#pragma unroll
                            for (int j = 0; j < 4; ++j) { p1[j] = dpp_ror1(fr == 15 ? gp[j] : g[j]); p2[j] = dpp_ror2(fr >= 14 ? gp[j] : g[j]); p3[j] = dpp_ror3(fr >= 13 ? gp[j] : g[j]); } }
                        else { const int t = fr & 3; const float* sp = stp + (size_t)((row - MP) >> 2) * 3 * CW + ch;
                            const f32x4 b0 = *(const f32x4*)sp, b1 = *(const f32x4*)(sp + CW), b2 = *(const f32x4*)(sp + 2 * CW);
#pragma unroll
                            for (int j = 0; j < 4; ++j) { const float r1 = dpp_ror1(g[j]), r2 = dpp_ror2(g[j]), r3 = dpp_ror3(g[j]);
                                p1[j] = t >= 1 ? r1 : b2[j]; p2[j] = t >= 2 ? r2 : (t == 1 ? b2[j] : b1[j]); p3[j] = t >= 3 ? r3 : (t == 2 ? b2[j] : (t == 1 ? b1[j] : b0[j])); } }
                        float o[4];
#pragma unroll
                        for (int j = 0; j < 4; ++j) { const float y = bb[j] + w0[j] * p3[j] + w1[j] * p2[j] + w2[j] * p1[j] + w3[j] * g[j]; o[j] = is_rg ? y : siluf_(y); }
                        u32x2 w; w.x = cvt_pk_bf16(o[0], o[1]); w.y = cvt_pk_bf16(o[2], o[3]);
                        *(u32x2*)(dst + (size_t)row * ld + bj * 128 + 4 * n) = w; }
                    asm volatile("" ::: "memory"); } }
    }
};
struct EpiGates {
    static constexpr bool PERM = false;
    unsigned* AB; const bf16_t* XCB; const float *ba, *bi, *sp8;
    __device__ __forceinline__ void operator()(const f32x4 (&acc)[2][2][4][2], const pg8::Unit& u, int wr, int wc, int fr, int fq) const {
        const int row0 = u.pm * 256 + wr * 64 + fr, ch0 = (u.pn >> 1) * 256 + (u.pn & 1) * 128 + wc * 32 + 4 * fq;
        const unsigned base = (unsigned)row0 * DRNN + ch0;
        u32x2 xw[2][2][4]; f32x4 bav[2], biv[2], spv[2];
#pragma unroll
        for (int n = 0; n < 2; ++n) { const int ch = ch0 + n * 16; bav[n] = *(const f32x4*)(ba + ch); biv[n] = *(const f32x4*)(bi + ch); spv[n] = *(const f32x4*)(sp8 + ch);
#pragma unroll
            for (int ai = 0; ai < 2; ++ai)
#pragma unroll
                for (int m = 0; m < 4; ++m) xw[n][ai][m] = *(const u32x2*)((const char*)XCB + (size_t)((base + (unsigned)((ai * 128 + m * 16) * DRNN + n * 16)) * 2u)); }
#pragma unroll
        for (int n = 0; n < 2; ++n) {
#pragma unroll
            for (int ai = 0; ai < 2; ++ai)
#pragma unroll
                for (int m = 0; m < 4; ++m) { const unsigned off = base + (unsigned)((ai * 128 + m * 16) * DRNN + n * 16);
                    const u32x2 x2 = xw[n][ai][m];
                    const float xc[4] = {bf_lo(x2.x), bf_hi(x2.x), bf_lo(x2.y), bf_hi(x2.y)};
                    const f32x4 r4 = acc[ai][0][m][n] + bav[n], i4 = acc[ai][1][m][n] + biv[n];
                    float av[4], bv[4];
#pragma unroll
                    for (int j = 0; j < 4; ++j) { const float gr = sigmoidf_(r4[j]), gi = sigmoidf_(i4[j]); const float la = -gr * spv[n][j];
                        av[j] = __expf(la); bv[j] = __builtin_amdgcn_sqrtf(neg_expm1_small(2.0f * la, av[j])) * gi * xc[j]; }
                    u32x4 pk; pk.x = cvt_pk_bf16(1.0f - av[0], bv[0]); pk.y = cvt_pk_bf16(1.0f - av[1], bv[1]); pk.z = cvt_pk_bf16(1.0f - av[2], bv[2]); pk.w = cvt_pk_bf16(1.0f - av[3], bv[3]);
                    *(u32x4*)((char*)AB + (size_t)off * 4u) = pk; } }
    }
};
struct EpiX1 {
    static constexpr bool PERM = true;
    const float *xp, *xs; bf16_t* X1;
    __device__ __forceinline__ void operator()(const f32x4 (&acc)[2][2][4][2], const pg8::Unit& u, int wr, int wc, int fr, int fq) const {
        const int row0 = u.pm * 256 + wr * 64 + fr, col0 = u.pn * 256 + wc * 32 + 8 * fq;
#pragma unroll
        for (int am = 0; am < 4; ++am) { const int ai = am >> 1, m0 = 2 * (am & 1); f32x4 r[2][2][2];
#pragma unroll
            for (int mm = 0; mm < 2; ++mm) { const int row = row0 + ai * 128 + (m0 + mm) * 16; const float* xin = (row < MP ? xp + (size_t)row * DM : xs + (size_t)(row - MP) * DM) + col0;
#pragma unroll
                for (int bj = 0; bj < 2; ++bj)
#pragma unroll
                    for (int n = 0; n < 2; ++n) r[mm][bj][n] = *(const f32x4*)(xin + bj * 128 + 4 * n); }
#pragma unroll
            for (int mm = 0; mm < 2; ++mm) { bf16_t* o = X1 + (size_t)(row0 + ai * 128 + (m0 + mm) * 16) * DM + col0;
#pragma unroll
                for (int bj = 0; bj < 2; ++bj) { const f32x4 v0 = acc[ai][bj][m0 + mm][0] + r[mm][bj][0], v1 = acc[ai][bj][m0 + mm][1] + r[mm][bj][1];
                    u32x4 w; w.x = cvt_pk_bf16(v0[0], v0[1]); w.y = cvt_pk_bf16(v0[2], v0[3]); w.z = cvt_pk_bf16(v1[0], v1[1]); w.w = cvt_pk_bf16(v1[2], v1[3]);
                    *(u32x4*)(o + bj * 128) = w; } } }
    }
};
struct EpiUpConv {
    static constexpr bool PERM = true;
    bf16_t* ACT; const float* rf; const unsigned* cmax; float* out; const float *cw, *cb, *stf; LAS float* H; unsigned long long* HALO; unsigned* HFLAG; unsigned* tmo;
    __device__ __forceinline__ void operator()(f32x4 (&acc)[2][2][4][2], const pg8::Unit& u, int wr, int wc, int fr, int fq) const {
        const int row0 = u.pm * 256 + wr * 64 + fr, cl0 = wc * 32 + 8 * fq, ch0 = u.pn * 128 + cl0;
        float sc[2][4];
#pragma unroll
        for (int ai = 0; ai < 2; ++ai)
#pragma unroll
            for (int m = 0; m < 4; ++m) sc[ai][m] = rf[row0 + ai * 128 + m * 16];
        {
            f32x4 sw[2][2];
#pragma unroll
            for (int bj = 0; bj < 2; ++bj)
#pragma unroll
                for (int n = 0; n < 2; ++n) { const u32x4 c = *(const u32x4*)(cmax + u.pn * 256 + bj * 128 + cl0 + 4 * n); sw[bj][n] = (f32x4){__uint_as_float(c.x), __uint_as_float(c.y), __uint_as_float(c.z), __uint_as_float(c.w)} * (1.004f / 127.0f); }
#pragma unroll
            for (int ai = 0; ai < 2; ++ai)
#pragma unroll
                for (int m = 0; m < 4; ++m)
#pragma unroll
                    for (int bj = 0; bj < 2; ++bj)
#pragma unroll
                        for (int n = 0; n < 2; ++n) { const i32x4 q = __builtin_bit_cast(i32x4, acc[ai][bj][m][n]); acc[ai][bj][m][n] = (f32x4){(float)q[0], (float)q[1], (float)q[2], (float)q[3]} * sw[bj][n] * sc[ai][m]; }
        }
        if ((u.pm & 7) == 7 || u.pm >= MP / 256) {
#pragma unroll
            for (int ai = 0; ai < 2; ++ai)
#pragma unroll
                for (int m = 0; m < 4; ++m) { const int row = row0 + ai * 128 + m * 16; float* so = nullptr;
                    if (row < MP) { const int t = row & (SEQ - 1); if (t >= SEQ - 2) so = out + O_PFC + ((size_t)(row >> 11) * 2 + (t - (SEQ - 2))) * DFF + ch0; }
                    else { const int r = row - MP, t = r & 3; if (t >= 2) so = out + O_SFC + ((size_t)(r >> 2) * 2 + (t - 2)) * DFF + ch0; }
                    if (so) { *(f32x4*)so = acc[ai][0][m][0]; *(f32x4*)(so + 4) = acc[ai][0][m][1]; } } }
        const bool prompt = u.pm < MP / 256;
        if (prompt) {
            if (fr >= 14) {
#pragma unroll
                for (int ai = 0; ai < 2; ++ai)
#pragma unroll
                    for (int n = 0; n < 2; ++n) *(LAS f32x4*)(H + ((2 * ai + wr) * 2 + (fr - 14)) * 128 + cl0 + 4 * n) = acc[ai][0][3][n];
                if (wr == 1 && (u.pm & 7) != 7) { unsigned long long* hp = HALO + ((size_t)(u.pm * 96 + u.pn) * 2 + (fr - 14)) * 64 + (cl0 >> 1);
#pragma unroll
                    for (int n = 0; n < 2; ++n) { const f32x4 g = acc[1][0][3][n];
                        __hip_atomic_store(hp + 2 * n, ((unsigned long long)__float_as_uint(g[1]) << 32) | __float_as_uint(g[0]), __ATOMIC_RELAXED, __HIP_MEMORY_SCOPE_AGENT);
                        __hip_atomic_store(hp + 2 * n + 1, ((unsigned long long)__float_as_uint(g[3]) << 32) | __float_as_uint(g[2]), __ATOMIC_RELAXED, __HIP_MEMORY_SCOPE_AGENT); } }
            }
            if (wr == 1 && (u.pm & 7) != 7) { asm volatile("s_waitcnt vmcnt(0)" ::: "memory");
                if (fr == 0 && fq == 0) __hip_atomic_fetch_add(HFLAG + u.pm * 96 + u.pn, 1u, __ATOMIC_RELAXED, __HIP_MEMORY_SCOPE_AGENT); }
            asm volatile("s_waitcnt lgkmcnt(0)" ::: "memory"); __builtin_amdgcn_s_barrier(); asm volatile("" ::: "memory");
        }
#pragma unroll
        for (int ai = 0; ai < 2; ++ai) {
            f32x4 hal[2]; hal[0] = hal[1] = (f32x4){0.f, 0.f, 0.f, 0.f};
            if (prompt) { const int b = 2 * ai + wr;
                if (b >= 1) { if (fr >= 14) {
#pragma unroll
                        for (int n = 0; n < 2; ++n) hal[n] = *(const LAS f32x4*)(H + ((b - 1) * 2 + (fr - 14)) * 128 + cl0 + 4 * n); } }
                else if ((u.pm & 7) != 0) { unsigned* fl = HFLAG + (u.pm - 1) * 96 + u.pn; unsigned sp = 0;
                    while ((unsigned)__builtin_amdgcn_readfirstlane(__hip_atomic_load(fl, __ATOMIC_RELAXED, __HIP_MEMORY_SCOPE_AGENT)) < 4u) { __builtin_amdgcn_s_sleep(2);
                        if ((++sp & 1023u) == 0u) { if (__hip_atomic_load(tmo, __ATOMIC_RELAXED, __HIP_MEMORY_SCOPE_AGENT) != 0u) break; if (sp > (1u << 22)) { __hip_atomic_store(tmo, 1u, __ATOMIC_RELAXED, __HIP_MEMORY_SCOPE_AGENT); break; } } }
                    if (fr >= 14) { const unsigned long long* hp = HALO + ((size_t)((u.pm - 1) * 96 + u.pn) * 2 + (fr - 14)) * 64 + (cl0 >> 1);
#pragma unroll
                        for (int n = 0; n < 2; ++n) { const unsigned long long a = __hip_atomic_load(hp + 2 * n, __ATOMIC_RELAXED, __HIP_MEMORY_SCOPE_AGENT), b2 = __hip_atomic_load(hp + 2 * n + 1, __ATOMIC_RELAXED, __HIP_MEMORY_SCOPE_AGENT);
                            hal[n] = (f32x4){__uint_as_float((unsigned)a), __uint_as_float((unsigned)(a >> 32)), __uint_as_float((unsigned)b2), __uint_as_float((unsigned)(b2 >> 32))}; } } } }
#pragma unroll
            for (int n = 0; n < 2; ++n) {
                const f32x4 w0 = *(const f32x4*)(cw + ch0 + 4 * n), w1 = *(const f32x4*)(cw + DFF + ch0 + 4 * n), w2 = *(const f32x4*)(cw + 2 * DFF + ch0 + 4 * n), bb = *(const f32x4*)(cb + ch0 + 4 * n);
#pragma unroll
                for (int m = 0; m < 4; ++m) { const int row = row0 + ai * 128 + m * 16; const f32x4 g = acc[ai][0][m][n], vv = acc[ai][1][m][n]; f32x4 p1, p2;
                    if (prompt) { const f32x4 gp = (m == 0) ? hal[n] : acc[ai][0][m > 0 ? m - 1 : 0][n];
#pragma unroll
                        for (int j = 0; j < 4; ++j) { p1[j] = dpp_ror1(fr == 15 ? gp[j] : g[j]); p2[j] = dpp_ror2(fr >= 14 ? gp[j] : g[j]); } }
                    else { const int t = fr & 3; const float* sp = stf + (size_t)((row - MP) >> 2) * 2 * DFF + ch0 + 4 * n;
                        f32x4 b0 = (f32x4){0.f, 0.f, 0.f, 0.f}, b1 = b0; if (t == 0) b0 = *(const f32x4*)sp; if (t <= 1) b1 = *(const f32x4*)(sp + DFF);
#pragma unroll
                        for (int j = 0; j < 4; ++j) { const float r1 = dpp_ror1(g[j]), r2 = dpp_ror2(g[j]); p1[j] = t >= 1 ? r1 : b1[j]; p2[j] = t >= 2 ? r2 : (t == 1 ? b1[j] : b0[j]); } }
                    float o[4];
#pragma unroll
                    for (int j = 0; j < 4; ++j) { const float y = bb[j] + w0[j] * p2[j] + w1[j] * p1[j] + w2[j] * g[j]; o[j] = gelu_tanh(y) * vv[j]; }
                    u32x2 w; w.x = cvt_pk_bf16(o[0], o[1]); w.y = cvt_pk_bf16(o[2], o[3]);
                    *(u32x2*)(ACT + (size_t)row * DFF + ch0 + 4 * n) = w; } } }
    }
};
struct EpiX2 {
    static constexpr bool PERM = false;
    const bf16_t* X1; bf16_t* X2; const float *sa, *sw;
    __device__ __forceinline__ void operator()(const f32x4 (&acc)[2][2][4][2], const pg8::Unit& u, int wr, int wc, int fr, int fq) const {
        const int row0 = u.pm * 256 + wr * 64 + fr, col0 = u.pn * 256 + wc * 32 + 4 * fq;
        f32x4 swv[2][2];
#pragma unroll
        for (int bj = 0; bj < 2; ++bj)
#pragma unroll
            for (int n = 0; n < 2; ++n) swv[bj][n] = *(const f32x4*)(sw + col0 + bj * 128 + n * 16);
        float sav[2][4];
#pragma unroll
        for (int ai = 0; ai < 2; ++ai)
#pragma unroll
            for (int m = 0; m < 4; ++m) sav[ai][m] = sa[row0 + ai * 128 + m * 16];
#pragma unroll
        for (int am = 0; am < 4; ++am) { const int ai = am >> 1, m0 = 2 * (am & 1); f32x4 r[2][2][2];
#pragma unroll
            for (int mm = 0; mm < 2; ++mm) { const size_t off = (size_t)(row0 + ai * 128 + (m0 + mm) * 16) * DM + col0;
#pragma unroll
                for (int bj = 0; bj < 2; ++bj)
#pragma unroll
                    for (int n = 0; n < 2; ++n) r[mm][bj][n] = ld_bf4(X1 + off + bj * 128 + n * 16); }
#pragma unroll
            for (int mm = 0; mm < 2; ++mm) { const size_t off = (size_t)(row0 + ai * 128 + (m0 + mm) * 16) * DM + col0;
#pragma unroll
                for (int bj = 0; bj < 2; ++bj)
#pragma unroll
                    for (int n = 0; n < 2; ++n) { const i32x4 q = __builtin_bit_cast(i32x4, acc[ai][bj][m0 + mm][n]);
                        const f32x4 v = (f32x4){(float)q[0], (float)q[1], (float)q[2], (float)q[3]} * swv[bj][n] * sav[ai][m0 + mm] + r[mm][bj][n];
                        u32x2 w; w.x = cvt_pk_bf16(v[0], v[1]); w.y = cvt_pk_bf16(v[2], v[3]); *(u32x2*)(X2 + off + bj * 128 + n * 16) = w; } } }
    }
};
struct EpiX1Q {
    static constexpr bool PERM = false;
    const float *xp, *xs; bf16_t* X1; const float *sa, *sw;
    __device__ __forceinline__ void operator()(const f32x4 (&acc)[2][2][4][2], const pg8::Unit& u, int wr, int wc, int fr, int fq) const {
        const int row0 = u.pm * 256 + wr * 64 + fr, col0 = u.pn * 256 + wc * 32 + 4 * fq;
        f32x4 swv[2][2];
#pragma unroll
        for (int bj = 0; bj < 2; ++bj)
#pragma unroll
            for (int n = 0; n < 2; ++n) swv[bj][n] = *(const f32x4*)(sw + col0 + bj * 128 + n * 16);
        float sav[2][4];
#pragma unroll
        for (int ai = 0; ai < 2; ++ai)
#pragma unroll
            for (int m = 0; m < 4; ++m) sav[ai][m] = sa[row0 + ai * 128 + m * 16];
#pragma unroll
        for (int am = 0; am < 4; ++am) { const int ai = am >> 1, m0 = 2 * (am & 1); f32x4 r[2][2][2];
#pragma unroll
            for (int mm = 0; mm < 2; ++mm) { const int row = row0 + ai * 128 + (m0 + mm) * 16; const float* xin = (row < MP ? xp + (size_t)row * DM : xs + (size_t)(row - MP) * DM) + col0;
#pragma unroll
                for (int bj = 0; bj < 2; ++bj)
#pragma unroll
                    for (int n = 0; n < 2; ++n) r[mm][bj][n] = *(const f32x4*)(xin + bj * 128 + n * 16); }
#pragma unroll
            for (int mm = 0; mm < 2; ++mm) { const size_t off = (size_t)(row0 + ai * 128 + (m0 + mm) * 16) * DM + col0;
#pragma unroll
                for (int bj = 0; bj < 2; ++bj)
#pragma unroll
                    for (int n = 0; n < 2; ++n) { const i32x4 q = __builtin_bit_cast(i32x4, acc[ai][bj][m0 + mm][n]);
                        const f32x4 v = (f32x4){(float)q[0], (float)q[1], (float)q[2], (float)q[3]} * swv[bj][n] * sav[ai][m0 + mm] + r[mm][bj][n];
                        u32x2 w; w.x = cvt_pk_bf16(v[0], v[1]); w.y = cvt_pk_bf16(v[2], v[3]); *(u32x2*)(X1 + off + bj * 128 + n * 16) = w; } } }
    }
};
struct EpiPart {
    static constexpr bool PERM = false;
    float* P;
    __device__ __forceinline__ void operator()(const f32x4 (&acc)[2][2][4][2], const pg8::Unit& u, int wr, int wc, int fr, int fq) const {
        float* base = P + ((size_t)(u.tl * 8 + u.ks) << 16) + (size_t)(wr * 64 + fr) * 256 + wc * 32 + 4 * fq;
#pragma unroll
        for (int ai = 0; ai < 2; ++ai)
#pragma unroll
            for (int m = 0; m < 4; ++m)
#pragma unroll
                for (int bj = 0; bj < 2; ++bj)
#pragma unroll
                    for (int n = 0; n < 2; ++n) *(f32x4*)(base + (size_t)(ai * 128 + m * 16) * 256 + bj * 128 + n * 16) = acc[ai][bj][m][n];
    }
};
struct EpiPartQ {
    static constexpr bool PERM = false;
    float* P; const float *sa, *sw;
    __device__ __forceinline__ void operator()(const f32x4 (&acc)[2][2][4][2], const pg8::Unit& u, int wr, int wc, int fr, int fq) const {
        float* base = P + ((size_t)(u.tl * 8 + u.ks) << 16) + (size_t)(wr * 64 + fr) * 256 + wc * 32 + 4 * fq;
        const int row0 = u.pm * 256 + wr * 64 + fr, col0 = u.pn * 256 + wc * 32 + 4 * fq;
        f32x4 swv[2][2];
#pragma unroll
        for (int bj = 0; bj < 2; ++bj)
#pragma unroll
            for (int n = 0; n < 2; ++n) swv[bj][n] = *(const f32x4*)(sw + col0 + bj * 128 + n * 16);
#pragma unroll
        for (int ai = 0; ai < 2; ++ai)
#pragma unroll
            for (int m = 0; m < 4; ++m) { const float sav = sa[row0 + ai * 128 + m * 16];
#pragma unroll
                for (int bj = 0; bj < 2; ++bj)
#pragma unroll
                    for (int n = 0; n < 2; ++n) { const i32x4 q = __builtin_bit_cast(i32x4, acc[ai][bj][m][n]);
                        *(f32x4*)(base + (size_t)(ai * 128 + m * 16) * 256 + bj * 128 + n * 16) = (f32x4){(float)q[0], (float)q[1], (float)q[2], (float)q[3]} * swv[bj][n] * sav; } }
    }
};

__device__ __forceinline__ void p0_transpose_item(const float* W, int N, int k0, int n0, const float* gk, bf16_t* WT, int ldt, int dst_row0, LAS float* scr, int lane, unsigned* cmax = nullptr) {
    const int lq = lane >> 4, n4 = lane & 15; const bool inb = (n0 + 4 * n4) < N;
    f32x4 v[16];
#pragma unroll
    for (int i = 0; i < 16; ++i) v[i] = inb ? __builtin_nontemporal_load((const f32x4*)(W + (size_t)(k0 + 4 * i + lq) * N + n0 + 4 * n4)) : (f32x4){0.f, 0.f, 0.f, 0.f};
    if (gk) {
#pragma unroll
        for (int i = 0; i < 16; ++i) v[i] *= gk[k0 + 4 * i + lq]; }
#pragma unroll
    for (int i = 0; i < 16; ++i) { const int k = 4 * i + lq; *(LAS f32x4*)(scr + k * 64 + 4 * ((n4 ^ (2 * (k >> 3))) & 15)) = v[i]; }
    LDS_WAIT(); asm volatile("" ::: "memory");
    const int c = lane & 7, np = lane >> 3;
#pragma unroll
    for (int j = 0; j < 8; ++j) { const int n = np + 8 * j; const LAS float* sp = scr + (8 * c) * 64 + 4 * ((((n >> 2) ^ (2 * c)) & 15)) + (n & 3);
        u32x4 o; o.x = cvt_pk_bf16(sp[0 * 64], sp[1 * 64]); o.y = cvt_pk_bf16(sp[2 * 64], sp[3 * 64]); o.z = cvt_pk_bf16(sp[4 * 64], sp[5 * 64]); o.w = cvt_pk_bf16(sp[6 * 64], sp[7 * 64]);
        if (n0 + n < N) *(u32x4*)(WT + (size_t)(dst_row0 + n) * ldt + k0 + 8 * c) = o;
        if (cmax) { float mx = fmaxf(fmaxf(fmaxf(fabsf(sp[0 * 64]), fabsf(sp[1 * 64])), fmaxf(fabsf(sp[2 * 64]), fabsf(sp[3 * 64]))), fmaxf(fmaxf(fabsf(sp[4 * 64]), fabsf(sp[5 * 64])), fmaxf(fabsf(sp[6 * 64]), fabsf(sp[7 * 64]))));
            mx = fmaxf(mx, __shfl_xor(mx, 1)); mx = fmaxf(mx, __shfl_xor(mx, 2)); mx = fmaxf(mx, __shfl_xor(mx, 4));
            if (c == 0) atomicMax(cmax + dst_row0 + n, __float_as_uint(mx)); } }
    LDS_WAIT(); asm volatile("" ::: "memory");
}
__device__ __forceinline__ void p0_late_weights(Frame& F, int gw, int NGW) {
    LAS float* scr = (LAS float*)(F.lds + F.wave * 16384);
    constexpr int I_OUT = (DM / 64) * (DM / 64), I_UP = (DM / 64) * (2 * DFF / 64), I_DN = (DFF / 64) * (DM / 64);
    for (int it = gw; it < I_UP + I_DN + I_OUT; it += NGW) {
        int r = it;
        if (r < I_UP) { const int nblk = 2 * DFF / 64, kb = r / nblk, nb = r % nblk; const int n0 = 64 * nb, half = n0 / DFF, j = n0 % DFF;
            p0_transpose_item(F.in[25], 2 * DFF, 64 * kb, n0, F.in[24], WSP(bf16_t, WS_BT3), DM, (j / 128) * 256 + half * 128 + (j % 128), scr, F.lane, (unsigned*)(F.ws + WS_CTL) + CW_CMAX3); continue; } r -= I_UP;
        if (r < I_DN) { const int nblk = DM / 64, kb = r / nblk, nb = r % nblk; p0_transpose_item(F.in[28], DM, 64 * kb, 64 * nb, nullptr, WSP(bf16_t, WS_BT4), DFF, 64 * nb, scr, F.lane); continue; } r -= I_DN;
        { const int nblk = DM / 64, kb = r / nblk, nb = r % nblk; const int k0 = 64 * kb;
          const float* gk = k0 < DRNN ? F.in[16] : F.in[22] - DRNN;
          p0_transpose_item(F.in[23], DM, k0, 64 * nb, gk, WSP(bf16_t, WS_BT2), DM, 64 * nb, scr, F.lane); }
    }
}
constexpr int G1_PER = 26, G1_HI = 2, NGEMM1 = 8 * G1_PER + G1_HI, NSTREAM = 256 - NGEMM1;
__device__ __forceinline__ void p0_prologue(Frame& F) {
    LAS float* scr = (LAS float*)(F.lds + F.wave * 16384);
    const int gw = F.wave * F.G + blockIdx.x, NGW = F.G * 8;
    constexpr int NB_IN = (INC + 63) / 64;
    constexpr int I_IN = (DM / 64) * NB_IN, I_G = 16 * 4 * 4;
    for (int it = gw; it < I_IN + I_G; it += NGW) {
        int r = it;
        if (r < I_IN) { const int kb = r / NB_IN, nb = r % NB_IN; p0_transpose_item(F.in[8], INC, 64 * kb, 64 * nb, F.in[7], WSP(bf16_t, WS_BT1), DM, 64 * nb, scr, F.lane); continue; } r -= I_IN;
        { const int mat = r / 16, rr = r % 16, kb = rr / 4, nb = rr % 4, gate = mat / 8, h = mat % 8, n0 = 64 * nb, hc = n0 / 128, idx = n0 % 128;
          const float* W = (gate ? F.in[13] : F.in[11]) + (size_t)h * 65536;
          p0_transpose_item(W, 256, 64 * kb, n0, nullptr, WSP(bf16_t, WS_BTG), 256, ((h * 2 + hc) * 2 + gate) * 128 + idx, scr, F.lane); }
    }
    if (F.G != 256) p0_late_weights(F, gw, NGW);
    bf16_t* XB = WSP(bf16_t, WS_XB); float* rs1 = WSP(float, WS_RS1);
    for (int m = gw; m < M; m += NGW) {
        const float* xr = (m < MP ? F.in[0] + (size_t)m * DM : F.in[1] + (size_t)(m - MP) * DM);
        f32x4 v[16]; float ss = 0.f;
#pragma unroll
        for (int j = 0; j < 16; ++j) { v[j] = __builtin_nontemporal_load((const f32x4*)(xr + 4 * (F.lane + 64 * j))); ss += (v[j][0] * v[j][0] + v[j][1] * v[j][1]) + (v[j][2] * v[j][2] + v[j][3] * v[j][3]); }
        ss = wave_sum(ss);
        if (F.lane == 0) rs1[m] = rsqrtf(ss * (1.0f / DM) + EPS);
#pragma unroll
        for (int j = 0; j < 16; ++j) { u32x2 w; w.x = cvt_pk_bf16(v[j][0], v[j][1]); w.y = cvt_pk_bf16(v[j][2], v[j][3]); *(u32x2*)(XB + (size_t)m * DM + 4 * (F.lane + 64 * j)) = w; }
    }
    { float* sp8 = WSP(float, WS_SP8); const int gt = blockIdx.x * 512 + F.tid; if (gt < DRNN) sp8[gt] = 8.0f * softplusf_(-F.in[15][gt]); }
}

constexpr int SI_W = 2048, SI_B = SI_W + 128 * 272, SI_X = SI_B + 128 * 272, SI_XP = 144, SI_END = SI_X + 128 * SI_XP;
static_assert(SI_END <= LDSCTL_OFF, "ssd intra LDS map");
typedef unsigned short u16x4 __attribute__((ext_vector_type(4)));
template <int PITCH>
__device__ __forceinline__ void tr_frags(unsigned a, bf16x8 (&f)[4]) {
    u16x4 r[8];
    asm volatile("ds_read_b64_tr_b16 %0, %8 offset:%9\n\tds_read_b64_tr_b16 %1, %8 offset:%10\n\tds_read_b64_tr_b16 %2, %8 offset:%11\n\tds_read_b64_tr_b16 %3, %8 offset:%12\n\t"
                 "ds_read_b64_tr_b16 %4, %8 offset:%13\n\tds_read_b64_tr_b16 %5, %8 offset:%14\n\tds_read_b64_tr_b16 %6, %8 offset:%15\n\tds_read_b64_tr_b16 %7, %8 offset:%16\n\ts_waitcnt lgkmcnt(0)"
                 : "=&v"(r[0]), "=&v"(r[1]), "=&v"(r[2]), "=&v"(r[3]), "=&v"(r[4]), "=&v"(r[5]), "=&v"(r[6]), "=&v"(r[7])
                 : "v"(a), "n"(0 * PITCH), "n"(4 * PITCH), "n"(32 * PITCH), "n"(36 * PITCH), "n"(64 * PITCH), "n"(68 * PITCH), "n"(96 * PITCH), "n"(100 * PITCH) : "memory");
#pragma unroll
    for (int ks = 0; ks < 4; ++ks) f[ks] = (bf16x8){(short)r[2 * ks][0], (short)r[2 * ks][1], (short)r[2 * ks][2], (short)r[2 * ks][3], (short)r[2 * ks + 1][0], (short)r[2 * ks + 1][1], (short)r[2 * ks + 1][2], (short)r[2 * ks + 1][3]};
}
struct SgPre { u32x4 x[2]; float d0, d1; };
__device__ __forceinline__ void ssd_head_load(Frame& F, SgPre& P, int bc, int hd) {
    const int row0 = bc * 128, tid = F.tid; const bf16_t* XS = WSP(bf16_t, WS_XS); const float* DTA = WSP(float, WS_DTA);
#pragma unroll
    for (int k = 0; k < 2; ++k) { const int id = tid + 512 * k, r = id >> 3, c = id & 7; P.x[k] = *(const u32x4*)(XS + (size_t)(row0 + r) * DSSM + hd * 64 + 8 * c); }
    P.d0 = DTA[(size_t)(row0 + F.lane) * NH + hd]; P.d1 = DTA[(size_t)(row0 + 64 + F.lane) * NH + hd];
}
__device__ __forceinline__ void ssd_group_unit(Frame& F, int bc, int g) {
    LAS float* cumS = (LAS float*)F.lds; LAS float* dtS = cumS + 128; LAS float* decS = dtS + 128;
    LAS bf16_t* Wl = (LAS bf16_t*)(F.lds + SI_W);
    const int row0 = bc * 128, w = F.wave, tid = F.tid, lane = F.lane, li = lane & 15, lq = lane >> 4;
    const unsigned ldsb = (unsigned)(size_t)F.lds;
    const unsigned tq = (unsigned)(8 * lq + (li >> 2)), tp = (unsigned)(4 * (li & 3));
    const bf16_t* BC = WSP(bf16_t, WS_BC);
    SgPre P; ssd_head_load(F, P, bc, 8 * g);
    { u32x4 bq[4];
#pragma unroll
      for (int k = 0; k < 4; ++k) { const int id = tid + 512 * k, r = id >> 4, c = id & 15; bq[k] = *(const u32x4*)(BC + (size_t)(row0 + r) * 1024 + g * 128 + 8 * c); }
      __syncthreads();
#pragma unroll
      for (int k = 0; k < 4; ++k) { const int id = tid + 512 * k, r = id >> 4, c = id & 15; *(LAS u32x4*)(F.lds + SI_B + r * 272 + 16 * c) = bq[k]; } }
    bf16x8 cf[4];
#pragma unroll
    for (int ks = 0; ks < 4; ++ks) cf[ks] = *(const bf16x8*)(BC + (size_t)(row0 + 16 * w + li) * 1024 + 512 + g * 128 + ks * 32 + 8 * lq);
    asm volatile("s_waitcnt lgkmcnt(0)" ::: "memory");
    __syncthreads();
    f32x4 Gr[8];
#pragma unroll
    for (int sb = 0; sb < 8; ++sb) { Gr[sb] = (f32x4){0.f, 0.f, 0.f, 0.f};
        if (sb <= w) {
#pragma unroll
            for (int ks = 0; ks < 4; ++ks) Gr[sb] = __builtin_amdgcn_mfma_f32_16x16x32_bf16(*(const LAS bf16x8*)(F.lds + SI_B + (16 * sb + li) * 272 + (ks * 32 + 8 * lq) * 2), cf[ks], Gr[sb], 0, 0, 0); } }
    bf16x8 btr[4]; tr_frags<272>(ldsb + SI_B + tq * 272 + (16 * w + tp) * 2, btr);
#pragma unroll 1
    for (int hl = 0; hl < 8; ++hl) { const int hd = 8 * g + hl;
        LDS_BARRIER();
#pragma unroll
        for (int k = 0; k < 2; ++k) { const int id = tid + 512 * k, r = id >> 3, c = id & 7; *(LAS u32x4*)(F.lds + SI_X + r * SI_XP + 16 * c) = P.x[k]; }
        if (w == 0) {
            const float A = -__expf(F.in[20][hd]); const float d0 = P.d0, d1 = P.d1;
            float a0 = d0 * A, a1 = d1 * A;
#pragma unroll
            for (int o = 1; o < 64; o <<= 1) { const float t0 = __shfl_up(a0, o), t1 = __shfl_up(a1, o); if (lane >= o) { a0 += t0; a1 += t1; } }
            a1 += __shfl(a0, 63);
            const float last = __shfl(a1, 63);
            cumS[lane] = a0; cumS[64 + lane] = a1; dtS[lane] = d0; dtS[64 + lane] = d1;
            decS[lane] = __expf(last - a0) * d0; decS[64 + lane] = __expf(last - a1) * d1;
            float* CUM = WSP(float, WS_CUM);
            CUM[(size_t)(row0 + lane) * NH + hd] = a0; CUM[(size_t)(row0 + 64 + lane) * NH + hd] = a1;
            if (lane == 0) WSP(float, WS_DEC)[bc * NH + hd] = __expf(last);
        }
        LDS_BARRIER();
        ssd_head_load(F, P, bc, hl < 7 ? hd + 1 : hd);
        bf16x8 xf[4][4];
#pragma unroll
        for (int pb = 0; pb < 4; ++pb) tr_frags<SI_XP>(ldsb + SI_X + tq * SI_XP + (pb * 16 + tp) * 2, xf[pb]);
        { const int t = 16 * w + li; const float cum_t = cumS[t];
#pragma unroll
          for (int sb = 0; sb < 8; ++sb) if (sb <= w) {
              const f32x4 cs = *(const LAS f32x4*)(cumS + 16 * sb + 4 * lq), ds = *(const LAS f32x4*)(dtS + 16 * sb + 4 * lq); float wv[4];
#pragma unroll
              for (int r = 0; r < 4; ++r) { const int s2 = 16 * sb + 4 * lq + r; wv[r] = (s2 <= t) ? Gr[sb][r] * __expf(cum_t - cs[r]) * ds[r] : 0.f; }
              u32x2 pw; pw.x = cvt_pk_bf16(wv[0], wv[1]); pw.y = cvt_pk_bf16(wv[2], wv[3]);
              *(LAS u32x2*)(Wl + t * 136 + 16 * sb + 4 * lq) = pw; }
          if ((w & 1) == 0) *(LAS u32x2*)(Wl + t * 136 + 16 * (w + 1) + 4 * lq) = (u32x2){0u, 0u}; }
        asm volatile("s_waitcnt lgkmcnt(0)" ::: "memory");
        { f32x4 ay[4];
#pragma unroll
          for (int pb = 0; pb < 4; ++pb) ay[pb] = (f32x4){0.f, 0.f, 0.f, 0.f};
          const int nks = (w >> 1) + 1;
#pragma unroll
          for (int ks = 0; ks < 4; ++ks) if (ks < nks) { const bf16x8 wf = *(const LAS bf16x8*)(Wl + (16 * w + li) * 136 + ks * 32 + 8 * lq);
#pragma unroll
              for (int pb = 0; pb < 4; ++pb) ay[pb] = __builtin_amdgcn_mfma_f32_16x16x32_bf16(xf[pb][ks], wf, ay[pb], 0, 0, 0); }
          bf16_t* YD = WSP(bf16_t, WS_YD) + (size_t)(row0 + 16 * w + li) * DSSM + hd * 64 + 4 * lq;
#pragma unroll
          for (int pb = 0; pb < 4; ++pb) { u32x2 o; o.x = cvt_pk_bf16(ay[pb][0], ay[pb][1]); o.y = cvt_pk_bf16(ay[pb][2], ay[pb][3]); *(u32x2*)(YD + pb * 16) = o; } }
        { bf16x8 bt[4];
#pragma unroll
          for (int ks = 0; ks < 4; ++ks) { const u32x4 raw = __builtin_bit_cast(u32x4, btr[ks]);
              const f32x4 d0 = *(const LAS f32x4*)(decS + ks * 32 + 8 * lq), d1 = *(const LAS f32x4*)(decS + ks * 32 + 8 * lq + 4);
              u32x4 sc; sc.x = cvt_pk_bf16(bf_lo(raw.x) * d0[0], bf_hi(raw.x) * d0[1]); sc.y = cvt_pk_bf16(bf_lo(raw.y) * d0[2], bf_hi(raw.y) * d0[3]);
              sc.z = cvt_pk_bf16(bf_lo(raw.z) * d1[0], bf_hi(raw.z) * d1[1]); sc.w = cvt_pk_bf16(bf_lo(raw.w) * d1[2], bf_hi(raw.w) * d1[3]);
              bt[ks] = __builtin_bit_cast(bf16x8, sc); }
          float* ST = WSP(float, WS_ST) + ((size_t)(bc * NH + hd) * 64 + li) * 128 + 16 * w + 4 * lq;
#pragma unroll
          for (int pb = 0; pb < 4; ++pb) { f32x4 as = (f32x4){0.f, 0.f, 0.f, 0.f};
#pragma unroll
              for (int ks = 0; ks < 4; ++ks) as = __builtin_amdgcn_mfma_f32_16x16x32_bf16(bt[ks], xf[pb][ks], as, 0, 0, 0);
              *(f32x4*)(ST + (size_t)pb * 16 * 128) = as; } }
    }
}
__device__ __forceinline__ void ssd_intra_all(Frame& F) {
    for (int u = blockIdx.x; u < NCH * NG; u += F.G) ssd_group_unit(F, u >> 2, u & 3);
    __syncthreads();
}
struct SsPre { f32x4 h0[4]; float dt[4]; bf16_t x[4]; };
struct SsBC { u32x2 bq[4][4], cq[4][4]; };
__device__ __forceinline__ void ssd_sample_load(Frame& F, SsPre& P, int s, int hd) {
    const int tid = F.tid, p = tid >> 3, nq = tid & 7, r0 = MP + 4 * s;
    const float* DTA = WSP(float, WS_DTA); const bf16_t* XS = WSP(bf16_t, WS_XS);
    const float* h0p = F.in[4] + (((size_t)s * NH + hd) * 64 + p) * 128 + 4 * nq;
#pragma unroll
    for (int j = 0; j < 4; ++j) P.h0[j] = __builtin_nontemporal_load((const f32x4*)(h0p + 32 * j));
#pragma unroll
    for (int t = 0; t < 4; ++t) { P.dt[t] = DTA[(size_t)(r0 + t) * NH + hd]; P.x[t] = XS[(size_t)(r0 + t) * DSSM + hd * 64 + p]; }
}
__device__ __forceinline__ void ssd_sample_loadbc(Frame& F, SsBC& Q, int s, int g) {
    const int nq = F.tid & 7, r0 = MP + 4 * s; const bf16_t* BC = WSP(bf16_t, WS_BC);
#pragma unroll
    for (int t = 0; t < 4; ++t) { const bf16_t* br = BC + (size_t)(r0 + t) * 1024 + g * 128 + 4 * nq;
#pragma unroll
        for (int j = 0; j < 4; ++j) { Q.bq[t][j] = *(const u32x2*)(br + 32 * j); Q.cq[t][j] = *(const u32x2*)(br + 512 + 32 * j); } }
}
__device__ __forceinline__ void ssd_sample_compute(Frame& F, const SsPre& P, const SsBC& Q, int s, int hd, const LAS float* scb, const LAS float* atab) {
    const int tid = F.tid, p = tid >> 3, nq = tid & 7, r0 = MP + 4 * s;
    const u32x2 (&bq)[4][4] = Q.bq; const u32x2 (&cq)[4][4] = Q.cq;
    const float A = atab[hd];
    float dt[4], cum[4], x[4]; float run = 0.f;
#pragma unroll
    for (int t = 0; t < 4; ++t) { dt[t] = P.dt[t]; run += dt[t] * A; cum[t] = run; x[t] = bf2f(P.x[t]); }
    float yoff[4];
#pragma unroll
    for (int t = 0; t < 4; ++t) { float a = 0.f;
#pragma unroll
        for (int j = 0; j < 4; ++j) a += (bf_lo(cq[t][j].x) * P.h0[j][0] + bf_hi(cq[t][j].x) * P.h0[j][1]) + (bf_lo(cq[t][j].y) * P.h0[j][2] + bf_hi(cq[t][j].y) * P.h0[j][3]);
        yoff[t] = a; }
#pragma unroll
    for (int o = 1; o < 8; o <<= 1) {
#pragma unroll
        for (int t = 0; t < 4; ++t) yoff[t] += __shfl_xor(yoff[t], o); }
    if (nq == 0) {
        float* YD = WSP(float, WS_YD);
#pragma unroll
        for (int t = 0; t < 4; ++t) { float y = __expf(cum[t]) * yoff[t];
#pragma unroll
            for (int s2 = 0; s2 < 4; ++s2) if (s2 <= t) y += scb[t * (t + 1) / 2 + s2] * __expf(cum[t] - cum[s2]) * dt[s2] * x[s2];
            YD[(size_t)(r0 + t) * DSSM + hd * 64 + p] = y; }
    }
    const float dec3 = __expf(cum[3]); float cx[4];
#pragma unroll
    for (int t = 0; t < 4; ++t) cx[t] = __expf(cum[3] - cum[t]) * dt[t] * x[t];
    float* hp = F.out + O_SSH + (((size_t)s * NH + hd) * 64 + p) * 128 + 4 * nq;
#pragma unroll
    for (int j = 0; j < 4; ++j) { f32x4 hn = P.h0[j] * dec3;
#pragma unroll
        for (int t = 0; t < 4; ++t) { hn[0] += bf_lo(bq[t][j].x) * cx[t]; hn[1] += bf_hi(bq[t][j].x) * cx[t]; hn[2] += bf_lo(bq[t][j].y) * cx[t]; hn[3] += bf_hi(bq[t][j].y) * cx[t]; }
        __builtin_nontemporal_store(hn, (f32x4*)(hp + 32 * j)); }
}
__device__ __forceinline__ void ssd_sample_all(Frame& F) {
    LAS float* atab = (LAS float*)F.lds;
    LAS float* scb = atab + 32;
    if (F.tid < NH) atab[F.tid] = -__expf(F.in[20][F.tid]);
    const bf16_t* BC = WSP(bf16_t, WS_BC);
    int start, count; const int c = blockIdx.x;
    if (F.G == 256) { if (c < 32) { count = 10; start = 10 * c; } else { const int i = c - 32; count = i < 192 ? 17 : 16; start = 320 + (i < 192 ? 17 * i : 17 * 192 + 16 * (i - 192)); } }
    else { const int per = (NSQ * NH + F.G - 1) / F.G; start = c * per; count = NSQ * NH - start; count = count < 0 ? 0 : (count > per ? per : count); }
    SsBC Q; int cur = -1;
#pragma unroll 1
    for (int b0 = 0; b0 < count; b0 += 32) { const int nb = count - b0 < 32 ? count - b0 : 32;
        __syncthreads();
        if (F.tid < nb * 10) { const int k = F.tid / 10, pr = F.tid % 10, u = start + b0 + k;
            const int t = pr < 1 ? 0 : pr < 3 ? 1 : pr < 6 ? 2 : 3, s2 = pr - t * (t + 1) / 2, r0 = MP + 4 * (u >> 5), g = (u & 31) >> 3;
            const bf16_t* cr = BC + (size_t)(r0 + t) * 1024 + 512 + g * 128; const bf16_t* br = BC + (size_t)(r0 + s2) * 1024 + g * 128; float a = 0.f;
#pragma unroll
            for (int q = 0; q < 16; ++q) { const u32x4 cv = *(const u32x4*)(cr + 8 * q), bv = *(const u32x4*)(br + 8 * q);
                a += (bf_lo(cv.x) * bf_lo(bv.x) + bf_hi(cv.x) * bf_hi(bv.x)) + (bf_lo(cv.y) * bf_lo(bv.y) + bf_hi(cv.y) * bf_hi(bv.y)) + (bf_lo(cv.z) * bf_lo(bv.z) + bf_hi(cv.z) * bf_hi(bv.z)) + (bf_lo(cv.w) * bf_lo(bv.w) + bf_hi(cv.w) * bf_hi(bv.w)); }
            scb[k * 16 + pr] = a; }
        __syncthreads();
        SsPre A, B; const int ub = start + b0, ulast = ub + nb - 1;
        ssd_sample_load(F, A, ub >> 5, ub & 31);
        FULL_FENCE();
#pragma unroll 1
        for (int k = 0; k < nb; k += 2) {
            const int u = ub + k, u1 = u + 1 < ulast ? u + 1 : ulast, u2 = u + 2 < ulast ? u + 2 : ulast;
            if ((u >> 3) != cur) { ssd_sample_loadbc(F, Q, u >> 5, (u & 31) >> 3); cur = u >> 3; }
            ssd_sample_load(F, B, u1 >> 5, u1 & 31);
            FULL_FENCE();
            ssd_sample_compute(F, A, Q, u >> 5, u & 31, scb + k * 16, atab);
            FULL_FENCE();
            if (k + 1 < nb) { if ((u1 >> 3) != cur) { ssd_sample_loadbc(F, Q, u1 >> 5, (u1 & 31) >> 3); cur = u1 >> 3; }
                ssd_sample_load(F, A, u2 >> 5, u2 & 31);
                FULL_FENCE();
                ssd_sample_compute(F, B, Q, u1 >> 5, u1 & 31, scb + (k + 1) * 16, atab);
                FULL_FENCE(); }
        }
    }
}
__device__ __forceinline__ void p4_scan(Frame& F) {
    const unsigned* AB = WSP(unsigned, WS_AB); const bf16_t* G2 = WSP(bf16_t, WS_G2); bf16_t* CAT = WSP(bf16_t, WS_CAT); float* SSQ = WSP(float, WS_SSQRG);
    LAS f32x2* carr = (LAS f32x2*)F.lds;
    for (int u = blockIdx.x; u < NB * 64; u += F.G) {
        const int b = u >> 6, slab = u & 63, cl = F.tid & 31, seg = F.tid >> 5, ch = slab * 32 + cl, rowb = b * SEQ + seg * 128;
        float Ap = 1.f, hl = 0.f;
#pragma unroll 1
        for (int tt = 0; tt < 128; tt += 32) { unsigned v[32];
#pragma unroll
            for (int k = 0; k < 32; ++k) v[k] = AB[(size_t)(rowb + tt + k) * DRNN + ch];
#pragma unroll
            for (int k = 0; k < 32; ++k) { const float a = 1.0f - bf_lo(v[k]); Ap *= a; hl = a * hl + bf_hi(v[k]); } }
        __syncthreads();
        carr[seg * 32 + cl] = (f32x2){Ap, hl};
        __syncthreads();
        float h = 0.f;
        for (int s2 = 0; s2 < seg; ++s2) { const f32x2 c = carr[s2 * 32 + cl]; h = c[0] * h + c[1]; }
#pragma unroll 1
        for (int tt = 0; tt < 128; tt += 32) { unsigned v[32]; float gt[32];
#pragma unroll
            for (int k = 0; k < 32; ++k) { v[k] = AB[(size_t)(rowb + tt + k) * DRNN + ch]; gt[k] = bf2f(G2[(size_t)(rowb + tt + k) * 4096 + ch]); }
            float q[32];
#pragma unroll
            for (int k = 0; k < 32; ++k) { h = (1.0f - bf_lo(v[k])) * h + bf_hi(v[k]); const float o = h * gt[k];
                CAT[(size_t)(rowb + tt + k) * DM + ch] = (bf16_t)(cvt_pk_bf16(o, 0.f) & 0xffffu); q[k] = o * o; }
#define SCAN_BFLY(HB) do { const bool up = (cl & (HB)) != 0; _Pragma("unroll") for (int k = 0; k < (HB); ++k) { const float send = up ? q[k] : q[k + (HB)], keep = up ? q[k + (HB)] : q[k]; q[k] = keep + __shfl_xor(send, (HB)); } } while (0)
            SCAN_BFLY(16); SCAN_BFLY(8); SCAN_BFLY(4); SCAN_BFLY(2); SCAN_BFLY(1);
#undef SCAN_BFLY
            SSQ[(size_t)(rowb + tt + cl) * 64 + slab] = q[0]; }
        if (seg == 15) F.out[O_PRGH + (size_t)b * DRNN + ch] = h;
    }
    { const size_t gt = (size_t)blockIdx.x * 512 + F.tid, NT = (size_t)F.G * 512;
      for (size_t it = gt; it < (size_t)NSQ * DRNN; it += NT) { const int s = (int)(it >> 11), ch = (int)(it & 2047); float h = F.in[2][it];
#pragma unroll
          for (int t = 0; t < 4; ++t) { const int row = MP + 4 * s + t; const unsigned v = AB[(size_t)row * DRNN + ch]; h = (1.0f - bf_lo(v)) * h + bf_hi(v);
              const float o = h * bf2f(G2[(size_t)row * 4096 + ch]); CAT[(size_t)row * DM + ch] = (bf16_t)(cvt_pk_bf16(o, 0.f) & 0xffffu);
              const float q = wave_sum(o * o);
              if (F.lane == 0) { SSQ[(size_t)row * 64 + 2 * (ch >> 6)] = q; SSQ[(size_t)row * 64 + 2 * (ch >> 6) + 1] = 0.f; } }
          F.out[O_SRGH + it] = h; } }
    { const float* ST = WSP(float, WS_ST); const float* DEC = WSP(float, WS_DEC); bf16_t* HPB = WSP(bf16_t, WS_HPB);
      const size_t gt = (size_t)blockIdx.x * 512 + F.tid, NT = (size_t)F.G * 512;
      for (size_t it = gt; it < (size_t)NB * NH * 64 * 32; it += NT) { const int b = (int)(it >> 16), rem = (int)(it & 65535), hd = rem >> 11, e = rem & 2047;
          f32x4 h = (f32x4){0.f, 0.f, 0.f, 0.f}; f32x4 stv[16]; float dcv[16];
#pragma unroll
          for (int c = 0; c < 16; ++c) { const int bc = b * 16 + c; stv[c] = __builtin_nontemporal_load((const f32x4*)(ST + ((size_t)(bc * NH + hd) * 8192) + 4 * e)); dcv[c] = DEC[bc * NH + hd]; }
#pragma unroll
          for (int c = 0; c < 16; ++c) { const int bc = b * 16 + c; const size_t o = ((size_t)(bc * NH + hd) * 8192) + 4 * e;
              u32x2 w; w.x = cvt_pk_bf16(h[0], h[1]); w.y = cvt_pk_bf16(h[2], h[3]); *(u32x2*)(HPB + o) = w;
              h = h * dcv[c] + stv[c]; }
          *(f32x4*)(F.out + O_PSH + ((size_t)(b * NH + hd) * 8192) + 4 * e) = h; } }
}

constexpr int P5_HT_OFF = 8 * 16640;
static_assert(P5_HT_OFF + 64 * 272 <= LDSCTL_OFF, "P5 LDS map");
__device__ __forceinline__ void p5_unit(Frame& F, int g, int bc) {
    const int w = F.wave, lane = F.lane, li = lane & 15, lq = lane >> 4, row0 = bc * 128, row = row0 + 16 * w + li;
    const bf16_t* BC = WSP(bf16_t, WS_BC); bf16_t* CAT = WSP(bf16_t, WS_CAT);
    LAS unsigned char* U = F.lds + w * 16640;
    bf16x8 cf[4];
#pragma unroll
    for (int ks = 0; ks < 4; ++ks) cf[ks] = *(const bf16x8*)(BC + (size_t)row * 1024 + 512 + g * 128 + ks * 32 + 8 * lq);
    float ss = 0.f;
    const bf16_t* HPB = WSP(bf16_t, WS_HPB); const bf16_t* XS = WSP(bf16_t, WS_XS); const bf16_t* YD = WSP(bf16_t, WS_YD); const float* CUM = WSP(float, WS_CUM); const bf16_t* G2 = WSP(bf16_t, WS_G2);
    LAS unsigned char* HT = F.lds + P5_HT_OFF;
    u32x4 hq[2];
#pragma unroll
    for (int k = 0; k < 2; ++k) { const int id = F.tid + 512 * k; hq[k] = *(const u32x4*)(HPB + (size_t)(bc * NH + 8 * g) * 8192 + (id >> 4) * 128 + 8 * (id & 15)); }
#pragma unroll 1
    for (int hl = 0; hl < 8; ++hl) { const int hd = 8 * g + hl;
        LDS_BARRIER();
#pragma unroll
        for (int k = 0; k < 2; ++k) { const int id = F.tid + 512 * k; *(LAS u32x4*)(HT + (id >> 4) * 272 + 16 * (id & 15)) = hq[k]; }
        u32x2 yw[4], zw[4], xw[4];
        const float ecr = CUM[(size_t)row * NH + hd], Dh = F.in[21][hd];
#pragma unroll
        for (int pb = 0; pb < 4; ++pb) { const int ch = hd * 64 + pb * 16 + 4 * lq;
            yw[pb] = __builtin_nontemporal_load((const u32x2*)(YD + (size_t)row * DSSM + ch)); zw[pb] = *(const u32x2*)(G2 + (size_t)row * 4096 + 2048 + ch); xw[pb] = *(const u32x2*)(XS + (size_t)row * DSSM + ch); }
        { const int hn = hl < 7 ? hd + 1 : hd;
#pragma unroll
          for (int k = 0; k < 2; ++k) { const int id = F.tid + 512 * k; hq[k] = *(const u32x4*)(HPB + (size_t)(bc * NH + hn) * 8192 + (id >> 4) * 128 + 8 * (id & 15)); } }
        LDS_BARRIER();
        const float ec = __expf(ecr);
#pragma unroll
        for (int pb = 0; pb < 4; ++pb) { f32x4 a = (f32x4){0.f, 0.f, 0.f, 0.f};
#pragma unroll
            for (int ks = 0; ks < 4; ++ks) a = __builtin_amdgcn_mfma_f32_16x16x32_bf16(*(const LAS bf16x8*)(HT + (pb * 16 + li) * 272 + (ks * 32 + 8 * lq) * 2), cf[ks], a, 0, 0, 0);
            const float xv[4] = {bf_lo(xw[pb].x), bf_hi(xw[pb].x), bf_lo(xw[pb].y), bf_hi(xw[pb].y)}; const float zv[4] = {bf_lo(zw[pb].x), bf_hi(zw[pb].x), bf_lo(zw[pb].y), bf_hi(zw[pb].y)}; float v[4];
            const float yv[4] = {bf_lo(yw[pb].x), bf_hi(yw[pb].x), bf_lo(yw[pb].y), bf_hi(yw[pb].y)};
#pragma unroll
            for (int r = 0; r < 4; ++r) { const float y = yv[r] + ec * a[r] + Dh * xv[r]; v[r] = y * zv[r]; ss += v[r] * v[r]; }
            u32x2 o; o.x = cvt_pk_bf16(v[0], v[1]); o.y = cvt_pk_bf16(v[2], v[3]);
            *(LAS u32x2*)(U + li * 1040 + (hl * 64 + pb * 16 + 4 * lq) * 2) = o; }
    }
    ss += __shfl_xor(ss, 16); ss += __shfl_xor(ss, 32);
    const float rs = rsqrtf(ss * (1.0f / 512.0f) + EPS);
    asm volatile("s_waitcnt lgkmcnt(0)" ::: "memory");
#pragma unroll 4
    for (int j = 0; j < 16; ++j) { const float rj = __shfl(rs, j); u32x4 v = *(const LAS u32x4*)(U + j * 1040 + lane * 16);
        v.x = cvt_pk_bf16(bf_lo(v.x) * rj, bf_hi(v.x) * rj); v.y = cvt_pk_bf16(bf_lo(v.y) * rj, bf_hi(v.y) * rj); v.z = cvt_pk_bf16(bf_lo(v.z) * rj, bf_hi(v.z) * rj); v.w = cvt_pk_bf16(bf_lo(v.w) * rj, bf_hi(v.w) * rj);
        *(u32x4*)(CAT + (size_t)(row0 + 16 * w + j) * DM + DRNN + g * 512 + lane * 8) = v; }
    asm volatile("s_waitcnt lgkmcnt(0)" ::: "memory");
}
__device__ __forceinline__ void p5_norms(Frame& F, bool rg_rows) {
    const int gw = F.wave * F.G + blockIdx.x, NGW = F.G * 8;
    if (rg_rows && gw < M) { const float* SSQ = WSP(float, WS_SSQRG); bf16_t* CAT = WSP(bf16_t, WS_CAT);
      const int rlast = gw + ((M - 1 - gw) / NGW) * NGW;
      float qa, qb; u32x4 ca[4], cb[4];
#define P5_RG_LOAD(q_, c_, r_) do { q_ = SSQ[(size_t)(r_) * 64 + F.lane]; _Pragma("unroll") for (int j = 0; j < 4; ++j) c_[j] = *(const u32x4*)(CAT + (size_t)(r_) * DM + 8 * (F.lane + 64 * j)); } while (0)
#define P5_RG_FIN(q_, c_, r_) do { const float rs = rsqrtf(wave_sum(q_) * (1.0f / DRNN) + EPS); _Pragma("unroll") for (int j = 0; j < 4; ++j) { u32x4 v = c_[j]; \
          v.x = cvt_pk_bf16(bf_lo(v.x) * rs, bf_hi(v.x) * rs); v.y = cvt_pk_bf16(bf_lo(v.y) * rs, bf_hi(v.y) * rs); v.z = cvt_pk_bf16(bf_lo(v.z) * rs, bf_hi(v.z) * rs); v.w = cvt_pk_bf16(bf_lo(v.w) * rs, bf_hi(v.w) * rs); \
          *(u32x4*)(CAT + (size_t)(r_) * DM + 8 * (F.lane + 64 * j)) = v; } } while (0)
      P5_RG_LOAD(qa, ca, gw);
#pragma unroll 1
      for (int row = gw; row <= rlast; row += 2 * NGW) {
          const int r1 = row + NGW < rlast ? row + NGW : rlast, r2 = row + 2 * NGW < rlast ? row + 2 * NGW : rlast;
          const bool two = row + NGW <= rlast;
          P5_RG_LOAD(qb, cb, r1);
          FULL_FENCE();
          P5_RG_FIN(qa, ca, row); FULL_FENCE();
          if (two) { P5_RG_LOAD(qa, ca, r2); FULL_FENCE(); P5_RG_FIN(qb, cb, r1); FULL_FENCE(); }
      }
#undef P5_RG_LOAD
#undef P5_RG_FIN
    }
    { const float* YD = WSP(float, WS_YD); const bf16_t* G2 = WSP(bf16_t, WS_G2); const bf16_t* XS = WSP(bf16_t, WS_XS); bf16_t* CAT = WSP(bf16_t, WS_CAT);
      for (int it = gw; it < MS * NG; it += NGW) { const int row = MP + (it >> 2), g = it & 3, ch = g * 512 + 8 * F.lane; const float Dh = F.in[21][ch >> 6];
          const f32x4 y0 = *(const f32x4*)(YD + (size_t)row * DSSM + ch), y1 = *(const f32x4*)(YD + (size_t)row * DSSM + ch + 4);
          const f32x4 z0 = ld_bf4(G2 + (size_t)row * 4096 + 2048 + ch), z1 = ld_bf4(G2 + (size_t)row * 4096 + 2048 + ch + 4);
          const u32x4 xw = *(const u32x4*)(XS + (size_t)row * DSSM + ch);
          const float xv[8] = {bf_lo(xw.x), bf_hi(xw.x), bf_lo(xw.y), bf_hi(xw.y), bf_lo(xw.z), bf_hi(xw.z), bf_lo(xw.w), bf_hi(xw.w)};
          float v[8]; float ss = 0.f;
#pragma unroll
          for (int e = 0; e < 8; ++e) { const float y = (e < 4 ? y0[e & 3] : y1[e & 3]) + Dh * xv[e]; const float z = e < 4 ? z0[e & 3] : z1[e & 3]; v[e] = y * z; ss += v[e] * v[e]; }
          const float rs = rsqrtf(wave_sum(ss) * (1.0f / 512.0f) + EPS);
          u32x4 o; o.x = cvt_pk_bf16(v[0] * rs, v[1] * rs); o.y = cvt_pk_bf16(v[2] * rs, v[3] * rs); o.z = cvt_pk_bf16(v[4] * rs, v[5] * rs); o.w = cvt_pk_bf16(v[6] * rs, v[7] * rs);
          *(u32x4*)(CAT + (size_t)row * DM + DRNN + ch) = o; } }
    for (int u = blockIdx.x; u < NCH * NG; u += F.G) p5_unit(F, u & 3, u >> 2);
}

constexpr int G3_BUSY = ((M / 256) * (2 * DFF / 256)) % 256;
static_assert(G3_BUSY > 0 && G3_BUSY < 256, "up GEMM tail");
constexpr int REM_FIRST = 512, REM_N = 32;
__device__ __forceinline__ void rem_table(Frame& F, LAS signed char* rem) {
    for (int i = F.tid; i < (M / 256) * 16; i += 512) rem[i] = -1;
    __syncthreads();
    if (F.G == 256 && F.tid < REM_N) { pg8::StaticOrder S; S.init(M, DM, F.G, 0); pg8::Unit u; S.tile_of(REM_FIRST + F.tid, u); rem[u.pm * 16 + u.pn] = (signed char)F.tid; }
    __syncthreads();
}
__device__ __forceinline__ void p7_row_load(const bf16_t* X1, int row, int lane, u32x2 (&w)[16]) {
#pragma unroll
    for (int j = 0; j < 16; ++j) w[j] = *(const u32x2*)(X1 + (size_t)row * DM + 256 * j + 4 * lane);
}
__device__ __forceinline__ void p7_row_finish(Frame& F, const LAS signed char* rem, int row, const u32x2 (&w)[16]) {
    const float* PART = WSP(float, WS_PART); bf16_t* X1 = WSP(bf16_t, WS_X1); unsigned char* X1Q = WSP(unsigned char, WS_X1B); float* RF3 = WSP(float, WS_RF3);
    bf16_t* xr = X1 + (size_t)row * DM; const float* xin = (row < MP ? F.in[0] + (size_t)row * DM : F.in[1] + (size_t)(row - MP) * DM);
    f32x4 v[16]; float ss = 0.f, mx = 0.f;
#pragma unroll
    for (int j = 0; j < 16; ++j) { const int c = 256 * j + 4 * F.lane; const int tl = rem[(row >> 8) * 16 + j];
        if (tl < 0) v[j] = (f32x4){bf_lo(w[j].x), bf_hi(w[j].x), bf_lo(w[j].y), bf_hi(w[j].y)};
        else { f32x4 a = *(const f32x4*)(xin + c);
#pragma unroll
            for (int ks = 0; ks < 8; ++ks) a += *(const f32x4*)(PART + ((size_t)(tl * 8 + ks) << 16) + (row & 255) * 256 + 4 * F.lane);
            u32x2 q; q.x = cvt_pk_bf16(a[0], a[1]); q.y = cvt_pk_bf16(a[2], a[3]); *(u32x2*)(xr + c) = q;
            v[j] = (f32x4){bf_lo(q.x), bf_hi(q.x), bf_lo(q.y), bf_hi(q.y)}; }
        ss += (v[j][0] * v[j][0] + v[j][1] * v[j][1]) + (v[j][2] * v[j][2] + v[j][3] * v[j][3]);
        mx = fmaxf(mx, fmaxf(fmaxf(fabsf(v[j][0]), fabsf(v[j][1])), fmaxf(fabsf(v[j][2]), fabsf(v[j][3])))); }
    ss = wave_sum(ss);
#pragma unroll
    for (int o = 1; o < 64; o <<= 1) mx = fmaxf(mx, __shfl_xor(mx, o));
    mx = fmaxf(mx, 1e-30f);
    if (F.lane == 0) RF3[row] = rsqrtf(ss * (1.0f / DM) + EPS) * mx * (1.0f / 127.0f);
    const float inv = 127.0f / mx;
#pragma unroll
    for (int j = 0; j < 16; ++j) *(unsigned*)(X1Q + (size_t)row * DM + 256 * j + 4 * F.lane) = q8_pack4(v[j][0], v[j][1], v[j][2], v[j][3], inv);
}
__device__ __forceinline__ void p7_x1_rows(Frame& F) {
    LAS signed char* rem = (LAS signed char*)F.lds; rem_table(F, rem);
    const bf16_t* X1 = WSP(bf16_t, WS_X1);
    const int gw = F.wave * F.G + blockIdx.x, NGW = F.G * 8;
    if (gw >= M) return;
    const int rlast = gw + ((M - 1 - gw) / NGW) * NGW;
    u32x2 wa[16], wb[16];
    p7_row_load(X1, gw, F.lane, wa);
#pragma unroll 1
    for (int row = gw; row <= rlast; row += 2 * NGW) {
        const int r1 = row + NGW < rlast ? row + NGW : rlast, r2 = row + 2 * NGW < rlast ? row + 2 * NGW : rlast;
        p7_row_load(X1, r1, F.lane, wb); FULL_FENCE();
        p7_row_finish(F, rem, row, wa); FULL_FENCE();
        if (row + NGW <= rlast) { p7_row_load(X1, r2, F.lane, wa); FULL_FENCE(); p7_row_finish(F, rem, r1, wb); FULL_FENCE(); }
    }
}
__device__ __forceinline__ void pf_row_finish(Frame& F, const LAS signed char* rem, int row, const u32x2 (&w)[16], const f32x4 (&gfv)[16]) {
    const float* PART = WSP(float, WS_PART); const bf16_t* X1 = WSP(bf16_t, WS_X1);
    float* o = F.out + (size_t)row * DM; f32x4 v[16]; float ss = 0.f;
#pragma unroll
    for (int j = 0; j < 16; ++j) { const int c = 256 * j + 4 * F.lane; const int tl = rem[(row >> 8) * 16 + j];
        if (tl < 0) v[j] = (f32x4){bf_lo(w[j].x), bf_hi(w[j].x), bf_lo(w[j].y), bf_hi(w[j].y)};
        else { f32x4 a = ld_bf4(X1 + (size_t)row * DM + c);
#pragma unroll
            for (int ks = 0; ks < 8; ++ks) a += *(const f32x4*)(PART + ((size_t)(tl * 8 + ks) << 16) + (row & 255) * 256 + 4 * F.lane);
            v[j] = a; }
        ss += (v[j][0] * v[j][0] + v[j][1] * v[j][1]) + (v[j][2] * v[j][2] + v[j][3] * v[j][3]); }
    const float rs = rsqrtf(wave_sum(ss) * (1.0f / DM) + EPS);
#pragma unroll
    for (int j = 0; j < 16; ++j) *(f32x4*)(o + 256 * j + 4 * F.lane) = v[j] * rs * gfv[j];
}
__device__ __forceinline__ void p_final(Frame& F) {
    LAS signed char* rem = (LAS signed char*)F.lds; rem_table(F, rem);
    const bf16_t* X2B = WSP(bf16_t, WS_X2B); const float* gf = F.in[29];
    const int gw = F.wave * F.G + blockIdx.x, NGW = F.G * 8;
    if (gw >= M) return;
    f32x4 gfv[16];
#pragma unroll
    for (int j = 0; j < 16; ++j) gfv[j] = *(const f32x4*)(gf + 256 * j + 4 * F.lane);
    const int rlast = gw + ((M - 1 - gw) / NGW) * NGW;
    u32x2 wa[16], wb[16];
    p7_row_load(X2B, gw, F.lane, wa);
#pragma unroll 1
    for (int row = gw; row <= rlast; row += 2 * NGW) {
        const int r1 = row + NGW < rlast ? row + NGW : rlast, r2 = row + 2 * NGW < rlast ? row + 2 * NGW : rlast;
        p7_row_load(X2B, r1, F.lane, wb); FULL_FENCE();
        pf_row_finish(F, rem, row, wa, gfv); FULL_FENCE();
        if (row + NGW <= rlast) { p7_row_load(X2B, r2, F.lane, wa); FULL_FENCE(); pf_row_finish(F, rem, r1, wb, gfv); FULL_FENCE(); }
    }
}

constexpr int NPH = 12;
__global__ void __launch_bounds__(512, 2) mk_fwd(Args args) {
    extern __shared__ __attribute__((aligned(16))) unsigned char lds_raw[];
    Frame F;
    F.lds = (LAS unsigned char*)lds_raw; F.tid = threadIdx.x; F.lane = F.tid & 63; F.wave = __builtin_amdgcn_readfirstlane(F.tid >> 6); F.G = gridDim.x;
#pragma unroll
    for (int i = 0; i < 30; ++i) F.in[i] = args.in[i];
    F.out = args.out; F.ws = args.ws;
    volatile LAS unsigned* MISC = (volatile LAS unsigned*)(F.lds + LDSCTL_OFF);
    if (F.tid < 64) MISC[F.tid] = 0u;
    __syncthreads();
    unsigned* ctl = (unsigned*)(F.ws + WS_CTL);
    XcdBarrier bar = xcd_barrier_post(ctl + CW_BAR + args.li * XCD_BAR_WORDS, MISC + 8);
    const int lo = args.ph_lo, hi = args.ph_hi;
#ifndef PH_MASK
#define PH_MASK 0xfff
#endif
#define IN(k) (((PH_MASK >> (k)) & 1) && lo <= (k) && (k) < hi)
#define SEAM(k) do { if (IN(k) && IN((k) + 1)) xcd_barrier(bar); } while (0)

    if (IN(0)) { p0_prologue(F); } SEAM(0);
    if (IN(1)) {
        const bool roles = (F.G == 256);
        const int x = (int)blockIdx.x & 7, j = (int)blockIdx.x >> 3; const bool is_gemm = !roles || j < G1_PER + (x < G1_HI ? 1 : 0);
        if (!is_gemm) { const int sidx = (j == G1_PER) ? x - G1_HI : (8 - G1_HI) + (j - G1_PER - 1) * 8 + x; p0_late_weights(F, sidx * 8 + F.wave, NSTREAM * 8); }
        else { pg8::Gemm g{WSP(bf16_t, WS_XB), WSP(bf16_t, WS_BT1), M, N1P, DM, DM, DM}; pg8::StaticOrder S0; S0.init(M, N1P, roles ? NGEMM1 : F.G, (int)blockIdx.x);
            pg8::ChunkOrder S{S0, roles ? G1_PER : ((F.G & 7) == 0 ? F.G >> 3 : 0), roles ? G1_HI : 0};
            EpiProjConv E{F.ws, F.out, F.in[9], F.in[10], F.in[17], F.in[18], F.in[19], F.in[3], F.in[5], (LAS float*)(F.lds + RING_BYTES)};
            pg8::gemm_phase<EpiProjConv, pg8::GeomPlain, pg8::ChunkOrder, true>(F.lds, g, S, E); } } SEAM(1);
    if (IN(3)) {
#ifndef P3_REP
#define P3_REP 0
#endif
        { pg8::Gemm g{WSP(bf16_t, WS_XCB), WSP(bf16_t, WS_BTG), M, 16 * 256, 256, DRNN, 256}; pg8::StaticOrder S; S.init(M, 16 * 256, F.G, (int)blockIdx.x);
          EpiGates E{WSP(unsigned, WS_AB), WSP(bf16_t, WS_XCB), F.in[12], F.in[14], WSP(float, WS_SP8)};
          pg8::gemm_phase<EpiGates, pg8::GeomGates, pg8::StaticOrder, true>(F.lds, g, S, E);
          if (P3_REP == 1) { pg8::gemm_phase<EpiGates, pg8::GeomGates, pg8::StaticOrder, true>(F.lds, g, S, E); pg8::gemm_phase<EpiGates, pg8::GeomGates, pg8::StaticOrder, true>(F.lds, g, S, E); pg8::gemm_phase<EpiGates, pg8::GeomGates, pg8::StaticOrder, true>(F.lds, g, S, E); }
        }
        ssd_intra_all(F);
        if (P3_REP == 2) { ssd_intra_all(F); ssd_intra_all(F); ssd_intra_all(F); }
        ssd_sample_all(F);
        if (P3_REP == 3) { ssd_sample_all(F); ssd_sample_all(F); ssd_sample_all(F); }
    } SEAM(3);
    if (IN(4)) { p4_scan(F); } SEAM(4);
    if (IN(5)) {
        rotq_rows_i8<2>(WSP(bf16_t, WS_BT2), WSP(unsigned char, WS_BT2Q), WSP(float, WS_SW2), DM, F.wave * F.G + (int)blockIdx.x, F.G * 8, F.lane);
        p5_norms(F, false);
        xcd_barrier(bar);
        rotq_rows_i8<2, true>(WSP(bf16_t, WS_CAT), WSP(unsigned char, WS_CATQ), WSP(float, WS_SA2), M, F.wave * F.G + (int)blockIdx.x, F.G * 8, F.lane, WSP(float, WS_SSQRG)); } SEAM(5);
    if (IN(6)) { pg8::Gemm g{WSP(bf16_t, WS_CATQ), WSP(bf16_t, WS_BT2Q), M, DM, DM / 2, DM / 2, DM / 2}; pg8::StaticOrder S; S.init(M, DM, F.G, (int)blockIdx.x);
        const bool split = (F.G == 256); if (split) S.limit = REM_FIRST;
        EpiX1Q E{F.in[0], F.in[1], WSP(bf16_t, WS_X1), WSP(float, WS_SA2), WSP(float, WS_SW2)};
        pg8::gemm_phase<EpiX1Q, pg8::GeomPlain, pg8::StaticOrder, true, true>(F.lds, g, S, E);
        if (split) { pg8::Gemm g2{WSP(bf16_t, WS_CATQ), WSP(bf16_t, WS_BT2Q), M, DM, DM / 16, DM / 2, DM / 2}; pg8::SplitOrder S2{S, REM_FIRST, REM_N, (int)blockIdx.x}; EpiPartQ E2{WSP(float, WS_PART), WSP(float, WS_SA2), WSP(float, WS_SW2)};
            pg8::gemm_phase<EpiPartQ, pg8::GeomSplit, pg8::SplitOrder, true, true>(F.lds, g2, S2, E2); } } SEAM(6);
    if (IN(7)) { p7_x1_rows(F);
        quant_rows_i8(WSP(bf16_t, WS_BT3), WSP(unsigned char, WS_BT3Q), ctl + CW_CMAX3, 2 * DFF, DM, (size_t)blockIdx.x * 512 + F.tid, (size_t)F.G * 512);
        if (F.G != 256) rotq_rows_i8(WSP(bf16_t, WS_BT4), WSP(unsigned char, WS_BT4Q), WSP(float, WS_SW4), DM, blockIdx.x * 8 + F.wave, F.G * 8, F.lane); } SEAM(7);
    if (IN(8)) { pg8::Gemm g{WSP(bf16_t, WS_X1B), WSP(bf16_t, WS_BT3Q), M, 2 * DFF, DM / 2, DM / 2, DM / 2}; pg8::StaticOrder S; S.init(M, 2 * DFF, F.G, (int)blockIdx.x);
        EpiUpConv E{WSP(bf16_t, WS_ACT), WSP(float, WS_RF3), ctl + CW_CMAX3, F.out, F.in[26], F.in[27], F.in[6], (LAS float*)(F.lds + RING_BYTES), WSP(unsigned long long, WS_HALO), ctl + CW_HFLAG, ctl + CW_TMO};
        pg8::gemm_phase<EpiUpConv, pg8::GeomPlain, pg8::StaticOrder, true, true>(F.lds, g, S, E);
        if (F.G == 256 && blockIdx.x >= G3_BUSY) rotq_rows_i8(WSP(bf16_t, WS_BT4), WSP(unsigned char, WS_BT4Q), WSP(float, WS_SW4), DM, ((int)blockIdx.x - G3_BUSY) * 8 + F.wave, (256 - G3_BUSY) * 8, F.lane); } SEAM(8);
    if (IN(9)) { rotq_rows_i8(WSP(bf16_t, WS_ACT), WSP(unsigned char, WS_ACTQ), WSP(float, WS_SA4), M, F.wave * F.G + (int)blockIdx.x, F.G * 8, F.lane); } SEAM(9);
    if (IN(10)) { pg8::Gemm g{WSP(bf16_t, WS_ACTQ), WSP(bf16_t, WS_BT4Q), M, DM, DFF / 2, DFF / 2, DFF / 2}; pg8::StaticOrder S; S.init(M, DM, F.G, (int)blockIdx.x);
        const bool split = (F.G == 256); if (split) S.limit = REM_FIRST;
        EpiX2 E{WSP(bf16_t, WS_X1), WSP(bf16_t, WS_X2B), WSP(float, WS_SA4), WSP(float, WS_SW4)};
        pg8::gemm_phase<EpiX2, pg8::GeomPlain, pg8::StaticOrder, true, true>(F.lds, g, S, E);
        if (split) { pg8::Gemm g2{WSP(bf16_t, WS_ACTQ), WSP(bf16_t, WS_BT4Q), M, DM, DFF / 16, DFF / 2, DFF / 2}; pg8::SplitOrder S2{S, REM_FIRST, REM_N, (int)blockIdx.x}; EpiPartQ E2{WSP(float, WS_PART), WSP(float, WS_SA4), WSP(float, WS_SW4)};
            pg8::gemm_phase<EpiPartQ, pg8::GeomSplit, pg8::SplitOrder, true, true>(F.lds, g2, S2, E2); } } SEAM(10);
    if (IN(11)) { p_final(F); }
#undef IN
#undef SEAM
}

extern "C" void kernel_launch(void* const* d_in, const int* in_sizes, int n_in, void* d_out, int out_size, void* d_ws, size_t ws_size, hipStream_t stream) {
    static int grid = 0;
    if (grid == 0) {
        if (n_in != 30 || (size_t)out_size != O_END || ws_size < WS_END) { fprintf(stderr, "kernel_launch: unexpected shapes (n_in %d out %d ws %zu need %zu)\n", n_in, out_size, ws_size, (size_t)WS_END); grid = -1; return; }
        int dev = 0, cus = 0, per_cu = 0;
        if (hipGetDevice(&dev) != hipSuccess || hipDeviceGetAttribute(&cus, hipDeviceAttributeMultiprocessorCount, dev) != hipSuccess) { grid = -1; return; }
        if (hipFuncSetAttribute((const void*)mk_fwd, hipFuncAttributeMaxDynamicSharedMemorySize, LDS_BYTES) != hipSuccess) { fprintf(stderr, "kernel_launch: hipFuncSetAttribute failed\n"); grid = -1; return; }
        if (hipOccupancyMaxActiveBlocksPerMultiprocessor(&per_cu, (const void*)mk_fwd, 512, LDS_BYTES) != hipSuccess || per_cu < 1) { fprintf(stderr, "kernel_launch: occupancy query says %d\n", per_cu); }
        (void)hipGetLastError();
        grid = cus;
    }
    if (grid < 0) return;
    (void)hipMemsetAsync((char*)d_ws + WS_CTL, 0, CTL_BYTES, stream);
    Args a{};
    for (int i = 0; i < 30; ++i) a.in[i] = (const float*)d_in[i];
    a.out = (float*)d_out; a.ws = (unsigned char*)d_ws;
#if PROBE_HI > PROBE_LO
    { const int cuts[5][3] = {{0, PROBE_HI, 0}, {PROBE_LO, PROBE_HI, 1}, {PROBE_LO, PROBE_HI, 1}, {PROBE_LO, PROBE_HI, 1}, {PROBE_HI, NPH, 0}};
      for (int li = 0; li < 5; ++li) { if (cuts[li][0] >= cuts[li][1]) continue; a.ph_lo = cuts[li][0]; a.ph_hi = cuts[li][1]; a.li = li; a.rep = cuts[li][2];
          hipLaunchKernelGGL(mk_fwd, dim3(grid), dim3(512), LDS_BYTES, stream, a); } }
#else
    a.ph_lo = 0; a.ph_hi = NPH; a.li = 0; a.rep = 0;
    hipLaunchKernelGGL(mk_fwd, dim3(grid), dim3(512), LDS_BYTES, stream, a);
#endif
}
```

```cpp
#include <hip/hip_runtime.h>
#include <cstdio>
#include <cstdint>
#include <cstddef>

#ifndef PROBE_LO
#define PROBE_LO 0
#define PROBE_HI 0
#endif

#define LAS __attribute__((address_space(3)))
#define GAS __attribute__((address_space(1)))
typedef unsigned short bf16_t;
typedef short bf16x8 __attribute__((ext_vector_type(8)));
typedef float f32x4 __attribute__((ext_vector_type(4)));
typedef float f32x2 __attribute__((ext_vector_type(2)));
typedef unsigned u32x4 __attribute__((ext_vector_type(4)));
typedef unsigned u32x2 __attribute__((ext_vector_type(2)));
typedef int i32x4 __attribute__((ext_vector_type(4)));

constexpr int DM = 4096, SEQ = 2048, NB = 4, MP = NB * SEQ, NSQ = 128, DSEQ = 4, MS = NSQ * DSEQ, M = MP + MS;
constexpr int DRNN = 2048, DSSM = 2048, NH = 32, HP = 64, NG = 4, NST = 128, DXBC = 3072, DFF = 12288, INC = 9248;
constexpr int N1P = 9472;
constexpr int C_RGX = 0, C_RGG = 2048, C_Z = 4096, C_XBC = 6144, C_DT = 9216;
constexpr float EPS = 1e-6f;
constexpr int NCH = MP / 128;

constexpr size_t O_Y = 0;
constexpr size_t O_PRGH = (size_t)M * DM;
constexpr size_t O_PRGC = O_PRGH + (size_t)NB * DRNN;
constexpr size_t O_PSH = O_PRGC + (size_t)NB * 3 * DRNN;
constexpr size_t O_PSC = O_PSH + (size_t)NB * NH * HP * NST;
constexpr size_t O_PFC = O_PSC + (size_t)NB * 3 * DXBC;
constexpr size_t O_SRGH = O_PFC + (size_t)NB * 2 * DFF;
constexpr size_t O_SRGC = O_SRGH + (size_t)NSQ * DRNN;
constexpr size_t O_SSH = O_SRGC + (size_t)NSQ * 3 * DRNN;
constexpr size_t O_SSC = O_SSH + (size_t)NSQ * NH * HP * NST;
constexpr size_t O_SFC = O_SSC + (size_t)NSQ * 3 * DXBC;
constexpr size_t O_END = O_SFC + (size_t)NSQ * 2 * DFF;

constexpr size_t al256(size_t x) { return (x + 255) & ~(size_t)255; }
constexpr size_t WS_CTL = 0, CTL_BYTES = 1u << 20;
constexpr size_t WS_BT1 = WS_CTL + CTL_BYTES;
constexpr size_t WS_BT2 = WS_BT1 + al256((size_t)N1P * DM * 2);
constexpr size_t WS_BT3 = WS_BT2 + al256((size_t)DM * DM * 2);
constexpr size_t WS_BT4 = WS_BT3 + al256((size_t)2 * DFF * DM * 2);
constexpr size_t WS_BTG = WS_BT4 + al256((size_t)DM * DFF * 2);
constexpr size_t WS_SP8 = WS_BTG + al256((size_t)16 * 256 * 256 * 2);
constexpr size_t WS_RS1 = WS_SP8 + al256((size_t)DRNN * 4);
constexpr size_t WS_HALO = WS_RS1 + al256((size_t)M * 4);
constexpr size_t WS_RF3 = WS_HALO + al256((size_t)34 * 96 * 2 * 128 * 4);
constexpr size_t WS_DTR = WS_RF3 + al256((size_t)M * 4);
constexpr size_t WS_SA4 = WS_DTR + al256((size_t)M * NH * 4);
constexpr size_t WS_SW4 = WS_SA4 + al256((size_t)M * 4);
constexpr size_t WS_HALO1 = WS_SW4 + al256((size_t)DM * 4);
constexpr size_t WS_CAT = WS_HALO1 + al256((size_t)34 * 37 * 3 * 256 * 4);
constexpr size_t WS_X1 = WS_CAT + al256((size_t)M * DM * 2);
constexpr size_t WS_X2B = WS_X1 + al256((size_t)M * DM * 2);
constexpr size_t WS_X1B = WS_X1 + al256((size_t)M * DM * 4);
constexpr size_t WS_OV = WS_X1B + al256((size_t)M * DM * 2);
constexpr size_t WS_XB = WS_OV;
constexpr size_t WS_PROJ = WS_XB + al256((size_t)M * DM * 2);
constexpr size_t WS_G2 = WS_PROJ;
constexpr size_t WS_XCB = WS_PROJ + al256((size_t)M * INC * 2);
constexpr size_t WS_AB = WS_XCB + al256((size_t)M * DRNN * 2);
constexpr size_t WS_XS = WS_AB + al256((size_t)M * DRNN * 8);
constexpr size_t WS_BC = WS_XS + al256((size_t)M * DSSM * 2);
constexpr size_t WS_XST = WS_BC + al256((size_t)M * 1024 * 2);
constexpr size_t WS_BTT = WS_XST + al256((size_t)NCH * 2048 * 128 * 2);
constexpr size_t WS_DTA = WS_BTT + al256((size_t)NCH * 512 * 128 * 2);
constexpr size_t WS_CUM = WS_DTA + al256((size_t)M * NH * 4);
constexpr size_t WS_YD = WS_CUM + al256((size_t)M * NH * 4);
constexpr size_t WS_ST = WS_YD + al256((size_t)M * DSSM * 4);
constexpr size_t WS_DEC = WS_ST + al256((size_t)NCH * NH * HP * NST * 4);
constexpr size_t WS_HPB = WS_DEC + al256((size_t)NCH * NH * 4);
constexpr size_t WS_SSQRG = WS_HPB + al256((size_t)NCH * NH * HP * NST * 2);
constexpr size_t WS_ENDA = WS_SSQRG + al256((size_t)M * 64 * 4);
constexpr size_t WS_PART = WS_OV;
constexpr size_t WS_GATE = WS_OV;
constexpr size_t WS_VAL = WS_GATE + al256((size_t)M * DFF * 2);
constexpr size_t WS_ACT = WS_VAL + al256((size_t)M * DFF * 2);
constexpr size_t WS_BT3Q = WS_VAL;
constexpr size_t WS_ACTQ = WS_ACT + al256((size_t)M * DFF * 2);
constexpr size_t WS_BT4Q = WS_ACTQ + al256((size_t)M * DFF);
constexpr size_t WS_ENDB = WS_BT4Q + al256((size_t)DM * DFF);
constexpr size_t WS_END0 = WS_ENDA > WS_ENDB ? WS_ENDA : WS_ENDB;
constexpr size_t WS_CATQ = WS_X1B + al256((size_t)M * DM);
constexpr size_t WS_BT2Q = WS_END0;
constexpr size_t WS_SA2 = WS_BT2Q + al256((size_t)DM * DM);
constexpr size_t WS_SW2 = WS_SA2 + al256((size_t)M * 4);
constexpr size_t WS_END = WS_SW2 + al256((size_t)DM * 4);
static_assert(WS_END <= (size_t)1536 * 1024 * 1024, "d_ws map exceeds the guaranteed 1536 MiB");
constexpr int CW_BAR = 1024;
constexpr int CW_SSQ1 = 20480;
constexpr int CW_SSQ2 = CW_SSQ1 + M + 64;
constexpr int CW_HFLAG = CW_SSQ2 + M + 64;
constexpr int CW_HFLAG1 = CW_HFLAG + 34 * 96 + 64;
constexpr int CW_CMAX3 = CW_HFLAG1 + 34 * 37 + 64;
constexpr int CW_CMAX4 = CW_CMAX3 + 2 * DFF;
constexpr int CW_RMAX4 = CW_CMAX4 + DM;
constexpr int CW_DUMMY = CW_RMAX4 + M + 64;
constexpr int CW_TMO = 16;
static_assert((size_t)(CW_DUMMY + M) * 4 <= CTL_BYTES && CW_BAR + 5 * 3456 <= CW_SSQ1, "ctl");
static_assert(((34 * 96) / 8) % 8 == 0 && (34 * 96) % 8 == 0, "up-GEMM unit order: every XCD chunk must start on a sequence-start row panel");

constexpr int RING_BYTES = 131072, LDS_BYTES = 163840, LDSCTL_OFF = LDS_BYTES - 256;

__device__ __forceinline__ unsigned cvt_pk_bf16(float lo, float hi) { unsigned r; asm("v_cvt_pk_bf16_f32 %0, %1, %2" : "=v"(r) : "v"(lo), "v"(hi)); return r; }
__device__ __forceinline__ float bf_lo(unsigned w) { return __uint_as_float(w << 16); }
__device__ __forceinline__ float bf_hi(unsigned w) { return __uint_as_float(w & 0xffff0000u); }
__device__ __forceinline__ float bf2f(bf16_t b) { return __uint_as_float(((unsigned)b) << 16); }
__device__ __forceinline__ f32x4 ld_bf4(const bf16_t* p) { const u32x2 w = *(const u32x2*)p; return (f32x4){bf_lo(w.x), bf_hi(w.x), bf_lo(w.y), bf_hi(w.y)}; }
__device__ __forceinline__ float frcp(float x) { return __builtin_amdgcn_rcpf(x); }
__device__ __forceinline__ float sigmoidf_(float x) { return frcp(1.0f + __expf(-x)); }
__device__ __forceinline__ float siluf_(float x) { return x * sigmoidf_(x); }
__device__ __forceinline__ float gelu_tanh(float x) { const float u = 0.7978845608028654f * (x + 0.044715f * x * x * x); return x * sigmoidf_(2.0f * u); }
__device__ __forceinline__ float softplusf_(float x) { return fmaxf(x, 0.0f) + log1pf(__expf(-fabsf(x))); }
__device__ __forceinline__ float neg_expm1_small(float x, float ehalf  ) {
    const float p = x * (1.0f + x * (0.5f + x * (0.16666667f + x * (0.041666668f + x * (0.008333334f + x * (0.0013888889f + x * 0.0001984127f))))));
    return x > -0.5f ? -p : 1.0f - ehalf * ehalf;
}
__device__ __forceinline__ float wave_sum(float v) {
#pragma unroll
    for (int o = 1; o < 64; o <<= 1) v += __shfl_xor(v, o);
    return v;
}
__device__ __forceinline__ unsigned q8_pack4(float a, float b, float c, float d, float inv) {
    const unsigned ua = __float_as_uint(fmaf(a, inv, 12582912.0f)), ub = __float_as_uint(fmaf(b, inv, 12582912.0f)), uc = __float_as_uint(fmaf(c, inv, 12582912.0f)), ud = __float_as_uint(fmaf(d, inv, 12582912.0f));
    return (ua & 255u) | ((ub & 255u) << 8) | ((uc & 255u) << 16) | (ud << 24);
}
__device__ __forceinline__ u32x4 q8_pack16(const u32x4 lo, const u32x4 hi, float inv) {
    u32x4 o; o.x = q8_pack4(bf_lo(lo.x), bf_hi(lo.x), bf_lo(lo.y), bf_hi(lo.y), inv); o.y = q8_pack4(bf_lo(lo.z), bf_hi(lo.z), bf_lo(lo.w), bf_hi(lo.w), inv);
    o.z = q8_pack4(bf_lo(hi.x), bf_hi(hi.x), bf_lo(hi.y), bf_hi(hi.y), inv); o.w = q8_pack4(bf_lo(hi.z), bf_hi(hi.z), bf_lo(hi.w), bf_hi(hi.w), inv); return o;
}
__device__ __forceinline__ void quant_rows_i8(const bf16_t* src, unsigned char* dst, const unsigned* rmax, int R, int C, size_t gt, size_t NT) {
    const size_t per = (size_t)C / 8, tot = (size_t)R * per;
    for (size_t it0 = gt; it0 < tot; it0 += 8 * NT) { u32x4 w[8]; float inv[8];
#pragma unroll
        for (int k = 0; k < 8; ++k) { const size_t it = it0 + k * NT; if (it < tot) { w[k] = __builtin_nontemporal_load((const u32x4*)(src + it * 8));
                inv[k] = 127.0f / fmaxf(__uint_as_float(rmax[(int)(it / per)]) * 1.004f, 1e-30f); } }
#pragma unroll
        for (int k = 0; k < 8; ++k) { const size_t it = it0 + k * NT; if (it < tot) { u32x2 o; o.x = q8_pack4(bf_lo(w[k].x), bf_hi(w[k].x), bf_lo(w[k].y), bf_hi(w[k].y), inv[k]); o.y = q8_pack4(bf_lo(w[k].z), bf_hi(w[k].z), bf_lo(w[k].w), bf_hi(w[k].w), inv[k]);
                *(u32x2*)(dst + it * 8) = o; } } }
}
__device__ __forceinline__ void fwht32(float (&x)[32]) {
    f32x2 v[16];
#pragma unroll
    for (int i = 0; i < 16; ++i) v[i] = (f32x2){x[2 * i] + x[2 * i + 1], x[2 * i] - x[2 * i + 1]};
#pragma unroll
    for (int h = 1; h < 16; h <<= 1) {
#pragma unroll
        for (int i = 0; i < 16; ++i) if ((i & h) == 0) { const f32x2 a = v[i], b = v[i + h]; v[i] = a + b; v[i + h] = a - b; } }
#pragma unroll
    for (int i = 0; i < 16; ++i) { x[2 * i] = v[i][0]; x[2 * i + 1] = v[i][1]; }
}
template <int NC = 6, bool RGN = false>
__device__ __forceinline__ void rotq_rows_i8(const bf16_t* src, unsigned char* dst, float* scale, int R, int gw, int NGW, int lane, const float* ssq = nullptr) {
    constexpr int RL = 2048 * NC;
    for (int r = gw; r < R; r += NGW) { const bf16_t* sr = src + (size_t)r * RL; u32x4 pk[NC][4]; float mx = 0.f;
        float sq = 0.f; if constexpr (RGN) sq = ssq[(size_t)r * 64 + lane];
#pragma unroll
        for (int i = 0; i < NC; ++i)
#pragma unroll
            for (int q = 0; q < 4; ++q) pk[i][q] = __builtin_nontemporal_load((const u32x4*)(sr + 2048 * i + 8 * (lane + 64 * q)));
#pragma unroll
        for (int i = 0; i < NC; ++i) { float x[32];
#pragma unroll
            for (int q = 0; q < 4; ++q) { const u32x4 w = pk[i][q]; x[8 * q] = bf_lo(w.x); x[8 * q + 1] = bf_hi(w.x); x[8 * q + 2] = bf_lo(w.y); x[8 * q + 3] = bf_hi(w.y); x[8 * q + 4] = bf_lo(w.z); x[8 * q + 5] = bf_hi(w.z); x[8 * q + 6] = bf_lo(w.w); x[8 * q + 7] = bf_hi(w.w); }
            fwht32(x);
            if constexpr (RGN) { if (i == 0) { const float rs = rsqrtf(wave_sum(sq) * (1.0f / DRNN) + EPS);
#pragma unroll
                    for (int e = 0; e < 32; ++e) x[e] *= rs; } }
#pragma unroll
            for (int q = 0; q < 4; ++q) { pk[i][q].x = cvt_pk_bf16(x[8 * q], x[8 * q + 1]); pk[i][q].y = cvt_pk_bf16(x[8 * q + 2], x[8 * q + 3]); pk[i][q].z = cvt_pk_bf16(x[8 * q + 4], x[8 * q + 5]); pk[i][q].w = cvt_pk_bf16(x[8 * q + 6], x[8 * q + 7]); }
#pragma unroll
            for (int e = 0; e < 32; ++e) mx = fmaxf(mx, fabsf(x[e])); }
#pragma unroll
        for (int o = 1; o < 64; o <<= 1) mx = fmaxf(mx, __shfl_xor(mx, o));
        mx = fmaxf(mx * 1.004f, 1e-30f);
        if (lane == 0) scale[r] = mx * (0.17677669529663687f / 127.0f);
        const float inv = 127.0f / mx;
#pragma unroll
        for (int i = 0; i < NC; ++i) { unsigned char* d = dst + (size_t)r * RL + 2048 * i + 8 * lane;
#pragma unroll
            for (int q = 0; q < 4; ++q) { const u32x4 w = pk[i][q]; u32x2 o; o.x = q8_pack4(bf_lo(w.x), bf_hi(w.x), bf_lo(w.y), bf_hi(w.y), inv); o.y = q8_pack4(bf_lo(w.z), bf_hi(w.z), bf_lo(w.w), bf_hi(w.w), inv);
                *(u32x2*)(d + 512 * q) = o; } } }
}
#define FULL_FENCE() do { asm volatile("" ::: "memory"); __builtin_amdgcn_sched_barrier(0); } while (0)
#define LDS_BARRIER() do { asm volatile("s_waitcnt lgkmcnt(0)" ::: "memory"); __builtin_amdgcn_s_barrier(); asm volatile("" ::: "memory"); } while (0)
#define LDS_WAIT() asm volatile("s_waitcnt lgkmcnt(0)" ::: "memory")
#define VM_WAIT() asm volatile("s_waitcnt vmcnt(0)" ::: "memory")

#define XB_TMO      128
#define XB_XCNT(j)  (256  + 64 * (j))
#define XB_XSUB(j)  (1280 + 64 * (j))
#define XB_XGEN(j)  (2304 + 64 * (j))
#define XB_TOP      3328
#define XB_TOPGEN   3392
#define XCD_BAR_WORDS 3456
#define XB_SPIN_CAP (1u << 18)
__device__ __forceinline__ unsigned xb_ld(unsigned* p)              { return __hip_atomic_load(p, __ATOMIC_RELAXED, __HIP_MEMORY_SCOPE_AGENT); }
__device__ __forceinline__ unsigned xb_add(unsigned* p, unsigned v) { return __hip_atomic_fetch_add(p, v, __ATOMIC_RELAXED, __HIP_MEMORY_SCOPE_AGENT); }
__device__ __forceinline__ unsigned xb_xcc_id() { return (unsigned)__builtin_amdgcn_s_getreg((3 << 11) | 20) & 0xFu; }
#define XB_SPIN(cond, bar) do { unsigned _sp = 0; while (cond) { __builtin_amdgcn_s_sleep(1); \
    if ((++_sp & 255u) == 0u) { if (xb_ld(&(bar)[XB_TMO])) break; if (_sp > XB_SPIN_CAP) { atomicAdd(&(bar)[XB_TMO], 1u); break; } } } } while (0)
struct XcdBarrier { unsigned* bar; unsigned x; volatile LAS unsigned* st; };
__device__ __forceinline__ XcdBarrier xcd_barrier_post(unsigned* bar, volatile LAS unsigned* st) {
    XcdBarrier b; b.bar = bar; b.x = xb_xcc_id(); b.st = st;
    if (threadIdx.x == 0) (void)xb_add(&bar[XB_XCNT(b.x)], 1u);
    return b;
}
__device__ __forceinline__ void xcd_barrier_complete(unsigned* bar, unsigned x, unsigned& nloc, unsigned& nx) {
    const unsigned G = gridDim.x * gridDim.y * gridDim.z;
    unsigned sum, cnt, mine, sp = 0u;
    for (;;) {
        sum = 0u; cnt = 0u; mine = 0u;
#pragma unroll
        for (unsigned j = 0; j < 16; ++j) { const unsigned c = xb_ld(&bar[XB_XCNT(j)]); sum += c; cnt += (c > 0u) ? 1u : 0u; mine = (j == x) ? c : mine; }
        if (sum == G) break;
        __builtin_amdgcn_s_sleep(1);
        if ((++sp & 255u) == 0u) { if (xb_ld(&bar[XB_TMO])) break; if (sp > XB_SPIN_CAP) { atomicAdd(&bar[XB_TMO], 1u); break; } }
    }
    nloc = mine > 0u ? mine : 1u; nx = cnt > 0u ? cnt : 1u;
}
__device__ __forceinline__ void xcd_barrier(const XcdBarrier& b) {
    asm volatile("s_waitcnt vmcnt(0)" ::: "memory");
    __syncthreads();
    if (threadIdx.x == 0) {
        unsigned* bar = b.bar;
        __builtin_amdgcn_s_waitcnt(0);
        unsigned nloc = b.st[0], nx = b.st[1];
        if (nloc == 0u) { xcd_barrier_complete(bar, b.x, nloc, nx); b.st[0] = nloc; b.st[1] = nx; }
        const unsigned old = xb_add(&bar[XB_XSUB(b.x)], 1u);
        const unsigned gen = old / nloc;
        if (old + 1u == (gen + 1u) * nloc) {
            __builtin_amdgcn_fence(__ATOMIC_RELEASE, "agent");
            asm volatile("s_waitcnt vmcnt(0)" ::: "memory");
            const unsigned og = xb_add(&bar[XB_TOP], 1u);
            const unsigned tg = og / nx;
            if (og + 1u == (tg + 1u) * nx) xb_add(&bar[XB_TOPGEN], 1u);
            else XB_SPIN(xb_ld(&bar[XB_TOPGEN]) == tg, bar);
            __builtin_amdgcn_fence(__ATOMIC_ACQUIRE, "agent");
            xb_add(&bar[XB_XGEN(b.x)], 1u);
            asm volatile("s_waitcnt vmcnt(0)" ::: "memory");
        } else {
            XB_SPIN(xb_ld(&bar[XB_XGEN(b.x)]) == gen, bar);
            __builtin_amdgcn_fence(__ATOMIC_ACQUIRE, "agent");
            asm volatile("s_waitcnt vmcnt(0)" ::: "memory");
        }
    }
    __syncthreads();
}

namespace pg8 {
constexpr int BM = 256, BK = 64, HALF = 128, HTB = HALF * BK * 2, STAGE_BYTES = 8 * HTB, NXCD = 8, WGM = 8;
__host__ __device__ __forceinline__ int lds_byte(int r, int c) { const int st = (r >> 4) * 2 + (c >> 5), rr = r & 15, cc = c & 31, ob = rr * 64 + cc * 2; return st * 1024 + (ob ^ (((ob >> 9) & 1) << 5)); }
__host__ __device__ __forceinline__ void stage_rc(int b, int& R, int& C) { const int st = b / 1024, sb = b % 1024, swz = sb ^ (((sb >> 9) & 1) << 5); R = (st >> 1) * 16 + swz / 64; C = (st & 1) * 32 + (swz % 64) / 2; }
__host__ __device__ __forceinline__ int perm32(int rho) { const int n = rho >> 4, i = rho & 15; return 8 * (i >> 2) + 4 * n + (i & 3); }
struct Unit { int pm, pn, ks, tl; };
struct Gemm { const bf16_t* A; const bf16_t* Bt; int M, N, K, lda, ldb; };
struct GeomPlain {
    static __device__ __forceinline__ size_t a_off(const Gemm& g, const Unit& u) { return (size_t)u.pm * 256 * g.lda * 2; }
    static __device__ __forceinline__ size_t b_off(const Gemm& g, const Unit& u) { return (size_t)u.pn * 256 * g.ldb * 2; }
};
struct GeomGates {
    static __device__ __forceinline__ size_t a_off(const Gemm& g, const Unit& u) { return ((size_t)u.pm * 256 * g.lda + (size_t)(u.pn >> 1) * 256) * 2; }
    static __device__ __forceinline__ size_t b_off(const Gemm& g, const Unit& u) { return (size_t)u.pn * 256 * g.ldb * 2; }
};
struct StaticOrder {
    int nM, nN, nwg, G, c, limit;
    __host__ __device__ void init(int M, int N, int G_, int c_) { nM = M / BM; nN = N / BM; nwg = nM * nN; G = G_; c = c_; limit = nwg; }
    __host__ __device__ void tile_of(int L, Unit& u) const {
        int wgid = L; { const int q = nwg / NXCD, r = nwg % NXCD, xcd = wgid % NXCD, off = wgid / NXCD; wgid = (xcd < r ? xcd * (q + 1) : r * (q + 1) + (xcd - r) * q) + off; }
        tile_of_wgid(wgid, u);
    }
    __host__ __device__ void tile_of_wgid(int wgid, Unit& u) const {
        const int nig = WGM * nN, gid = wgid / nig, fm = gid * WGM, gsz = (nM - fm) < WGM ? (nM - fm) : WGM;
        u.pm = fm + ((wgid % nig) % gsz); u.pn = (wgid % nig) / gsz; u.ks = 0; u.tl = 0;
    }
    __host__ __device__ bool next(int i, Unit& u) const { const long L = (long)i * G + c; if (L >= limit) return false; tile_of((int)L, u); return true; }
};
struct ChunkOrder {
    StaticOrder base; int per_lo, n_hi;
    __host__ __device__ bool next(int i, Unit& u) const {
        const int G = base.G, c = base.c; int wgid;
        if (per_lo > 0) { const int x = c & 7, j = c >> 3; wgid = i * G + x * per_lo + (x < n_hi ? x : n_hi) + j; } else wgid = i * G + c;
        if (wgid >= base.nwg) return false; base.tile_of_wgid(wgid, u); return true;
    }
};
struct SplitOrder {
    StaticOrder base; int first, nrem, c;
    __host__ __device__ bool next(int i, Unit& u) const { if (i > 0 || c >= nrem * 8) return false; base.tile_of(first + c % nrem, u); u.tl = c % nrem; u.ks = c / nrem; return true; }
};
struct GeomSplit {
    static __device__ __forceinline__ size_t a_off(const Gemm& g, const Unit& u) { return ((size_t)u.pm * 256 * g.lda + (size_t)u.ks * g.K) * 2; }
    static __device__ __forceinline__ size_t b_off(const Gemm& g, const Unit& u) { return ((size_t)u.pn * 256 * g.ldb + (size_t)u.ks * g.K) * 2; }
};

template <class Epi, class Geom, class Sched, bool ALIGN_EPI, bool I8 = false>
__device__ __forceinline__ void gemm_phase(LAS unsigned char* lds, const Gemm g, const Sched& S, const Epi& E) {
    const int tid = threadIdx.x, wid = __builtin_amdgcn_readfirstlane(tid >> 6), lane = tid & 63, wr = wid >> 2, wc = wid & 3, fr = lane & 15, fq = lane >> 4;
    const int K = g.K, nt = K / BK;
    unsigned voffA[2], voffB[2];
#pragma unroll
    for (int i = 0; i < 2; ++i) { int R, C; stage_rc(tid * 16 + i * 8192, R, C); const int Rb = Epi::PERM ? ((R & ~31) + perm32(R & 31)) : R;
        voffA[i] = (unsigned)(R * g.lda + C) * 2u; voffB[i] = (unsigned)(Rb * g.ldb + C) * 2u; }
    const size_t kstep = (size_t)(BK * 2);
    const size_t hsA = (size_t)HALF * g.lda * 2, hsB = (size_t)HALF * g.ldb * 2;
    const unsigned ldsw = (unsigned)wid * 1024u;
    const int aoff = lds_byte(wr * 64 + fr, fq * 8), boff = lds_byte(wc * 32 + fr, fq * 8);
#define PG8_SA(b, h) (((b) * 2 + (h)) * HTB)
#define PG8_SB(b, h) ((4 + (b) * 2 + (h)) * HTB)
#define PG8_STAGE(bufoff, gbase, voff) do { _Pragma("unroll") for (int _i = 0; _i < 2; ++_i) \
        __builtin_amdgcn_global_load_lds((const unsigned*)((const char*)(gbase) + (voff)[_i]), (LAS unsigned*)(lds + (bufoff) + ldsw + _i * 8192), 16, 0, 0); } while (0)
#define PG8_LDA(dst, b, h) do { _Pragma("unroll") for (int m = 0; m < 4; ++m) _Pragma("unroll") for (int k = 0; k < 2; ++k) dst[m][k] = *(const LAS bf16x8*)(lds + PG8_SA(b, h) + aoff + m * 2048 + k * 1024); } while (0)
#define PG8_LDB(dst, b, h) do { _Pragma("unroll") for (int n = 0; n < 2; ++n) _Pragma("unroll") for (int k = 0; k < 2; ++k) dst[n][k] = *(const LAS bf16x8*)(lds + PG8_SB(b, h) + boff + n * 2048 + k * 1024); } while (0)
#define PG8_MMA(ai, bj, At, Bt) do { __builtin_amdgcn_s_setprio(1); _Pragma("unroll") for (int m = 0; m < 4; ++m) _Pragma("unroll") for (int n = 0; n < 2; ++n) _Pragma("unroll") for (int k = 0; k < 2; ++k) { \
        if constexpr (I8) acc[ai][bj][m][n] = __builtin_bit_cast(f32x4, __builtin_amdgcn_mfma_i32_16x16x64_i8(__builtin_bit_cast(i32x4, Bt[n][k]), __builtin_bit_cast(i32x4, At[m][k]), __builtin_bit_cast(i32x4, acc[ai][bj][m][n]), 0, 0, 0)); \
        else acc[ai][bj][m][n] = __builtin_amdgcn_mfma_f32_16x16x32_bf16(Bt[n][k], At[m][k], acc[ai][bj][m][n], 0, 0, 0); } __builtin_amdgcn_s_setprio(0); } while (0)
#define PG8_WAIT_V(n) asm volatile("s_waitcnt vmcnt(" #n ")" ::: "memory")
#define PG8_WAIT_L(n) asm volatile("s_waitcnt lgkmcnt(" #n ")" ::: "memory")
#define PG8_BAR __builtin_amdgcn_s_barrier()
#define PG8_SCHED __builtin_amdgcn_sched_barrier(0)
    Unit cur, nxt; int ui = 0;
    if (!S.next(0, cur)) return;
    f32x4 acc[2][2][4][2];
#pragma unroll
    for (int a = 0; a < 2; ++a)
#pragma unroll
        for (int b = 0; b < 2; ++b)
#pragma unroll
            for (int m = 0; m < 4; ++m)
#pragma unroll
                for (int n = 0; n < 2; ++n) acc[a][b][m][n] = (f32x4){0.f, 0.f, 0.f, 0.f};
    bf16x8 At[4][2], B0[2][2], B1[2][2];
    const char* cA = (const char*)g.A + Geom::a_off(g, cur); const char* cB = (const char*)g.Bt + Geom::b_off(g, cur);
    PG8_STAGE(PG8_SB(0, 0), cB, voffB); PG8_STAGE(PG8_SB(0, 1), cB + hsB, voffB); PG8_STAGE(PG8_SA(0, 0), cA, voffA); PG8_STAGE(PG8_SA(0, 1), cA + hsA, voffA);
    if (wr == 1) PG8_BAR;
    PG8_WAIT_V(2); PG8_BAR;
    PG8_STAGE(PG8_SB(1, 0), cB + kstep, voffB); PG8_STAGE(PG8_SA(1, 0), cA + kstep, voffA); PG8_STAGE(PG8_SB(1, 1), cB + hsB + kstep, voffB);
    PG8_WAIT_V(6); PG8_BAR;
    for (;;) {
        const bool has_next = S.next(ui + 1, nxt);
        const char* nA = has_next ? (const char*)g.A + Geom::a_off(g, nxt) : cA; const char* nB = has_next ? (const char*)g.Bt + Geom::b_off(g, nxt) : cB;
#pragma unroll 1
        for (int t = 0; t < nt; t += 2) {
            const bool last = (t == nt - 2);
            const char* a1 = cA + (size_t)(t + 1) * kstep;
            const char* a2 = last ? nA : cA + (size_t)(t + 2) * kstep; const char* b2 = last ? nB : cB + (size_t)(t + 2) * kstep;
            const char* a3 = a2 + kstep; const char* b3 = b2 + kstep;
            PG8_LDB(B0, 0, 0); PG8_LDB(B1, 0, 1); PG8_SCHED; PG8_LDA(At, 0, 0); PG8_STAGE(PG8_SA(1, 1), a1 + hsA, voffA);
            PG8_WAIT_V(8); PG8_WAIT_L(0); PG8_BAR; PG8_MMA(0, 0, At, B0); PG8_MMA(0, 1, At, B1); PG8_BAR; PG8_SCHED;
            PG8_LDA(At, 0, 1); PG8_STAGE(PG8_SB(0, 0), b2, voffB); PG8_STAGE(PG8_SB(0, 1), b2 + hsB, voffB); PG8_STAGE(PG8_SA(0, 0), a2, voffA);
            PG8_WAIT_V(8); PG8_WAIT_L(0); PG8_BAR; PG8_MMA(1, 0, At, B0); PG8_MMA(1, 1, At, B1); PG8_BAR; PG8_SCHED;
            PG8_LDB(B0, 1, 0); PG8_LDB(B1, 1, 1); PG8_SCHED; PG8_LDA(At, 1, 0); PG8_STAGE(PG8_SA(0, 1), a2 + hsA, voffA);
            PG8_WAIT_V(8); PG8_WAIT_L(0); PG8_BAR; PG8_MMA(0, 0, At, B0); PG8_MMA(0, 1, At, B1); PG8_BAR; PG8_SCHED;
            PG8_LDA(At, 1, 1); PG8_STAGE(PG8_SB(1, 0), b3, voffB); PG8_STAGE(PG8_SB(1, 1), b3 + hsB, voffB); PG8_STAGE(PG8_SA(1, 0), a3, voffA);
            PG8_WAIT_V(8); PG8_WAIT_L(0); PG8_BAR; PG8_MMA(1, 0, At, B0); PG8_MMA(1, 1, At, B1); PG8_BAR; PG8_SCHED;
        }
        if constexpr (ALIGN_EPI) { if (wr == 0) PG8_BAR; }
        E(acc, cur, wr, wc, fr, fq);
        if (!has_next) break;
#pragma unroll
        for (int a = 0; a < 2; ++a)
#pragma unroll
            for (int b = 0; b < 2; ++b)
#pragma unroll
                for (int m = 0; m < 4; ++m)
#pragma unroll
                    for (int n = 0; n < 2; ++n) acc[a][b][m][n] = (f32x4){0.f, 0.f, 0.f, 0.f};
        cur = nxt; cA = nA; cB = nB; ++ui;
        if constexpr (ALIGN_EPI) { if (wr == 1) PG8_BAR; }
    }
    PG8_WAIT_V(0);
    if constexpr (!ALIGN_EPI) { if (wr == 0) PG8_BAR; }
    PG8_BAR;
#undef PG8_SA
#undef PG8_SB
#undef PG8_STAGE
#undef PG8_LDA
#undef PG8_LDB
#undef PG8_MMA
#undef PG8_WAIT_V
#undef PG8_WAIT_L
#undef PG8_BAR
#undef PG8_SCHED
}
}

struct Args { const float* in[30]; float* out; unsigned char* ws; int ph_lo, ph_hi, li, rep; };
struct Frame {
    LAS unsigned char* lds; int tid, lane, wave, G;
    const float* in[30]; float* out; unsigned char* ws;
};
#define WSP(T, off) ((T*)(F.ws + (off)))

__device__ __forceinline__ float dpp_ror1(float v) { return __builtin_bit_cast(float, __builtin_amdgcn_update_dpp(0, __builtin_bit_cast(int, v), 0x121, 0xf, 0xf, false)); }
__device__ __forceinline__ float dpp_ror2(float v) { return __builtin_bit_cast(float, __builtin_amdgcn_update_dpp(0, __builtin_bit_cast(int, v), 0x122, 0xf, 0xf, false)); }
__device__ __forceinline__ float dpp_ror3(float v) { return __builtin_bit_cast(float, __builtin_amdgcn_update_dpp(0, __builtin_bit_cast(int, v), 0x123, 0xf, 0xf, false)); }
struct EpiProjConv {
    static constexpr bool PERM = true;
    unsigned char* wsb; float* out; const float *rgw, *rgb, *sdw, *sdb, *dtb, *st_rg, *st_sd; LAS float* H;
    __device__ __forceinline__ void operator()(f32x4 (&acc)[2][2][4][2], const pg8::Unit& u, int wr, int wc, int fr, int fq) const {
        unsigned char* ws = wsb;
        asm volatile("" : "+v"(fr), "+v"(fq), "+s"(ws));
        const float* rs = (const float*)(ws + WS_RS1); bf16_t* G2 = (bf16_t*)(ws + WS_G2); float* DTA = (float*)(ws + WS_DTA);
        unsigned long long* HALO = (unsigned long long*)(ws + WS_HALO1); unsigned* HFLAG = (unsigned*)(ws + WS_CTL) + CW_HFLAG1; unsigned* tmo = (unsigned*)(ws + WS_CTL) + CW_TMO;
        const int row0 = u.pm * 256 + wr * 64 + fr, cl0 = wc * 32 + 8 * fq, c0 = u.pn * 256 + cl0;
        { float sc[2][4];
#pragma unroll
          for (int ai = 0; ai < 2; ++ai)
#pragma unroll
              for (int m = 0; m < 4; ++m) sc[ai][m] = rs[row0 + ai * 128 + m * 16];
#pragma unroll
          for (int ai = 0; ai < 2; ++ai)
#pragma unroll
              for (int m = 0; m < 4; ++m)
#pragma unroll
                  for (int bj = 0; bj < 2; ++bj) { acc[ai][bj][m][0] *= sc[ai][m]; acc[ai][bj][m][1] *= sc[ai][m]; } }
        const int pn = u.pn;
        if (pn >= 8 && pn < 24) {
#pragma unroll
            for (int ai = 0; ai < 2; ++ai)
#pragma unroll
                for (int m = 0; m < 4; ++m) { const int row = row0 + ai * 128 + m * 16;
#pragma unroll
                    for (int bj = 0; bj < 2; ++bj) { f32x4 v0 = acc[ai][bj][m][0], v1 = acc[ai][bj][m][1];
                        if (pn < 16) { v0 = (f32x4){gelu_tanh(v0[0]), gelu_tanh(v0[1]), gelu_tanh(v0[2]), gelu_tanh(v0[3])}; v1 = (f32x4){gelu_tanh(v1[0]), gelu_tanh(v1[1]), gelu_tanh(v1[2]), gelu_tanh(v1[3])}; }
                        else { v0 = (f32x4){siluf_(v0[0]), siluf_(v0[1]), siluf_(v0[2]), siluf_(v0[3])}; v1 = (f32x4){siluf_(v1[0]), siluf_(v1[1]), siluf_(v1[2]), siluf_(v1[3])}; }
                        u32x4 w; w.x = cvt_pk_bf16(v0[0], v0[1]); w.y = cvt_pk_bf16(v0[2], v0[3]); w.z = cvt_pk_bf16(v1[0], v1[1]); w.w = cvt_pk_bf16(v1[2], v1[3]);
                        *(u32x4*)(G2 + (size_t)row * 4096 + (c0 - C_RGG) + bj * 128) = w; } }
            return; }
        if (pn >= 36) {
            if (wc == 0) { const f32x4 b0 = *(const f32x4*)(dtb + cl0), b1 = *(const f32x4*)(dtb + cl0 + 4);
#pragma unroll
                for (int ai = 0; ai < 2; ++ai)
#pragma unroll
                    for (int m = 0; m < 4; ++m) { const int row = row0 + ai * 128 + m * 16; const f32x4 v0 = acc[ai][0][m][0] + b0, v1 = acc[ai][0][m][1] + b1;
                        float* d = DTA + (size_t)row * NH + cl0;
                        *(f32x4*)d = (f32x4){softplusf_(v0[0]), softplusf_(v0[1]), softplusf_(v0[2]), softplusf_(v0[3])}; *(f32x4*)(d + 4) = (f32x4){softplusf_(v1[0]), softplusf_(v1[1]), softplusf_(v1[2]), softplusf_(v1[3])}; } }
            return; }
        const bool is_rg = pn < 8, prompt = u.pm < MP / 256;
        const int ch0 = is_rg ? c0 : c0 - C_XBC, CW = is_rg ? DRNN : DXBC;
        const float* cw = rgw + (is_rg ? (ptrdiff_t)0 : (sdw - rgw)); const float* cb = rgb + (is_rg ? (ptrdiff_t)0 : (sdb - rgb)); const float* stp = st_rg + (is_rg ? (ptrdiff_t)0 : (st_sd - st_rg));
        if ((u.pm & 7) == 7 || !prompt) {
#pragma unroll
            for (int ai = 0; ai < 2; ++ai)
#pragma unroll
                for (int m = 0; m < 4; ++m) { const int row = row0 + ai * 128 + m * 16; int j = -1; size_t base = 0;
                    if (row < MP) { const int t = row & (SEQ - 1); if (t >= SEQ - 3) { j = t - (SEQ - 3); base = (size_t)(row >> 11) * 3; } }
                    else { const int r = row - MP, t = r & 3; if (t >= 1) { j = t - 1; base = (size_t)(r >> 2) * 3; } }
                    if (j >= 0) { const size_t oo = is_rg ? (row < MP ? O_PRGC : O_SRGC) : (row < MP ? O_PSC : O_SSC); float* so = out + oo + (base + j) * CW + ch0;
#pragma unroll
                        for (int bj = 0; bj < 2; ++bj) { *(f32x4*)(so + bj * 128) = acc[ai][bj][m][0]; *(f32x4*)(so + bj * 128 + 4) = acc[ai][bj][m][1]; } } } }
        const int tile = u.pm * 37 + u.pn;
        if (prompt) {
            if (fr >= 13) {
#pragma unroll
                for (int ai = 0; ai < 2; ++ai)
#pragma unroll
                    for (int bj = 0; bj < 2; ++bj)
#pragma unroll
                        for (int n = 0; n < 2; ++n) *(LAS f32x4*)(H + ((2 * ai + wr) * 3 + (fr - 13)) * 256 + bj * 128 + cl0 + 4 * n) = acc[ai][bj][3][n];
                if (wr == 1 && (u.pm & 7) != 7) { unsigned long long* hp = HALO + ((size_t)tile * 3 + (fr - 13)) * 128 + (cl0 >> 1);
#pragma unroll
                    for (int bj = 0; bj < 2; ++bj)
#pragma unroll
                        for (int n = 0; n < 2; ++n) { const f32x4 g = acc[1][bj][3][n];
                            __hip_atomic_store(hp + bj * 64 + 2 * n, ((unsigned long long)__float_as_uint(g[1]) << 32) | __float_as_uint(g[0]), __ATOMIC_RELAXED, __HIP_MEMORY_SCOPE_AGENT);
                            __hip_atomic_store(hp + bj * 64 + 2 * n + 1, ((unsigned long long)__float_as_uint(g[3]) << 32) | __float_as_uint(g[2]), __ATOMIC_RELAXED, __HIP_MEMORY_SCOPE_AGENT); } }
            }
            if (wr == 1 && (u.pm & 7) != 7) { asm volatile("s_waitcnt vmcnt(0)" ::: "memory");
                if (fr == 0 && fq == 0) __hip_atomic_fetch_add(HFLAG + tile, 1u, __ATOMIC_RELAXED, __HIP_MEMORY_SCOPE_AGENT); }
            asm volatile("s_waitcnt lgkmcnt(0)" ::: "memory"); __builtin_amdgcn_s_barrier(); asm volatile("" ::: "memory");
        }
        const size_t dso = is_rg ? WS_XCB : (ch0 < DSSM ? WS_XS : WS_BC); const int ld = is_rg ? DRNN : (ch0 < DSSM ? DSSM : 1024);
        bf16_t* dst = (bf16_t*)(ws + dso) + (is_rg ? ch0 : (ch0 < DSSM ? ch0 : ch0 - DSSM));
#pragma unroll
        for (int ai = 0; ai < 2; ++ai)
#pragma unroll
            for (int bj = 0; bj < 2; ++bj) {
                f32x4 hal[2];
                hal[0] = hal[1] = (f32x4){0.f, 0.f, 0.f, 0.f};
                if (prompt) { const int b = 2 * ai + wr;
                    if (b >= 1) { if (fr >= 13) {
#pragma unroll
                            for (int n = 0; n < 2; ++n) hal[n] = *(const LAS f32x4*)(H + ((b - 1) * 3 + (fr - 13)) * 256 + bj * 128 + cl0 + 4 * n); } }
                    else if ((u.pm & 7) != 0) { unsigned* fl = HFLAG + (tile - 37); unsigned sp = 0;
                        while ((unsigned)__builtin_amdgcn_readfirstlane(__hip_atomic_load(fl, __ATOMIC_RELAXED, __HIP_MEMORY_SCOPE_AGENT)) < 4u) { __builtin_amdgcn_s_sleep(2);
                            if ((++sp & 1023u) == 0u) { if (__hip_atomic_load(tmo, __ATOMIC_RELAXED, __HIP_MEMORY_SCOPE_AGENT) != 0u) break; if (sp > (1u << 22)) { __hip_atomic_store(tmo, 1u, __ATOMIC_RELAXED, __HIP_MEMORY_SCOPE_AGENT); break; } } }
                        if (fr >= 13) { const unsigned long long* hp = HALO + ((size_t)(tile - 37) * 3 + (fr - 13)) * 128 + (cl0 >> 1) + bj * 64;
#pragma unroll
                            for (int n = 0; n < 2; ++n) { const unsigned long long a2 = __hip_atomic_load(hp + 2 * n, __ATOMIC_RELAXED, __HIP_MEMORY_SCOPE_AGENT), b2 = __hip_atomic_load(hp + 2 * n + 1, __ATOMIC_RELAXED, __HIP_MEMORY_SCOPE_AGENT);
                                hal[n] = (f32x4){__uint_as_float((unsigned)a2), __uint_as_float((unsigned)(a2 >> 32)), __uint_as_float((unsigned)b2), __uint_as_float((unsigned)(b2 >> 32))}; } } } }
#pragma unroll
                for (int n = 0; n < 2; ++n) { const int ch = ch0 + bj * 128 + 4 * n;
                    const f32x4 w0 = *(const f32x4*)(cw + ch), w1 = *(const f32x4*)(cw + CW + ch), w2 = *(const f32x4*)(cw + 2 * CW + ch), w3 = *(const f32x4*)(cw + 3 * CW + ch), bb = *(const f32x4*)(cb + ch);
#pragma unroll
                    for (int m = 0; m < 4; ++m) { const int row = row0 + ai * 128 + m * 16; const f32x4 g = acc[ai][bj][m][n]; f32x4 p1, p2, p3;
                        if (prompt) { const f32x4 gp = (m == 0) ? hal[n] : acc[ai][bj][m > 0 ? m - 1 : 0][n];
#pragma unroll
                            for (int j = 0; j < 4; ++j) { p1[j] = dpp_ror1(fr == 15 ? gp[j] : g[j]); p2[j] = dpp_ror2(fr >= 14 ? gp[j] : g[j]); p3[j] = dpp_ror3(fr >= 13 ? gp[j] : g[j]); } }
                        else { const int t = fr & 3; const float* sp = stp + (size_t)((row - MP) >> 2) * 3 * CW + ch;
                            const f32x4 b0 = *(const f32x4*)sp, b1 = *(const f32x4*)(sp + CW), b2 = *(const f32x4*)(sp + 2 * CW);
#pragma unroll
                            for (int j = 0; j < 4; ++j) { const float r1 = dpp_ror1(g[j]), r2 = dpp_ror2(g[j]), r3 = dpp_ror3(g[j]);
                                p1[j] = t >= 1 ? r1 : b2[j]; p2[j] = t >= 2 ? r2 : (t == 1 ? b2[j] : b1[j]); p3[j] = t >= 3 ? r3 : (t == 2 ? b2[j] : (t == 1 ? b1[j] : b0[j])); } }
                        float o[4];
#pragma unroll
                        for (int j = 0; j < 4; ++j) { const float y = bb[j] + w0[j] * p3[j] + w1[j] * p2[j] + w2[j] * p1[j] + w3[j] * g[j]; o[j] = is_rg ? y : siluf_(y); }
                        u32x2 w; w.x = cvt_pk_bf16(o[0], o[1]); w.y = cvt_pk_bf16(o[2], o[3]);
                        *(u32x2*)(dst + (size_t)row * ld + bj * 128 + 4 * n) = w; }
                    asm volatile("" ::: "memory"); } }
    }
};
struct EpiGates {
    static constexpr bool PERM = false;
    unsigned* AB; const bf16_t* XCB; const float *ba, *bi, *sp8;
    __device__ __forceinline__ void operator()(const f32x4 (&acc)[2][2][4][2], const pg8::Unit& u, int wr, int wc, int fr, int fq) const {
        const int row0 = u.pm * 256 + wr * 64 + fr, ch0 = (u.pn >> 1) * 256 + (u.pn & 1) * 128 + wc * 32 + 4 * fq;
        const unsigned base = (unsigned)row0 * DRNN + ch0;
        u32x2 xw[2][2][4]; f32x4 bav[2], biv[2], spv[2];
#pragma unroll
        for (int n = 0; n < 2; ++n) { const int ch = ch0 + n * 16; bav[n] = *(const f32x4*)(ba + ch); biv[n] = *(const f32x4*)(bi + ch); spv[n] = *(const f32x4*)(sp8 + ch);
#pragma unroll
            for (int ai = 0; ai < 2; ++ai)
#pragma unroll
                for (int m = 0; m < 4; ++m) xw[n][ai][m] = *(const u32x2*)((const char*)XCB + (size_t)((base + (unsigned)((ai * 128 + m * 16) * DRNN + n * 16)) * 2u)); }
#pragma unroll
        for (int n = 0; n < 2; ++n) {
#pragma unroll
            for (int ai = 0; ai < 2; ++ai)
#pragma unroll
                for (int m = 0; m < 4; ++m) { const unsigned off = base + (unsigned)((ai * 128 + m * 16) * DRNN + n * 16);
                    const u32x2 x2 = xw[n][ai][m];
                    const float xc[4] = {bf_lo(x2.x), bf_hi(x2.x), bf_lo(x2.y), bf_hi(x2.y)};
                    const f32x4 r4 = acc[ai][0][m][n] + bav[n], i4 = acc[ai][1][m][n] + biv[n];
                    float av[4], bv[4];
#pragma unroll
                    for (int j = 0; j < 4; ++j) { const float gr = sigmoidf_(r4[j]), gi = sigmoidf_(i4[j]); const float la = -gr * spv[n][j];
                        av[j] = __expf(la); bv[j] = __builtin_amdgcn_sqrtf(neg_expm1_small(2.0f * la, av[j])) * gi * xc[j]; }
                    u32x4 pk; pk.x = cvt_pk_bf16(1.0f - av[0], bv[0]); pk.y = cvt_pk_bf16(1.0f - av[1], bv[1]); pk.z = cvt_pk_bf16(1.0f - av[2], bv[2]); pk.w = cvt_pk_bf16(1.0f - av[3], bv[3]);
                    *(u32x4*)((char*)AB + (size_t)off * 4u) = pk; } }
    }
};
struct EpiX1 {
    static constexpr bool PERM = true;
    const float *xp, *xs; bf16_t* X1;
    __device__ __forceinline__ void operator()(const f32x4 (&acc)[2][2][4][2], const pg8::Unit& u, int wr, int wc, int fr, int fq) const {
        const int row0 = u.pm * 256 + wr * 64 + fr, col0 = u.pn * 256 + wc * 32 + 8 * fq;
#pragma unroll
        for (int am = 0; am < 4; ++am) { const int ai = am >> 1, m0 = 2 * (am & 1); f32x4 r[2][2][2];
#pragma unroll
            for (int mm = 0; mm < 2; ++mm) { const int row = row0 + ai * 128 + (m0 + mm) * 16; const float* xin = (row < MP ? xp + (size_t)row * DM : xs + (size_t)(row - MP) * DM) + col0;
#pragma unroll
                for (int bj = 0; bj < 2; ++bj)
#pragma unroll
                    for (int n = 0; n < 2; ++n) r[mm][bj][n] = *(const f32x4*)(xin + bj * 128 + 4 * n); }
#pragma unroll
            for (int mm = 0; mm < 2; ++mm) { bf16_t* o = X1 + (size_t)(row0 + ai * 128 + (m0 + mm) * 16) * DM + col0;
#pragma unroll
                for (int bj = 0; bj < 2; ++bj) { const f32x4 v0 = acc[ai][bj][m0 + mm][0] + r[mm][bj][0], v1 = acc[ai][bj][m0 + mm][1] + r[mm][bj][1];
                    u32x4 w; w.x = cvt_pk_bf16(v0[0], v0[1]); w.y = cvt_pk_bf16(v0[2], v0[3]); w.z = cvt_pk_bf16(v1[0], v1[1]); w.w = cvt_pk_bf16(v1[2], v1[3]);
                    *(u32x4*)(o + bj * 128) = w; } } }
    }
};
struct EpiUpConv {
    static constexpr bool PERM = true;
    bf16_t* ACT; const float* rf; const unsigned* cmax; float* out; const float *cw, *cb, *stf; LAS float* H; unsigned long long* HALO; unsigned* HFLAG; unsigned* tmo;
    __device__ __forceinline__ void operator()(f32x4 (&acc)[2][2][4][2], const pg8::Unit& u, int wr, int wc, int fr, int fq) const {
        const int row0 = u.pm * 256 + wr * 64 + fr, cl0 = wc * 32 + 8 * fq, ch0 = u.pn * 128 + cl0;
        float sc[2][4];
#pragma unroll
        for (int ai = 0; ai < 2; ++ai)
#pragma unroll
            for (int m = 0; m < 4; ++m) sc[ai][m] = rf[row0 + ai * 128 + m * 16];
        {
            f32x4 sw[2][2];
#pragma unroll
            for (int bj = 0; bj < 2; ++bj)
#pragma unroll
                for (int n = 0; n < 2; ++n) { const u32x4 c = *(const u32x4*)(cmax + u.pn * 256 + bj * 128 + cl0 + 4 * n); sw[bj][n] = (f32x4){__uint_as_float(c.x), __uint_as_float(c.y), __uint_as_float(c.z), __uint_as_float(c.w)} * (1.004f / 127.0f); }
#pragma unroll
            for (int ai = 0; ai < 2; ++ai)
#pragma unroll
                for (int m = 0; m < 4; ++m)
#pragma unroll
                    for (int bj = 0; bj < 2; ++bj)
#pragma unroll
                        for (int n = 0; n < 2; ++n) { const i32x4 q = __builtin_bit_cast(i32x4, acc[ai][bj][m][n]); acc[ai][bj][m][n] = (f32x4){(float)q[0], (float)q[1], (float)q[2], (float)q[3]} * sw[bj][n] * sc[ai][m]; }
        }
        if ((u.pm & 7) == 7 || u.pm >= MP / 256) {
#pragma unroll
            for (int ai = 0; ai < 2; ++ai)
#pragma unroll
                for (int m = 0; m < 4; ++m) { const int row = row0 + ai * 128 + m * 16; float* so = nullptr;
                    if (row < MP) { const int t = row & (SEQ - 1); if (t >= SEQ - 2) so = out + O_PFC + ((size_t)(row >> 11) * 2 + (t - (SEQ - 2))) * DFF + ch0; }
                    else { const int r = row - MP, t = r & 3; if (t >= 2) so = out + O_SFC + ((size_t)(r >> 2) * 2 + (t - 2)) * DFF + ch0; }
                    if (so) { *(f32x4*)so = acc[ai][0][m][0]; *(f32x4*)(so + 4) = acc[ai][0][m][1]; } } }
        const bool prompt = u.pm < MP / 256;
        if (prompt) {
            if (fr >= 14) {
#pragma unroll
                for (int ai = 0; ai < 2; ++ai)
#pragma unroll
                    for (int n = 0; n < 2; ++n) *(LAS f32x4*)(H + ((2 * ai + wr) * 2 + (fr - 14)) * 128 + cl0 + 4 * n) = acc[ai][0][3][n];
                if (wr == 1 && (u.pm & 7) != 7) { unsigned long long* hp = HALO + ((size_t)(u.pm * 96 + u.pn) * 2 + (fr - 14)) * 64 + (cl0 >> 1);
#pragma unroll
                    for (int n = 0; n < 2; ++n) { const f32x4 g = acc[1][0][3][n];
                        __hip_atomic_store(hp + 2 * n, ((unsigned long long)__float_as_uint(g[1]) << 32) | __float_as_uint(g[0]), __ATOMIC_RELAXED, __HIP_MEMORY_SCOPE_AGENT);
                        __hip_atomic_store(hp + 2 * n + 1, ((unsigned long long)__float_as_uint(g[3]) << 32) | __float_as_uint(g[2]), __ATOMIC_RELAXED, __HIP_MEMORY_SCOPE_AGENT); } }
            }
            if (wr == 1 && (u.pm & 7) != 7) { asm volatile("s_waitcnt vmcnt(0)" ::: "memory");
                if (fr == 0 && fq == 0) __hip_atomic_fetch_add(HFLAG + u.pm * 96 + u.pn, 1u, __ATOMIC_RELAXED, __HIP_MEMORY_SCOPE_AGENT); }
            asm volatile("s_waitcnt lgkmcnt(0)" ::: "memory"); __builtin_amdgcn_s_barrier(); asm volatile("" ::: "memory");
        }
#pragma unroll
        for (int ai = 0; ai < 2; ++ai) {
            f32x4 hal[2]; hal[0] = hal[1] = (f32x4){0.f, 0.f, 0.f, 0.f};
            if (prompt) { const int b = 2 * ai + wr;
                if (b >= 1) { if (fr >= 14) {
#pragma unroll
                        for (int n = 0; n < 2; ++n) hal[n] = *(const LAS f32x4*)(H + ((b - 1) * 2 + (fr - 14)) * 128 + cl0 + 4 * n); } }
                else if ((u.pm & 7) != 0) { unsigned* fl = HFLAG + (u.pm - 1) * 96 + u.pn; unsigned sp = 0;
                    while ((unsigned)__builtin_amdgcn_readfirstlane(__hip_atomic_load(fl, __ATOMIC_RELAXED, __HIP_MEMORY_SCOPE_AGENT)) < 4u) { __builtin_amdgcn_s_sleep(2);
                        if ((++sp & 1023u) == 0u) { if (__hip_atomic_load(tmo, __ATOMIC_RELAXED, __HIP_MEMORY_SCOPE_AGENT) != 0u) break; if (sp > (1u << 22)) { __hip_atomic_store(tmo, 1u, __ATOMIC_RELAXED, __HIP_MEMORY_SCOPE_AGENT); break; } } }
                    if (fr >= 14) { const unsigned long long* hp = HALO + ((size_t)((u.pm - 1) * 96 + u.pn) * 2 + (fr - 14)) * 64 + (cl0 >> 1);
#pragma unroll
                        for (int n = 0; n < 2; ++n) { const unsigned long long a = __hip_atomic_load(hp + 2 * n, __ATOMIC_RELAXED, __HIP_MEMORY_SCOPE_AGENT), b2 = __hip_atomic_load(hp + 2 * n + 1, __ATOMIC_RELAXED, __HIP_MEMORY_SCOPE_AGENT);
                            hal[n] = (f32x4){__uint_as_float((unsigned)a), __uint_as_float((unsigned)(a >> 32)), __uint_as_float((unsigned)b2), __uint_as_float((unsigned)(b2 >> 32))}; } } } }
#pragma unroll
            for (int n = 0; n < 2; ++n) {
                const f32x4 w0 = *(const f32x4*)(cw + ch0 + 4 * n), w1 = *(const f32x4*)(cw + DFF + ch0 + 4 * n), w2 = *(const f32x4*)(cw + 2 * DFF + ch0 + 4 * n), bb = *(const f32x4*)(cb + ch0 + 4 * n);
#pragma unroll
                for (int m = 0; m < 4; ++m) { const int row = row0 + ai * 128 + m * 16; const f32x4 g = acc[ai][0][m][n], vv = acc[ai][1][m][n]; f32x4 p1, p2;
                    if (prompt) { const f32x4 gp = (m == 0) ? hal[n] : acc[ai][0][m > 0 ? m - 1 : 0][n];
#pragma unroll
                        for (int j = 0; j < 4; ++j) { p1[j] = dpp_ror1(fr == 15 ? gp[j] : g[j]); p2[j] = dpp_ror2(fr >= 14 ? gp[j] : g[j]); } }
                    else { const int t = fr & 3; const float* sp = stf + (size_t)((row - MP) >> 2) * 2 * DFF + ch0 + 4 * n;
                        f32x4 b0 = (f32x4){0.f, 0.f, 0.f, 0.f}, b1 = b0; if (t == 0) b0 = *(const f32x4*)sp; if (t <= 1) b1 = *(const f32x4*)(sp + DFF);
#pragma unroll
                        for (int j = 0; j < 4; ++j) { const float r1 = dpp_ror1(g[j]), r2 = dpp_ror2(g[j]); p1[j] = t >= 1 ? r1 : b1[j]; p2[j] = t >= 2 ? r2 : (t == 1 ? b1[j] : b0[j]); } }
                    float o[4];
#pragma unroll
                    for (int j = 0; j < 4; ++j) { const float y = bb[j] + w0[j] * p2[j] + w1[j] * p1[j] + w2[j] * g[j]; o[j] = gelu_tanh(y) * vv[j]; }
                    u32x2 w; w.x = cvt_pk_bf16(o[0], o[1]); w.y = cvt_pk_bf16(o[2], o[3]);
                    *(u32x2*)(ACT + (size_t)row * DFF + ch0 + 4 * n) = w; } } }
    }
};
struct EpiX2 {
    static constexpr bool PERM = false;
    const bf16_t* X1; bf16_t* X2; const float *sa, *sw;
    __device__ __forceinline__ void operator()(const f32x4 (&acc)[2][2][4][2], const pg8::Unit& u, int wr, int wc, int fr, int fq) const {
        const int row0 = u.pm * 256 + wr * 64 + fr, col0 = u.pn * 256 + wc * 32 + 4 * fq;
        f32x4 swv[2][2];
#pragma unroll
        for (int bj = 0; bj < 2; ++bj)
#pragma unroll
            for (int n = 0; n < 2; ++n) swv[bj][n] = *(const f32x4*)(sw + col0 + bj * 128 + n * 16);
        float sav[2][4];
#pragma unroll
        for (int ai = 0; ai < 2; ++ai)
#pragma unroll
            for (int m = 0; m < 4; ++m) sav[ai][m] = sa[row0 + ai * 128 + m * 16];
#pragma unroll
        for (int am = 0; am < 4; ++am) { const int ai = am >> 1, m0 = 2 * (am & 1); f32x4 r[2][2][2];
#pragma unroll
            for (int mm = 0; mm < 2; ++mm) { const size_t off = (size_t)(row0 + ai * 128 + (m0 + mm) * 16) * DM + col0;
#pragma unroll
                for (int bj = 0; bj < 2; ++bj)
#pragma unroll
                    for (int n = 0; n < 2; ++n) r[mm][bj][n] = ld_bf4(X1 + off + bj * 128 + n * 16); }
#pragma unroll
            for (int mm = 0; mm < 2; ++mm) { const size_t off = (size_t)(row0 + ai * 128 + (m0 + mm) * 16) * DM + col0;
#pragma unroll
                for (int bj = 0; bj < 2; ++bj)
#pragma unroll
                    for (int n = 0; n < 2; ++n) { const i32x4 q = __builtin_bit_cast(i32x4, acc[ai][bj][m0 + mm][n]);
                        const f32x4 v = (f32x4){(float)q[0], (float)q[1], (float)q[2], (float)q[3]} * swv[bj][n] * sav[ai][m0 + mm] + r[mm][bj][n];
                        u32x2 w; w.x = cvt_pk_bf16(v[0], v[1]); w.y = cvt_pk_bf16(v[2], v[3]); *(u32x2*)(X2 + off + bj * 128 + n * 16) = w; } } }
    }
};
struct EpiX1Q {
    static constexpr bool PERM = false;
    const float *xp, *xs; bf16_t* X1; const float *sa, *sw;
    __device__ __forceinline__ void operator()(const f32x4 (&acc)[2][2][4][2], const pg8::Unit& u, int wr, int wc, int fr, int fq) const {
        const int row0 = u.pm * 256 + wr * 64 + fr, col0 = u.pn * 256 + wc * 32 + 4 * fq;
        f32x4 swv[2][2];
#pragma unroll
        for (int bj = 0; bj < 2; ++bj)
#pragma unroll
            for (int n = 0; n < 2; ++n) swv[bj][n] = *(const f32x4*)(sw + col0 + bj * 128 + n * 16);
        float sav[2][4];
#pragma unroll
        for (int ai = 0; ai < 2; ++ai)
#pragma unroll
            for (int m = 0; m < 4; ++m) sav[ai][m] = sa[row0 + ai * 128 + m * 16];
#pragma unroll
        for (int am = 0; am < 4; ++am) { const int ai = am >> 1, m0 = 2 * (am & 1); f32x4 r[2][2][2];
#pragma unroll
            for (int mm = 0; mm < 2; ++mm) { const int row = row0 + ai * 128 + (m0 + mm) * 16; const float* xin = (row < MP ? xp + (size_t)row * DM : xs + (size_t)(row - MP) * DM) + col0;
#pragma unroll
                for (int bj = 0; bj < 2; ++bj)
#pragma unroll
                    for (int n = 0; n < 2; ++n) r[mm][bj][n] = *(const f32x4*)(xin + bj * 128 + n * 16); }
#pragma unroll
            for (int mm = 0; mm < 2; ++mm) { const size_t off = (size_t)(row0 + ai * 128 + (m0 + mm) * 16) * DM + col0;
#pragma unroll
                for (int bj = 0; bj < 2; ++bj)
#pragma unroll
                    for (int n = 0; n < 2; ++n) { const i32x4 q = __builtin_bit_cast(i32x4, acc[ai][bj][m0 + mm][n]);
                        const f32x4 v = (f32x4){(float)q[0], (float)q[1], (float)q[2], (float)q[3]} * swv[bj][n] * sav[ai][m0 + mm] + r[mm][bj][n];
                        u32x2 w; w.x = cvt_pk_bf16(v[0], v[1]); w.y = cvt_pk_bf16(v[2], v[3]); *(u32x2*)(X1 + off + bj * 128 + n * 16) = w; } } }
    }
};
struct EpiPart {
    static constexpr bool PERM = false;
    float* P;
    __device__ __forceinline__ void operator()(const f32x4 (&acc)[2][2][4][2], const pg8::Unit& u, int wr, int wc, int fr, int fq) const {
        float* base = P + ((size_t)(u.tl * 8 + u.ks) << 16) + (size_t)(wr * 64 + fr) * 256 + wc * 32 + 4 * fq;
#pragma unroll
        for (int ai = 0; ai < 2; ++ai)
#pragma unroll
            for (int m = 0; m < 4; ++m)
#pragma unroll
                for (int bj = 0; bj < 2; ++bj)
#pragma unroll
                    for (int n = 0; n < 2; ++n) *(f32x4*)(base + (size_t)(ai * 128 + m * 16) * 256 + bj * 128 + n * 16) = acc[ai][bj][m][n];
    }
};
struct EpiPartQ {
    static constexpr bool PERM = false;
    bf16_t* P; const float *sa, *sw;
    __device__ __forceinline__ void operator()(const f32x4 (&acc)[2][2][4][2], const pg8::Unit& u, int wr, int wc, int fr, int fq) const {
        bf16_t* base = P + ((size_t)(u.tl * 8 + u.ks) << 16) + (size_t)(wr * 64 + fr) * 256 + wc * 32 + 4 * fq;
        const int row0 = u.pm * 256 + wr * 64 + fr, col0 = u.pn * 256 + wc * 32 + 4 * fq;
        f32x4 swv[2][2];
#pragma unroll
        for (int bj = 0; bj < 2; ++bj)
#pragma unroll
            for (int n = 0; n < 2; ++n) swv[bj][n] = *(const f32x4*)(sw + col0 + bj * 128 + n * 16);
#pragma unroll
        for (int ai = 0; ai < 2; ++ai)
#pragma unroll
            for (int m = 0; m < 4; ++m) { const float sav = sa[row0 + ai * 128 + m * 16];
#pragma unroll
                for (int bj = 0; bj < 2; ++bj)
#pragma unroll
                    for (int n = 0; n < 2; ++n) { const i32x4 q = __builtin_bit_cast(i32x4, acc[ai][bj][m][n]);
                        const f32x4 v = (f32x4){(float)q[0], (float)q[1], (float)q[2], (float)q[3]} * swv[bj][n] * sav;
                        u32x2 o; o.x = cvt_pk_bf16(v[0], v[1]); o.y = cvt_pk_bf16(v[2], v[3]);
                        *(u32x2*)(base + (size_t)(ai * 128 + m * 16) * 256 + bj * 128 + n * 16) = o; } }
    }
};

__device__ __forceinline__ void p0_transpose_item(const float* W, int N, int k0, int n0, const float* gk, bf16_t* WT, int ldt, int dst_row0, LAS float* scr, int lane, unsigned* cmax = nullptr) {
    const int lq = lane >> 4, n4 = lane & 15; const bool inb = (n0 + 4 * n4) < N;
    f32x4 v[16];
#pragma unroll
    for (int i = 0; i < 16; ++i) v[i] = inb ? __builtin_nontemporal_load((const f32x4*)(W + (size_t)(k0 + 4 * i + lq) * N + n0 + 4 * n4)) : (f32x4){0.f, 0.f, 0.f, 0.f};
    if (gk) {
#pragma unroll
        for (int i = 0; i < 16; ++i) v[i] *= gk[k0 + 4 * i + lq]; }
#pragma unroll
    for (int i = 0; i < 16; ++i) { const int k = 4 * i + lq; *(LAS f32x4*)(scr + k * 64 + 4 * ((n4 ^ (2 * (k >> 3))) & 15)) = v[i]; }
    LDS_WAIT(); asm volatile("" ::: "memory");
    const int c = lane & 7, np = lane >> 3;
#pragma unroll
    for (int j = 0; j < 8; ++j) { const int n = np + 8 * j; const LAS float* sp = scr + (8 * c) * 64 + 4 * ((((n >> 2) ^ (2 * c)) & 15)) + (n & 3);
        u32x4 o; o.x = cvt_pk_bf16(sp[0 * 64], sp[1 * 64]); o.y = cvt_pk_bf16(sp[2 * 64], sp[3 * 64]); o.z = cvt_pk_bf16(sp[4 * 64], sp[5 * 64]); o.w = cvt_pk_bf16(sp[6 * 64], sp[7 * 64]);
        if (n0 + n < N) *(u32x4*)(WT + (size_t)(dst_row0 + n) * ldt + k0 + 8 * c) = o;
        if (cmax) { float mx = fmaxf(fmaxf(fmaxf(fabsf(sp[0 * 64]), fabsf(sp[1 * 64])), fmaxf(fabsf(sp[2 * 64]), fabsf(sp[3 * 64]))), fmaxf(fmaxf(fabsf(sp[4 * 64]), fabsf(sp[5 * 64])), fmaxf(fabsf(sp[6 * 64]), fabsf(sp[7 * 64]))));
            mx = fmaxf(mx, __shfl_xor(mx, 1)); mx = fmaxf(mx, __shfl_xor(mx, 2)); mx = fmaxf(mx, __shfl_xor(mx, 4));
            if (c == 0) atomicMax(cmax + dst_row0 + n, __float_as_uint(mx)); } }
    LDS_WAIT(); asm volatile("" ::: "memory");
}
__device__ __forceinline__ void p0_late_weights(Frame& F, int gw, int NGW) {
    LAS float* scr = (LAS float*)(F.lds + F.wave * 16384);
    constexpr int I_OUT = (DM / 64) * (DM / 64), I_UP = (DM / 64) * (2 * DFF / 64), I_DN = (DFF / 64) * (DM / 64);
    for (int it = gw; it < I_UP + I_DN + I_OUT; it += NGW) {
        int r = it;
        if (r < I_UP) { const int nblk = 2 * DFF / 64, kb = r / nblk, nb = r % nblk; const int n0 = 64 * nb, half = n0 / DFF, j = n0 % DFF;
            p0_transpose_item(F.in[25], 2 * DFF, 64 * kb, n0, F.in[24], WSP(bf16_t, WS_BT3), DM, (j / 128) * 256 + half * 128 + (j % 128), scr, F.lane, (unsigned*)(F.ws + WS_CTL) + CW_CMAX3); continue; } r -= I_UP;
        if (r < I_DN) { const int nblk = DM / 64, kb = r / nblk, nb = r % nblk; p0_transpose_item(F.in[28], DM, 64 * kb, 64 * nb, nullptr, WSP(bf16_t, WS_BT4), DFF, 64 * nb, scr, F.lane); continue; } r -= I_DN;
        { const int nblk = DM / 64, kb = r / nblk, nb = r % nblk; const int k0 = 64 * kb;
          const float* gk = k0 < DRNN ? F.in[16] : F.in[22] - DRNN;
          p0_transpose_item(F.in[23], DM, k0, 64 * nb, gk, WSP(bf16_t, WS_BT2), DM, 64 * nb, scr, F.lane); }
    }
}
constexpr int G1_PER = 26, G1_HI = 2, NGEMM1 = 8 * G1_PER + G1_HI, NSTREAM = 256 - NGEMM1;
__device__ __forceinline__ void p0_prologue(Frame& F) {
    LAS float* scr = (LAS float*)(F.lds + F.wave * 16384);
    const int gw = F.wave * F.G + blockIdx.x, NGW = F.G * 8;
    constexpr int NB_IN = (INC + 63) / 64;
    constexpr int I_IN = (DM / 64) * NB_IN, I_G = 16 * 4 * 4;
    for (int it = gw; it < I_IN + I_G; it += NGW) {
        int r = it;
        if (r < I_IN) { const int kb = r / NB_IN, nb = r % NB_IN; p0_transpose_item(F.in[8], INC, 64 * kb, 64 * nb, F.in[7], WSP(bf16_t, WS_BT1), DM, 64 * nb, scr, F.lane); continue; } r -= I_IN;
        { const int mat = r / 16, rr = r % 16, kb = rr / 4, nb = rr % 4, gate = mat / 8, h = mat % 8, n0 = 64 * nb, hc = n0 / 128, idx = n0 % 128;
          const float* W = (gate ? F.in[13] : F.in[11]) + (size_t)h * 65536;
          p0_transpose_item(W, 256, 64 * kb, n0, nullptr, WSP(bf16_t, WS_BTG), 256, ((h * 2 + hc) * 2 + gate) * 128 + idx, scr, F.lane); }
    }
    if (F.G != 256) p0_late_weights(F, gw, NGW);
    bf16_t* XB = WSP(bf16_t, WS_XB); float* rs1 = WSP(float, WS_RS1);
    for (int m = gw; m < M; m += NGW) {
        const float* xr = (m < MP ? F.in[0] + (size_t)m * DM : F.in[1] + (size_t)(m - MP) * DM);
        f32x4 v[16]; float ss = 0.f;
#pragma unroll
        for (int j = 0; j < 16; ++j) { v[j] = __builtin_nontemporal_load((const f32x4*)(xr + 4 * (F.lane + 64 * j))); ss += (v[j][0] * v[j][0] + v[j][1] * v[j][1]) + (v[j][2] * v[j][2] + v[j][3] * v[j][3]); }
        ss = wave_sum(ss);
        if (F.lane == 0) rs1[m] = rsqrtf(ss * (1.0f / DM) + EPS);
#pragma unroll
        for (int j = 0; j < 16; ++j) { u32x2 w; w.x = cvt_pk_bf16(v[j][0], v[j][1]); w.y = cvt_pk_bf16(v[j][2], v[j][3]); *(u32x2*)(XB + (size_t)m * DM + 4 * (F.lane + 64 * j)) = w; }
    }
    { float* sp8 = WSP(float, WS_SP8); const int gt = blockIdx.x * 512 + F.tid; if (gt < DRNN) sp8[gt] = 8.0f * softplusf_(-F.in[15][gt]); }
}

constexpr int SI_W = 2048, SI_B = SI_W + 128 * 272, SI_X = SI_B + 128 * 272, SI_XP = 144, SI_END = SI_X + 128 * SI_XP;
static_assert(SI_END <= LDSCTL_OFF, "ssd intra LDS map");
typedef unsigned short u16x4 __attribute__((ext_vector_type(4)));
template <int PITCH>
__device__ __forceinline__ void tr_frags(unsigned a, bf16x8 (&f)[4]) {
    u16x4 r[8];
    asm volatile("ds_read_b64_tr_b16 %0, %8 offset:%9\n\tds_read_b64_tr_b16 %1, %8 offset:%10\n\tds_read_b64_tr_b16 %2, %8 offset:%11\n\tds_read_b64_tr_b16 %3, %8 offset:%12\n\t"
                 "ds_read_b64_tr_b16 %4, %8 offset:%13\n\tds_read_b64_tr_b16 %5, %8 offset:%14\n\tds_read_b64_tr_b16 %6, %8 offset:%15\n\tds_read_b64_tr_b16 %7, %8 offset:%16\n\ts_waitcnt lgkmcnt(0)"
                 : "=&v"(r[0]), "=&v"(r[1]), "=&v"(r[2]), "=&v"(r[3]), "=&v"(r[4]), "=&v"(r[5]), "=&v"(r[6]), "=&v"(r[7])
                 : "v"(a), "n"(0 * PITCH), "n"(4 * PITCH), "n"(32 * PITCH), "n"(36 * PITCH), "n"(64 * PITCH), "n"(68 * PITCH), "n"(96 * PITCH), "n"(100 * PITCH) : "memory");
#pragma unroll
    for (int ks = 0; ks < 4; ++ks) f[ks] = (bf16x8){(short)r[2 * ks][0], (short)r[2 * ks][1], (short)r[2 * ks][2], (short)r[2 * ks][3], (short)r[2 * ks + 1][0], (short)r[2 * ks + 1][1], (short)r[2 * ks + 1][2], (short)r[2 * ks + 1][3]};
}
struct SgPre { u32x4 x[2]; float d0, d1; };
__device__ __forceinline__ void ssd_head_load(Frame& F, SgPre& P, int bc, int hd) {
    const int row0 = bc * 128, tid = F.tid; const bf16_t* XS = WSP(bf16_t, WS_XS); const float* DTA = WSP(float, WS_DTA);
#pragma unroll
    for (int k = 0; k < 2; ++k) { const int id = tid + 512 * k, r = id >> 3, c = id & 7; P.x[k] = *(const u32x4*)(XS + (size_t)(row0 + r) * DSSM + hd * 64 + 8 * c); }
    P.d0 = DTA[(size_t)(row0 + F.lane) * NH + hd]; P.d1 = DTA[(size_t)(row0 + 64 + F.lane) * NH + hd];
}
__device__ __forceinline__ void ssd_group_unit(Frame& F, int bc, int g) {
    LAS float* cumS = (LAS float*)F.lds; LAS float* dtS = cumS + 128; LAS float* decS = dtS + 128;
    LAS bf16_t* Wl = (LAS bf16_t*)(F.lds + SI_W);
    const int row0 = bc * 128, w = F.wave, tid = F.tid, lane = F.lane, li = lane & 15, lq = lane >> 4;
    const unsigned ldsb = (unsigned)(size_t)F.lds;
    const unsigned tq = (unsigned)(8 * lq + (li >> 2)), tp = (unsigned)(4 * (li & 3));
    const bf16_t* BC = WSP(bf16_t, WS_BC);
    SgPre P; ssd_head_load(F, P, bc, 8 * g);
    { u32x4 bq[4];
#pragma unroll
      for (int k = 0; k < 4; ++k) { const int id = tid + 512 * k, r = id >> 4, c = id & 15; bq[k] = *(const u32x4*)(BC + (size_t)(row0 + r) * 1024 + g * 128 + 8 * c); }
      __syncthreads();
#pragma unroll
      for (int k = 0; k < 4; ++k) { const int id = tid + 512 * k, r = id >> 4, c = id & 15; *(LAS u32x4*)(F.lds + SI_B + r * 272 + 16 * c) = bq[k]; } }
    bf16x8 cf[4];
#pragma unroll
    for (int ks = 0; ks < 4; ++ks) cf[ks] = *(const bf16x8*)(BC + (size_t)(row0 + 16 * w + li) * 1024 + 512 + g * 128 + ks * 32 + 8 * lq);
    asm volatile("s_waitcnt lgkmcnt(0)" ::: "memory");
    __syncthreads();
    f32x4 Gr[8];
#pragma unroll
    for (int sb = 0; sb < 8; ++sb) { Gr[sb] = (f32x4){0.f, 0.f, 0.f, 0.f};
        if (sb <= w) {
#pragma unroll
            for (int ks = 0; ks < 4; ++ks) Gr[sb] = __builtin_amdgcn_mfma_f32_16x16x32_bf16(*(const LAS bf16x8*)(F.lds + SI_B + (16 * sb + li) * 272 + (ks * 32 + 8 * lq) * 2), cf[ks], Gr[sb], 0, 0, 0); } }
    bf16x8 btr[4]; tr_frags<272>(ldsb + SI_B + tq * 272 + (16 * w + tp) * 2, btr);
#pragma unroll 1
    for (int hl = 0; hl < 8; ++hl) { const int hd = 8 * g + hl;
        LDS_BARRIER();
#pragma unroll
        for (int k = 0; k < 2; ++k) { const int id = tid + 512 * k, r = id >> 3, c = id & 7; *(LAS u32x4*)(F.lds + SI_X + r * SI_XP + 16 * c) = P.x[k]; }
        if (w == 0) {
            const float A = -__expf(F.in[20][hd]); const float d0 = P.d0, d1 = P.d1;
            float a0 = d0 * A, a1 = d1 * A;
#pragma unroll
            for (int o = 1; o < 64; o <<= 1) { const float t0 = __shfl_up(a0, o), t1 = __shfl_up(a1, o); if (lane >= o) { a0 += t0; a1 += t1; } }
            a1 += __shfl(a0, 63);
            const float last = __shfl(a1, 63);
            cumS[lane] = a0; cumS[64 + lane] = a1; dtS[lane] = d0; dtS[64 + lane] = d1;
            decS[lane] = __expf(last - a0) * d0; decS[64 + lane] = __expf(last - a1) * d1;
            float* CUM = WSP(float, WS_CUM);
            CUM[(size_t)(row0 + lane) * NH + hd] = a0; CUM[(size_t)(row0 + 64 + lane) * NH + hd] = a1;
            if (lane == 0) WSP(float, WS_DEC)[bc * NH + hd] = __expf(last);
        }
        LDS_BARRIER();
        ssd_head_load(F, P, bc, hl < 7 ? hd + 1 : hd);
        bf16x8 xf[4][4];
#pragma unroll
        for (int pb = 0; pb < 4; ++pb) tr_frags<SI_XP>(ldsb + SI_X + tq * SI_XP + (pb * 16 + tp) * 2, xf[pb]);
        { const int t = 16 * w + li; const float cum_t = cumS[t];
#pragma unroll
          for (int sb = 0; sb < 8; ++sb) if (sb <= w) {
              const f32x4 cs = *(const LAS f32x4*)(cumS + 16 * sb + 4 * lq), ds = *(const LAS f32x4*)(dtS + 16 * sb + 4 * lq); float wv[4];
#pragma unroll
              for (int r = 0; r < 4; ++r) { const int s2 = 16 * sb + 4 * lq + r; wv[r] = (s2 <= t) ? Gr[sb][r] * __expf(cum_t - cs[r]) * ds[r] : 0.f; }
              u32x2 pw; pw.x = cvt_pk_bf16(wv[0], wv[1]); pw.y = cvt_pk_bf16(wv[2], wv[3]);
              *(LAS u32x2*)(Wl + t * 136 + 16 * sb + 4 * lq) = pw; }
          if ((w & 1) == 0) *(LAS u32x2*)(Wl + t * 136 + 16 * (w + 1) + 4 * lq) = (u32x2){0u, 0u}; }
        asm volatile("s_waitcnt lgkmcnt(0)" ::: "memory");
        { f32x4 ay[4];
#pragma unroll
          for (int pb = 0; pb < 4; ++pb) ay[pb] = (f32x4){0.f, 0.f, 0.f, 0.f};
          const int nks = (w >> 1) + 1;
#pragma unroll
          for (int ks = 0; ks < 4; ++ks) if (ks < nks) { const bf16x8 wf = *(const LAS bf16x8*)(Wl + (16 * w + li) * 136 + ks * 32 + 8 * lq);
#pragma unroll
              for (int pb = 0; pb < 4; ++pb) ay[pb] = __builtin_amdgcn_mfma_f32_16x16x32_bf16(xf[pb][ks], wf, ay[pb], 0, 0, 0); }
          bf16_t* YD = WSP(bf16_t, WS_YD) + (size_t)(row0 + 16 * w + li) * DSSM + hd * 64 + 4 * lq;
#pragma unroll
          for (int pb = 0; pb < 4; ++pb) { u32x2 o; o.x = cvt_pk_bf16(ay[pb][0], ay[pb][1]); o.y = cvt_pk_bf16(ay[pb][2], ay[pb][3]); *(u32x2*)(YD + pb * 16) = o; } }
        { bf16x8 bt[4];
#pragma unroll
          for (int ks = 0; ks < 4; ++ks) { const u32x4 raw = __builtin_bit_cast(u32x4, btr[ks]);
              const f32x4 d0 = *(const LAS f32x4*)(decS + ks * 32 + 8 * lq), d1 = *(const LAS f32x4*)(decS + ks * 32 + 8 * lq + 4);
              u32x4 sc; sc.x = cvt_pk_bf16(bf_lo(raw.x) * d0[0], bf_hi(raw.x) * d0[1]); sc.y = cvt_pk_bf16(bf_lo(raw.y) * d0[2], bf_hi(raw.y) * d0[3]);
              sc.z = cvt_pk_bf16(bf_lo(raw.z) * d1[0], bf_hi(raw.z) * d1[1]); sc.w = cvt_pk_bf16(bf_lo(raw.w) * d1[2], bf_hi(raw.w) * d1[3]);
              bt[ks] = __builtin_bit_cast(bf16x8, sc); }
          float* ST = WSP(float, WS_ST) + ((size_t)(bc * NH + hd) * 64 + li) * 128 + 16 * w + 4 * lq;
#pragma unroll
          for (int pb = 0; pb < 4; ++pb) { f32x4 as = (f32x4){0.f, 0.f, 0.f, 0.f};
#pragma unroll
              for (int ks = 0; ks < 4; ++ks) as = __builtin_amdgcn_mfma_f32_16x16x32_bf16(bt[ks], xf[pb][ks], as, 0, 0, 0);
              *(f32x4*)(ST + (size_t)pb * 16 * 128) = as; } }
    }
}
__device__ __forceinline__ void ssd_intra_all(Frame& F) {
    for (int u = blockIdx.x; u < NCH * NG; u += F.G) ssd_group_unit(F, u >> 2, u & 3);
    __syncthreads();
}
struct SsPre { f32x4 h0[4]; float dt[4]; bf16_t x[4]; };
struct SsBC { u32x2 bq[4][4], cq[4][4]; };
__device__ __forceinline__ void ssd_sample_load(Frame& F, SsPre& P, int s, int hd) {
    const int tid = F.tid, p = tid >> 3, nq = tid & 7, r0 = MP + 4 * s;
    const float* DTA = WSP(float, WS_DTA); const bf16_t* XS = WSP(bf16_t, WS_XS);
    const float* h0p = F.in[4] + (((size_t)s * NH + hd) * 64 + p) * 128 + 4 * nq;
#pragma unroll
    for (int j = 0; j < 4; ++j) P.h0[j] = __builtin_nontemporal_load((const f32x4*)(h0p + 32 * j));
#pragma unroll
    for (int t = 0; t < 4; ++t) { P.dt[t] = DTA[(size_t)(r0 + t) * NH + hd]; P.x[t] = XS[(size_t)(r0 + t) * DSSM + hd * 64 + p]; }
}
__device__ __forceinline__ void ssd_sample_loadbc(Frame& F, SsBC& Q, int s, int g) {
    const int nq = F.tid & 7, r0 = MP + 4 * s; const bf16_t* BC = WSP(bf16_t, WS_BC);
#pragma unroll
    for (int t = 0; t < 4; ++t) { const bf16_t* br = BC + (size_t)(r0 + t) * 1024 + g * 128 + 4 * nq;
#pragma unroll
        for (int j = 0; j < 4; ++j) { Q.bq[t][j] = *(const u32x2*)(br + 32 * j); Q.cq[t][j] = *(const u32x2*)(br + 512 + 32 * j); } }
}
__device__ __forceinline__ void ssd_sample_compute(Frame& F, const SsPre& P, const SsBC& Q, int s, int hd, const LAS float* scb, const LAS float* atab) {
    const int tid = F.tid, p = tid >> 3, nq = tid & 7, r0 = MP + 4 * s;
    const u32x2 (&bq)[4][4] = Q.bq; const u32x2 (&cq)[4][4] = Q.cq;
    const float A = atab[hd];
    float dt[4], cum[4], x[4]; float run = 0.f;
#pragma unroll
    for (int t = 0; t < 4; ++t) { dt[t] = P.dt[t]; run += dt[t] * A; cum[t] = run; x[t] = bf2f(P.x[t]); }
    float yoff[4];
#pragma unroll
    for (int t = 0; t < 4; ++t) { float a = 0.f;
#pragma unroll
        for (int j = 0; j < 4; ++j) a += (bf_lo(cq[t][j].x) * P.h0[j][0] + bf_hi(cq[t][j].x) * P.h0[j][1]) + (bf_lo(cq[t][j].y) * P.h0[j][2] + bf_hi(cq[t][j].y) * P.h0[j][3]);
        yoff[t] = a; }
#pragma unroll
    for (int o = 1; o < 8; o <<= 1) {
#pragma unroll
        for (int t = 0; t < 4; ++t) yoff[t] += __shfl_xor(yoff[t], o); }
    if (nq == 0) {
        float* YD = WSP(float, WS_YD);
#pragma unroll
        for (int t = 0; t < 4; ++t) { float y = __expf(cum[t]) * yoff[t];
#pragma unroll
            for (int s2 = 0; s2 < 4; ++s2) if (s2 <= t) y += scb[t * (t + 1) / 2 + s2] * __expf(cum[t] - cum[s2]) * dt[s2] * x[s2];
            YD[(size_t)(r0 + t) * DSSM + hd * 64 + p] = y; }
    }
    const float dec3 = __expf(cum[3]); float cx[4];
#pragma unroll
    for (int t = 0; t < 4; ++t) cx[t] = __expf(cum[3] - cum[t]) * dt[t] * x[t];
    float* hp = F.out + O_SSH + (((size_t)s * NH + hd) * 64 + p) * 128 + 4 * nq;
#pragma unroll
    for (int j = 0; j < 4; ++j) { f32x4 hn = P.h0[j] * dec3;
#pragma unroll
        for (int t = 0; t < 4; ++t) { hn[0] += bf_lo(bq[t][j].x) * cx[t]; hn[1] += bf_hi(bq[t][j].x) * cx[t]; hn[2] += bf_lo(bq[t][j].y) * cx[t]; hn[3] += bf_hi(bq[t][j].y) * cx[t]; }
        __builtin_nontemporal_store(hn, (f32x4*)(hp + 32 * j)); }
}
__device__ __forceinline__ void ssd_sample_all(Frame& F) {
    LAS float* atab = (LAS float*)F.lds;
    LAS float* scb = atab + 32;
    if (F.tid < NH) atab[F.tid] = -__expf(F.in[20][F.tid]);
    const bf16_t* BC = WSP(bf16_t, WS_BC);
    int start, count; const int c = blockIdx.x;
    if (F.G == 256) { if (c < 32) { count = 10; start = 10 * c; } else { const int i = c - 32; count = i < 192 ? 17 : 16; start = 320 + (i < 192 ? 17 * i : 17 * 192 + 16 * (i - 192)); } }
    else { const int per = (NSQ * NH + F.G - 1) / F.G; start = c * per; count = NSQ * NH - start; count = count < 0 ? 0 : (count > per ? per : count); }
    SsBC Q; int cur = -1;
#pragma unroll 1
    for (int b0 = 0; b0 < count; b0 += 32) { const int nb = count - b0 < 32 ? count - b0 : 32;
        __syncthreads();
        if (F.tid < nb * 10) { const int k = F.tid / 10, pr = F.tid % 10, u = start + b0 + k;
            const int t = pr < 1 ? 0 : pr < 3 ? 1 : pr < 6 ? 2 : 3, s2 = pr - t * (t + 1) / 2, r0 = MP + 4 * (u >> 5), g = (u & 31) >> 3;
            const bf16_t* cr = BC + (size_t)(r0 + t) * 1024 + 512 + g * 128; const bf16_t* br = BC + (size_t)(r0 + s2) * 1024 + g * 128; float a = 0.f;
#pragma unroll
            for (int q = 0; q < 16; ++q) { const u32x4 cv = *(const u32x4*)(cr + 8 * q), bv = *(const u32x4*)(br + 8 * q);
                a += (bf_lo(cv.x) * bf_lo(bv.x) + bf_hi(cv.x) * bf_hi(bv.x)) + (bf_lo(cv.y) * bf_lo(bv.y) + bf_hi(cv.y) * bf_hi(bv.y)) + (bf_lo(cv.z) * bf_lo(bv.z) + bf_hi(cv.z) * bf_hi(bv.z)) + (bf_lo(cv.w) * bf_lo(bv.w) + bf_hi(cv.w) * bf_hi(bv.w)); }
            scb[k * 16 + pr] = a; }
        __syncthreads();
        SsPre A, B; const int ub = start + b0, ulast = ub + nb - 1;
        ssd_sample_load(F, A, ub >> 5, ub & 31);
        FULL_FENCE();
#pragma unroll 1
        for (int k = 0; k < nb; k += 2) {
            const int u = ub + k, u1 = u + 1 < ulast ? u + 1 : ulast, u2 = u + 2 < ulast ? u + 2 : ulast;
            if ((u >> 3) != cur) { ssd_sample_loadbc(F, Q, u >> 5, (u & 31) >> 3); cur = u >> 3; }
            ssd_sample_load(F, B, u1 >> 5, u1 & 31);
            FULL_FENCE();
            ssd_sample_compute(F, A, Q, u >> 5, u & 31, scb + k * 16, atab);
            FULL_FENCE();
            if (k + 1 < nb) { if ((u1 >> 3) != cur) { ssd_sample_loadbc(F, Q, u1 >> 5, (u1 & 31) >> 3); cur = u1 >> 3; }
                ssd_sample_load(F, A, u2 >> 5, u2 & 31);
                FULL_FENCE();
                ssd_sample_compute(F, B, Q, u1 >> 5, u1 & 31, scb + (k + 1) * 16, atab);
                FULL_FENCE(); }
        }
    }
}
__device__ __forceinline__ void p4_scan(Frame& F) {
    const unsigned* AB = WSP(unsigned, WS_AB); const bf16_t* G2 = WSP(bf16_t, WS_G2); bf16_t* CAT = WSP(bf16_t, WS_CAT); float* SSQ = WSP(float, WS_SSQRG);
    LAS f32x2* carr = (LAS f32x2*)F.lds;
    for (int u = blockIdx.x; u < NB * 64; u += F.G) {
        const int b = u >> 6, slab = u & 63, cl = F.tid & 31, seg = F.tid >> 5, ch = slab * 32 + cl, rowb = b * SEQ + seg * 128;
        float Ap = 1.f, hl = 0.f;
#pragma unroll 1
        for (int tt = 0; tt < 128; tt += 32) { unsigned v[32];
#pragma unroll
            for (int k = 0; k < 32; ++k) v[k] = AB[(size_t)(rowb + tt + k) * DRNN + ch];
#pragma unroll
            for (int k = 0; k < 32; ++k) { const float a = 1.0f - bf_lo(v[k]); Ap *= a; hl = a * hl + bf_hi(v[k]); } }
        __syncthreads();
        carr[seg * 32 + cl] = (f32x2){Ap, hl};
        __syncthreads();
        float h = 0.f;
        for (int s2 = 0; s2 < seg; ++s2) { const f32x2 c = carr[s2 * 32 + cl]; h = c[0] * h + c[1]; }
#pragma unroll 1
        for (int tt = 0; tt < 128; tt += 32) { unsigned v[32]; float gt[32];
#pragma unroll
            for (int k = 0; k < 32; ++k) { v[k] = AB[(size_t)(rowb + tt + k) * DRNN + ch]; gt[k] = bf2f(G2[(size_t)(rowb + tt + k) * 4096 + ch]); }
            float q[32];
#pragma unroll
            for (int k = 0; k < 32; ++k) { h = (1.0f - bf_lo(v[k])) * h + bf_hi(v[k]); const float o = h * gt[k];
                CAT[(size_t)(rowb + tt + k) * DM + ch] = (bf16_t)(cvt_pk_bf16(o, 0.f) & 0xffffu); q[k] = o * o; }
#define SCAN_BFLY(HB) do { const bool up = (cl & (HB)) != 0; _Pragma("unroll") for (int k = 0; k < (HB); ++k) { const float send = up ? q[k] : q[k + (HB)], keep = up ? q[k + (HB)] : q[k]; q[k] = keep + __shfl_xor(send, (HB)); } } while (0)
            SCAN_BFLY(16); SCAN_BFLY(8); SCAN_BFLY(4); SCAN_BFLY(2); SCAN_BFLY(1);
#undef SCAN_BFLY
            SSQ[(size_t)(rowb + tt + cl) * 64 + slab] = q[0]; }
        if (seg == 15) F.out[O_PRGH + (size_t)b * DRNN + ch] = h;
    }
    { const size_t gt = (size_t)blockIdx.x * 512 + F.tid, NT = (size_t)F.G * 512;
      for (size_t it = gt; it < (size_t)NSQ * DRNN; it += NT) { const int s = (int)(it >> 11), ch = (int)(it & 2047); float h = F.in[2][it];
#pragma unroll
          for (int t = 0; t < 4; ++t) { const int row = MP + 4 * s + t; const unsigned v = AB[(size_t)row * DRNN + ch]; h = (1.0f - bf_lo(v)) * h + bf_hi(v);
              const float o = h * bf2f(G2[(size_t)row * 4096 + ch]); CAT[(size_t)row * DM + ch] = (bf16_t)(cvt_pk_bf16(o, 0.f) & 0xffffu);
              const float q = wave_sum(o * o);
              if (F.lane == 0) { SSQ[(size_t)row * 64 + 2 * (ch >> 6)] = q; SSQ[(size_t)row * 64 + 2 * (ch >> 6) + 1] = 0.f; } }
          F.out[O_SRGH + it] = h; } }
    { const float* ST = WSP(float, WS_ST); const float* DEC = WSP(float, WS_DEC); bf16_t* HPB = WSP(bf16_t, WS_HPB);
      const size_t gt = (size_t)blockIdx.x * 512 + F.tid, NT = (size_t)F.G * 512;
      for (size_t it = gt; it < (size_t)NB * NH * 64 * 32; it += NT) { const int b = (int)(it >> 16), rem = (int)(it & 65535), hd = rem >> 11, e = rem & 2047;
          f32x4 h = (f32x4){0.f, 0.f, 0.f, 0.f}; f32x4 stv[16]; float dcv[16];
#pragma unroll
          for (int c = 0; c < 16; ++c) { const int bc = b * 16 + c; stv[c] = __builtin_nontemporal_load((const f32x4*)(ST + ((size_t)(bc * NH + hd) * 8192) + 4 * e)); dcv[c] = DEC[bc * NH + hd]; }
#pragma unroll
          for (int c = 0; c < 16; ++c) { const int bc = b * 16 + c; const size_t o = ((size_t)(bc * NH + hd) * 8192) + 4 * e;
              u32x2 w; w.x = cvt_pk_bf16(h[0], h[1]); w.y = cvt_pk_bf16(h[2], h[3]); *(u32x2*)(HPB + o) = w;
              h = h * dcv[c] + stv[c]; }
          *(f32x4*)(F.out + O_PSH + ((size_t)(b * NH + hd) * 8192) + 4 * e) = h; } }
}

constexpr int P5_HT_OFF = 8 * 16640;
static_assert(P5_HT_OFF + 64 * 272 <= LDSCTL_OFF, "P5 LDS map");
__device__ __forceinline__ void p5_unit(Frame& F, int g, int bc) {
    const int w = F.wave, lane = F.lane, li = lane & 15, lq = lane >> 4, row0 = bc * 128, row = row0 + 16 * w + li;
    const bf16_t* BC = WSP(bf16_t, WS_BC); bf16_t* CAT = WSP(bf16_t, WS_CAT);
    LAS unsigned char* U = F.lds + w * 16640;
    bf16x8 cf[4];
#pragma unroll
    for (int ks = 0; ks < 4; ++ks) cf[ks] = *(const bf16x8*)(BC + (size_t)row * 1024 + 512 + g * 128 + ks * 32 + 8 * lq);
    float ss = 0.f;
    const bf16_t* HPB = WSP(bf16_t, WS_HPB); const bf16_t* XS = WSP(bf16_t, WS_XS); const bf16_t* YD = WSP(bf16_t, WS_YD); const float* CUM = WSP(float, WS_CUM); const bf16_t* G2 = WSP(bf16_t, WS_G2);
    LAS unsigned char* HT = F.lds + P5_HT_OFF;
    u32x4 hq[2];
#pragma unroll
    for (int k = 0; k < 2; ++k) { const int id = F.tid + 512 * k; hq[k] = *(const u32x4*)(HPB + (size_t)(bc * NH + 8 * g) * 8192 + (id >> 4) * 128 + 8 * (id & 15)); }
#pragma unroll 1
    for (int hl = 0; hl < 8; ++hl) { const int hd = 8 * g + hl;
        LDS_BARRIER();
#pragma unroll
        for (int k = 0; k < 2; ++k) { const int id = F.tid + 512 * k; *(LAS u32x4*)(HT + (id >> 4) * 272 + 16 * (id & 15)) = hq[k]; }
        u32x2 yw[4], zw[4], xw[4];
        const float ecr = CUM[(size_t)row * NH + hd], Dh = F.in[21][hd];
#pragma unroll
        for (int pb = 0; pb < 4; ++pb) { const int ch = hd * 64 + pb * 16 + 4 * lq;
            yw[pb] = __builtin_nontemporal_load((const u32x2*)(YD + (size_t)row * DSSM + ch)); zw[pb] = *(const u32x2*)(G2 + (size_t)row * 4096 + 2048 + ch); xw[pb] = *(const u32x2*)(XS + (size_t)row * DSSM + ch); }
        { const int hn = hl < 7 ? hd + 1 : hd;
#pragma unroll
          for (int k = 0; k < 2; ++k) { const int id = F.tid + 512 * k; hq[k] = *(const u32x4*)(HPB + (size_t)(bc * NH + hn) * 8192 + (id >> 4) * 128 + 8 * (id & 15)); } }
        LDS_BARRIER();
        const float ec = __expf(ecr);
#pragma unroll
        for (int pb = 0; pb < 4; ++pb) { f32x4 a = (f32x4){0.f, 0.f, 0.f, 0.f};
#pragma unroll
            for (int ks = 0; ks < 4; ++ks) a = __builtin_amdgcn_mfma_f32_16x16x32_bf16(*(const LAS bf16x8*)(HT + (pb * 16 + li) * 272 + (ks * 32 + 8 * lq) * 2), cf[ks], a, 0, 0, 0);
            const float xv[4] = {bf_lo(xw[pb].x), bf_hi(xw[pb].x), bf_lo(xw[pb].y), bf_hi(xw[pb].y)}; const float zv[4] = {bf_lo(zw[pb].x), bf_hi(zw[pb].x), bf_lo(zw[pb].y), bf_hi(zw[pb].y)}; float v[4];
            const float yv[4] = {bf_lo(yw[pb].x), bf_hi(yw[pb].x), bf_lo(yw[pb].y), bf_hi(yw[pb].y)};
#pragma unroll
            for (int r = 0; r < 4; ++r) { const float y = yv[r] + ec * a[r] + Dh * xv[r]; v[r] = y * zv[r]; ss += v[r] * v[r]; }
            u32x2 o; o.x = cvt_pk_bf16(v[0], v[1]); o.y = cvt_pk_bf16(v[2], v[3]);
            *(LAS u32x2*)(U + li * 1040 + (hl * 64 + pb * 16 + 4 * lq) * 2) = o; }
    }
    ss += __shfl_xor(ss, 16); ss += __shfl_xor(ss, 32);
    const float rs = rsqrtf(ss * (1.0f / 512.0f) + EPS);
    asm volatile("s_waitcnt lgkmcnt(0)" ::: "memory");
#pragma unroll 4
    for (int j = 0; j < 16; ++j) { const float rj = __shfl(rs, j); u32x4 v = *(const LAS u32x4*)(U + j * 1040 + lane * 16);
        v.x = cvt_pk_bf16(bf_lo(v.x) * rj, bf_hi(v.x) * rj); v.y = cvt_pk_bf16(bf_lo(v.y) * rj, bf_hi(v.y) * rj); v.z = cvt_pk_bf16(bf_lo(v.z) * rj, bf_hi(v.z) * rj); v.w = cvt_pk_bf16(bf_lo(v.w) * rj, bf_hi(v.w) * rj);
        *(u32x4*)(CAT + (size_t)(row0 + 16 * w + j) * DM + DRNN + g * 512 + lane * 8) = v; }
    asm volatile("s_waitcnt lgkmcnt(0)" ::: "memory");
}
__device__ __forceinline__ void p5_norms(Frame& F, bool rg_rows) {
    const int gw = F.wave * F.G + blockIdx.x, NGW = F.G * 8;
    if (rg_rows && gw < M) { const float* SSQ = WSP(float, WS_SSQRG); bf16_t* CAT = WSP(bf16_t, WS_CAT);
      const int rlast = gw + ((M - 1 - gw) / NGW) * NGW;
      float qa, qb; u32x4 ca[4], cb[4];
#define P5_RG_LOAD(q_, c_, r_) do { q_ = SSQ[(size_t)(r_) * 64 + F.lane]; _Pragma("unroll") for (int j = 0; j < 4; ++j) c_[j] = *(const u32x4*)(CAT + (size_t)(r_) * DM + 8 * (F.lane + 64 * j)); } while (0)
#define P5_RG_FIN(q_, c_, r_) do { const float rs = rsqrtf(wave_sum(q_) * (1.0f / DRNN) + EPS); _Pragma("unroll") for (int j = 0; j < 4; ++j) { u32x4 v = c_[j]; \
          v.x = cvt_pk_bf16(bf_lo(v.x) * rs, bf_hi(v.x) * rs); v.y = cvt_pk_bf16(bf_lo(v.y) * rs, bf_hi(v.y) * rs); v.z = cvt_pk_bf16(bf_lo(v.z) * rs, bf_hi(v.z) * rs); v.w = cvt_pk_bf16(bf_lo(v.w) * rs, bf_hi(v.w) * rs); \
          *(u32x4*)(CAT + (size_t)(r_) * DM + 8 * (F.lane + 64 * j)) = v; } } while (0)
      P5_RG_LOAD(qa, ca, gw);
#pragma unroll 1
      for (int row = gw; row <= rlast; row += 2 * NGW) {
          const int r1 = row + NGW < rlast ? row + NGW : rlast, r2 = row + 2 * NGW < rlast ? row + 2 * NGW : rlast;
          const bool two = row + NGW <= rlast;
          P5_RG_LOAD(qb, cb, r1);
          FULL_FENCE();
          P5_RG_FIN(qa, ca, row); FULL_FENCE();
          if (two) { P5_RG_LOAD(qa, ca, r2); FULL_FENCE(); P5_RG_FIN(qb, cb, r1); FULL_FENCE(); }
      }
#undef P5_RG_LOAD
#undef P5_RG_FIN
    }
    { const float* YD = WSP(float, WS_YD); const bf16_t* G2 = WSP(bf16_t, WS_G2); const bf16_t* XS = WSP(bf16_t, WS_XS); bf16_t* CAT = WSP(bf16_t, WS_CAT);
      for (int it = gw; it < MS * NG; it += NGW) { const int row = MP + (it >> 2), g = it & 3, ch = g * 512 + 8 * F.lane; const float Dh = F.in[21][ch >> 6];
          const f32x4 y0 = *(const f32x4*)(YD + (size_t)row * DSSM + ch), y1 = *(const f32x4*)(YD + (size_t)row * DSSM + ch + 4);
          const f32x4 z0 = ld_bf4(G2 + (size_t)row * 4096 + 2048 + ch), z1 = ld_bf4(G2 + (size_t)row * 4096 + 2048 + ch + 4);
          const u32x4 xw = *(const u32x4*)(XS + (size_t)row * DSSM + ch);
          const float xv[8] = {bf_lo(xw.x), bf_hi(xw.x), bf_lo(xw.y), bf_hi(xw.y), bf_lo(xw.z), bf_hi(xw.z), bf_lo(xw.w), bf_hi(xw.w)};
          float v[8]; float ss = 0.f;
#pragma unroll
          for (int e = 0; e < 8; ++e) { const float y = (e < 4 ? y0[e & 3] : y1[e & 3]) + Dh * xv[e]; const float z = e < 4 ? z0[e & 3] : z1[e & 3]; v[e] = y * z; ss += v[e] * v[e]; }
          const float rs = rsqrtf(wave_sum(ss) * (1.0f / 512.0f) + EPS);
          u32x4 o; o.x = cvt_pk_bf16(v[0] * rs, v[1] * rs); o.y = cvt_pk_bf16(v[2] * rs, v[3] * rs); o.z = cvt_pk_bf16(v[4] * rs, v[5] * rs); o.w = cvt_pk_bf16(v[6] * rs, v[7] * rs);
          *(u32x4*)(CAT + (size_t)row * DM + DRNN + ch) = o; } }
    for (int u = blockIdx.x; u < NCH * NG; u += F.G) p5_unit(F, u & 3, u >> 2);
}

constexpr int G3_BUSY = ((M / 256) * (2 * DFF / 256)) % 256;
static_assert(G3_BUSY > 0 && G3_BUSY < 256, "up GEMM tail");
constexpr int REM_FIRST = 512, REM_N = 32;
__device__ __forceinline__ void rem_table(Frame& F, LAS signed char* rem) {
    for (int i = F.tid; i < (M / 256) * 16; i += 512) rem[i] = -1;
    __syncthreads();
    if (F.G == 256 && F.tid < REM_N) { pg8::StaticOrder S; S.init(M, DM, F.G, 0); pg8::Unit u; S.tile_of(REM_FIRST + F.tid, u); rem[u.pm * 16 + u.pn] = (signed char)F.tid; }
    __syncthreads();
}
__device__ __forceinline__ void p7_row_load(const bf16_t* X1, int row, int lane, u32x2 (&w)[16]) {
#pragma unroll
    for (int j = 0; j < 16; ++j) w[j] = *(const u32x2*)(X1 + (size_t)row * DM + 256 * j + 4 * lane);
}
__device__ __forceinline__ void p7_row_finish(Frame& F, const LAS signed char* rem, int row, const u32x2 (&w)[16]) {
    const bf16_t* PART = WSP(bf16_t, WS_PART); bf16_t* X1 = WSP(bf16_t, WS_X1); unsigned char* X1Q = WSP(unsigned char, WS_X1B); float* RF3 = WSP(float, WS_RF3);
    bf16_t* xr = X1 + (size_t)row * DM; const float* xin = (row < MP ? F.in[0] + (size_t)row * DM : F.in[1] + (size_t)(row - MP) * DM);
    f32x4 v[16]; float ss = 0.f, mx = 0.f;
#pragma unroll
    for (int j = 0; j < 16; ++j) { const int c = 256 * j + 4 * F.lane; const int tl = rem[(row >> 8) * 16 + j];
        if (tl < 0) v[j] = (f32x4){bf_lo(w[j].x), bf_hi(w[j].x), bf_lo(w[j].y), bf_hi(w[j].y)};
        else { f32x4 a = *(const f32x4*)(xin + c);
#pragma unroll
            for (int ks = 0; ks < 8; ++ks) a += ld_bf4(PART + ((size_t)(tl * 8 + ks) << 16) + (row & 255) * 256 + 4 * F.lane);
            u32x2 q; q.x = cvt_pk_bf16(a[0], a[1]); q.y = cvt_pk_bf16(a[2], a[3]); *(u32x2*)(xr + c) = q;
            v[j] = (f32x4){bf_lo(q.x), bf_hi(q.x), bf_lo(q.y), bf_hi(q.y)}; }
        ss += (v[j][0] * v[j][0] + v[j][1] * v[j][1]) + (v[j][2] * v[j][2] + v[j][3] * v[j][3]);
        mx = fmaxf(mx, fmaxf(fmaxf(fabsf(v[j][0]), fabsf(v[j][1])), fmaxf(fabsf(v[j][2]), fabsf(v[j][3])))); }
    ss = wave_sum(ss);
#pragma unroll
    for (int o = 1; o < 64; o <<= 1) mx = fmaxf(mx, __shfl_xor(mx, o));
    mx = fmaxf(mx, 1e-30f);
    if (F.lane == 0) RF3[row] = rsqrtf(ss * (1.0f / DM) + EPS) * mx * (1.0f / 127.0f);
    const float inv = 127.0f / mx;
#pragma unroll
    for (int j = 0; j < 16; ++j) *(unsigned*)(X1Q + (size_t)row * DM + 256 * j + 4 * F.lane) = q8_pack4(v[j][0], v[j][1], v[j][2], v[j][3], inv);
}
__device__ __forceinline__ void p7_x1_rows(Frame& F) {
    LAS signed char* rem = (LAS signed char*)F.lds; rem_table(F, rem);
    const bf16_t* X1 = WSP(bf16_t, WS_X1);
    const int gw = F.wave * F.G + blockIdx.x, NGW = F.G * 8;
    if (gw >= M) return;
    const int rlast = gw + ((M - 1 - gw) / NGW) * NGW;
    u32x2 wa[16], wb[16];
    p7_row_load(X1, gw, F.lane, wa);
#pragma unroll 1
    for (int row = gw; row <= rlast; row += 2 * NGW) {
        const int r1 = row + NGW < rlast ? row + NGW : rlast, r2 = row + 2 * NGW < rlast ? row + 2 * NGW : rlast;
        p7_row_load(X1, r1, F.lane, wb); FULL_FENCE();
        p7_row_finish(F, rem, row, wa); FULL_FENCE();
        if (row + NGW <= rlast) { p7_row_load(X1, r2, F.lane, wa); FULL_FENCE(); p7_row_finish(F, rem, r1, wb); FULL_FENCE(); }
    }
}
__device__ __forceinline__ void pf_row_finish(Frame& F, const LAS signed char* rem, int row, const u32x2 (&w)[16], const f32x4 (&gfv)[16]) {
    const bf16_t* PART = WSP(bf16_t, WS_PART); const bf16_t* X1 = WSP(bf16_t, WS_X1);
    float* o = F.out + (size_t)row * DM; f32x4 v[16]; float ss = 0.f;
#pragma unroll
    for (int j = 0; j < 16; ++j) { const int c = 256 * j + 4 * F.lane; const int tl = rem[(row >> 8) * 16 + j];
        if (tl < 0) v[j] = (f32x4){bf_lo(w[j].x), bf_hi(w[j].x), bf_lo(w[j].y), bf_hi(w[j].y)};
        else { f32x4 a = ld_bf4(X1 + (size_t)row * DM + c);
#pragma unroll
            for (int ks = 0; ks < 8; ++ks) a += ld_bf4(PART + ((size_t)(tl * 8 + ks) << 16) + (row & 255) * 256 + 4 * F.lane);
            v[j] = a; }
        ss += (v[j][0] * v[j][0] + v[j][1] * v[j][1]) + (v[j][2] * v[j][2] + v[j][3] * v[j][3]); }
    const float rs = rsqrtf(wave_sum(ss) * (1.0f / DM) + EPS);
#pragma unroll
    for (int j = 0; j < 16; ++j) *(f32x4*)(o + 256 * j + 4 * F.lane) = v[j] * rs * gfv[j];
}
__device__ __forceinline__ void p_final(Frame& F) {
    LAS signed char* rem = (LAS signed char*)F.lds; rem_table(F, rem);
    const bf16_t* X2B = WSP(bf16_t, WS_X2B); const float* gf = F.in[29];
    const int gw = F.wave * F.G + blockIdx.x, NGW = F.G * 8;
    if (gw >= M) return;
    f32x4 gfv[16];
#pragma unroll
    for (int j = 0; j < 16; ++j) gfv[j] = *(const f32x4*)(gf + 256 * j + 4 * F.lane);
    const int rlast = gw + ((M - 1 - gw) / NGW) * NGW;
    u32x2 wa[16], wb[16];
    p7_row_load(X2B, gw, F.lane, wa);
#pragma unroll 1
    for (int row = gw; row <= rlast; row += 2 * NGW) {
        const int r1 = row + NGW < rlast ? row + NGW : rlast, r2 = row + 2 * NGW < rlast ? row + 2 * NGW : rlast;
        p7_row_load(X2B, r1, F.lane, wb); FULL_FENCE();
        pf_row_finish(F, rem, row, wa, gfv); FULL_FENCE();
        if (row + NGW <= rlast) { p7_row_load(X2B, r2, F.lane, wa); FULL_FENCE(); pf_row_finish(F, rem, r1, wb, gfv); FULL_FENCE(); }
    }
}

constexpr int NPH = 12;
__global__ void __launch_bounds__(512, 2) mk_fwd(Args args) {
    extern __shared__ __attribute__((aligned(16))) unsigned char lds_raw[];
    Frame F;
    F.lds = (LAS unsigned char*)lds_raw; F.tid = threadIdx.x; F.lane = F.tid & 63; F.wave = __builtin_amdgcn_readfirstlane(F.tid >> 6); F.G = gridDim.x;
#pragma unroll
    for (int i = 0; i < 30; ++i) F.in[i] = args.in[i];
    F.out = args.out; F.ws = args.ws;
    volatile LAS unsigned* MISC = (volatile LAS unsigned*)(F.lds + LDSCTL_OFF);
    if (F.tid < 64) MISC[F.tid] = 0u;
    __syncthreads();
    unsigned* ctl = (unsigned*)(F.ws + WS_CTL);
    XcdBarrier bar = xcd_barrier_post(ctl + CW_BAR + args.li * XCD_BAR_WORDS, MISC + 8);
    const int lo = args.ph_lo, hi = args.ph_hi;
#ifndef PH_MASK
#define PH_MASK 0xfff
#endif
#define IN(k) (((PH_MASK >> (k)) & 1) && lo <= (k) && (k) < hi)
#define SEAM(k) do { if (IN(k) && IN((k) + 1)) xcd_barrier(bar); } while (0)

    if (IN(0)) { p0_prologue(F); } SEAM(0);
    if (IN(1)) {
        const bool roles = (F.G == 256);
        const int x = (int)blockIdx.x & 7, j = (int)blockIdx.x >> 3; const bool is_gemm = !roles || j < G1_PER + (x < G1_HI ? 1 : 0);
        if (!is_gemm) { const int sidx = (j == G1_PER) ? x - G1_HI : (8 - G1_HI) + (j - G1_PER - 1) * 8 + x; p0_late_weights(F, sidx * 8 + F.wave, NSTREAM * 8); }
        else { pg8::Gemm g{WSP(bf16_t, WS_XB), WSP(bf16_t, WS_BT1), M, N1P, DM, DM, DM}; pg8::StaticOrder S0; S0.init(M, N1P, roles ? NGEMM1 : F.G, (int)blockIdx.x);
            pg8::ChunkOrder S{S0, roles ? G1_PER : ((F.G & 7) == 0 ? F.G >> 3 : 0), roles ? G1_HI : 0};
            EpiProjConv E{F.ws, F.out, F.in[9], F.in[10], F.in[17], F.in[18], F.in[19], F.in[3], F.in[5], (LAS float*)(F.lds + RING_BYTES)};
            pg8::gemm_phase<EpiProjConv, pg8::GeomPlain, pg8::ChunkOrder, true>(F.lds, g, S, E); } } SEAM(1);
    if (IN(3)) {
#ifndef P3_REP
#define P3_REP 0
#endif
        { pg8::Gemm g{WSP(bf16_t, WS_XCB), WSP(bf16_t, WS_BTG), M, 16 * 256, 256, DRNN, 256}; pg8::StaticOrder S; S.init(M, 16 * 256, F.G, (int)blockIdx.x);
          EpiGates E{WSP(unsigned, WS_AB), WSP(bf16_t, WS_XCB), F.in[12], F.in[14], WSP(float, WS_SP8)};
          pg8::gemm_phase<EpiGates, pg8::GeomGates, pg8::StaticOrder, true>(F.lds, g, S, E);
          if (P3_REP == 1) { pg8::gemm_phase<EpiGates, pg8::GeomGates, pg8::StaticOrder, true>(F.lds, g, S, E); pg8::gemm_phase<EpiGates, pg8::GeomGates, pg8::StaticOrder, true>(F.lds, g, S, E); pg8::gemm_phase<EpiGates, pg8::GeomGates, pg8::StaticOrder, true>(F.lds, g, S, E); }
        }
        ssd_intra_all(F);
        if (P3_REP == 2) { ssd_intra_all(F); ssd_intra_all(F); ssd_intra_all(F); }
        ssd_sample_all(F);
        if (P3_REP == 3) { ssd_sample_all(F); ssd_sample_all(F); ssd_sample_all(F); }
    } SEAM(3);
    if (IN(4)) { p4_scan(F); } SEAM(4);
    if (IN(5)) {
        rotq_rows_i8<2>(WSP(bf16_t, WS_BT2), WSP(unsigned char, WS_BT2Q), WSP(float, WS_SW2), DM, F.wave * F.G + (int)blockIdx.x, F.G * 8, F.lane);
        p5_norms(F, false);
        xcd_barrier(bar);
        rotq_rows_i8<2, true>(WSP(bf16_t, WS_CAT), WSP(unsigned char, WS_CATQ), WSP(float, WS_SA2), M, F.wave * F.G + (int)blockIdx.x, F.G * 8, F.lane, WSP(float, WS_SSQRG)); } SEAM(5);
    if (IN(6)) { pg8::Gemm g{WSP(bf16_t, WS_CATQ), WSP(bf16_t, WS_BT2Q), M, DM, DM / 2, DM / 2, DM / 2}; pg8::StaticOrder S; S.init(M, DM, F.G, (int)blockIdx.x);
        const bool split = (F.G == 256); if (split) S.limit = REM_FIRST;
        EpiX1Q E{F.in[0], F.in[1], WSP(bf16_t, WS_X1), WSP(float, WS_SA2), WSP(float, WS_SW2)};
        pg8::gemm_phase<EpiX1Q, pg8::GeomPlain, pg8::StaticOrder, true, true>(F.lds, g, S, E);
        if (split) { pg8::Gemm g2{WSP(bf16_t, WS_CATQ), WSP(bf16_t, WS_BT2Q), M, DM, DM / 16, DM / 2, DM / 2}; pg8::SplitOrder S2{S, REM_FIRST, REM_N, (int)blockIdx.x}; EpiPartQ E2{WSP(bf16_t, WS_PART), WSP(float, WS_SA2), WSP(float, WS_SW2)};
            pg8::gemm_phase<EpiPartQ, pg8::GeomSplit, pg8::SplitOrder, true, true>(F.lds, g2, S2, E2); } } SEAM(6);
    if (IN(7)) { p7_x1_rows(F);
        quant_rows_i8(WSP(bf16_t, WS_BT3), WSP(unsigned char, WS_BT3Q), ctl + CW_CMAX3, 2 * DFF, DM, (size_t)blockIdx.x * 512 + F.tid, (size_t)F.G * 512);
        if (F.G != 256) rotq_rows_i8(WSP(bf16_t, WS_BT4), WSP(unsigned char, WS_BT4Q), WSP(float, WS_SW4), DM, blockIdx.x * 8 + F.wave, F.G * 8, F.lane); } SEAM(7);
    if (IN(8)) { pg8::Gemm g{WSP(bf16_t, WS_X1B), WSP(bf16_t, WS_BT3Q), M, 2 * DFF, DM / 2, DM / 2, DM / 2}; pg8::StaticOrder S; S.init(M, 2 * DFF, F.G, (int)blockIdx.x);
        EpiUpConv E{WSP(bf16_t, WS_ACT), WSP(float, WS_RF3), ctl + CW_CMAX3, F.out, F.in[26], F.in[27], F.in[6], (LAS float*)(F.lds + RING_BYTES), WSP(unsigned long long, WS_HALO), ctl + CW_HFLAG, ctl + CW_TMO};
        pg8::gemm_phase<EpiUpConv, pg8::GeomPlain, pg8::StaticOrder, true, true>(F.lds, g, S, E);
        if (F.G == 256 && blockIdx.x >= G3_BUSY) rotq_rows_i8(WSP(bf16_t, WS_BT4), WSP(unsigned char, WS_BT4Q), WSP(float, WS_SW4), DM, ((int)blockIdx.x - G3_BUSY) * 8 + F.wave, (256 - G3_BUSY) * 8, F.lane); } SEAM(8);
    if (IN(9)) { rotq_rows_i8(WSP(bf16_t, WS_ACT), WSP(unsigned char, WS_ACTQ), WSP(float, WS_SA4), M, F.wave * F.G + (int)blockIdx.x, F.G * 8, F.lane); } SEAM(9);
    if (IN(10)) { pg8::Gemm g{WSP(bf16_t, WS_ACTQ), WSP(bf16_t, WS_BT4Q), M, DM, DFF / 2, DFF / 2, DFF / 2}; pg8::StaticOrder S; S.init(M, DM, F.G, (int)blockIdx.x);
        const bool split = (F.G == 256); if (split) S.limit = REM_FIRST;
        EpiX2 E{WSP(bf16_t, WS_X1), WSP(bf16_t, WS_X2B), WSP(float, WS_SA4), WSP(float, WS_SW4)};
        pg8::gemm_phase<EpiX2, pg8::GeomPlain, pg8::StaticOrder, true, true>(F.lds, g, S, E);
        if (split) { pg8::Gemm g2{WSP(bf16_t, WS_ACTQ), WSP(bf16_t, WS_BT4Q), M, DM, DFF / 16, DFF / 2, DFF / 2}; pg8::SplitOrder S2{S, REM_FIRST, REM_N, (int)blockIdx.x}; EpiPartQ E2{WSP(bf16_t, WS_PART), WSP(float, WS_SA4), WSP(float, WS_SW4)};
            pg8::gemm_phase<EpiPartQ, pg8::GeomSplit, pg8::SplitOrder, true, true>(F.lds, g2, S2, E2); } } SEAM(10);
    if (IN(11)) { p_final(F); }
#undef IN
#undef SEAM
}

extern "C" void kernel_launch(void* const* d_in, const int* in_sizes, int n_in, void* d_out, int out_size, void* d_ws, size_t ws_size, hipStream_t stream) {
    static int grid = 0;
    if (grid == 0) {
        if (n_in != 30 || (size_t)out_size != O_END || ws_size < WS_END) { fprintf(stderr, "kernel_launch: unexpected shapes (n_in %d out %d ws %zu need %zu)\n", n_in, out_size, ws_size, (size_t)WS_END); grid = -1; return; }
        int dev = 0, cus = 0, per_cu = 0;
        if (hipGetDevice(&dev) != hipSuccess || hipDeviceGetAttribute(&cus, hipDeviceAttributeMultiprocessorCount, dev) != hipSuccess) { grid = -1; return; }
        if (hipFuncSetAttribute((const void*)mk_fwd, hipFuncAttributeMaxDynamicSharedMemorySize, LDS_BYTES) != hipSuccess) { fprintf(stderr, "kernel_launch: hipFuncSetAttribute failed\n"); grid = -1; return; }
        if (hipOccupancyMaxActiveBlocksPerMultiprocessor(&per_cu, (const void*)mk_fwd, 512, LDS_BYTES) != hipSuccess || per_cu < 1) { fprintf(stderr, "kernel_launch: occupancy query says %d\n", per_cu); }
        (void)hipGetLastError();
        grid = cus;
    }
    if (grid < 0) return;
    (void)hipMemsetAsync((char*)d_ws + WS_CTL, 0, CTL_BYTES, stream);
    Args a{};
    for (int i = 0; i < 30; ++i) a.in[i] = (const float*)d_in[i];
    a.out = (float*)d_out; a.ws = (unsigned char*)d_ws;
#if PROBE_HI > PROBE_LO
    { const int cuts[5][3] = {{0, PROBE_HI, 0}, {PROBE_LO, PROBE_HI, 1}, {PROBE_LO, PROBE_HI, 1}, {PROBE_LO, PROBE_HI, 1}, {PROBE_HI, NPH, 0}};
      for (int li = 0; li < 5; ++li) { if (cuts[li][0] >= cuts[li][1]) continue; a.ph_lo = cuts[li][0]; a.ph_hi = cuts[li][1]; a.li = li; a.rep = cuts[li][2];
          hipLaunchKernelGGL(mk_fwd, dim3(grid), dim3(512), LDS_BYTES, stream, a); } }
#else
    a.ph_lo = 0; a.ph_hi = NPH; a.li = 0; a.rep = 0;
    hipLaunchKernelGGL(mk_fwd, dim3(grid), dim3(512), LDS_BYTES, stream, a);
#endif
}
```

```cpp
#include <hip/hip_runtime.h>
#include <cstdio>
#include <cstdint>
#include <cstddef>

#ifndef PROBE_LO
#define PROBE_LO 0
#define PROBE_HI 0
#endif

#define LAS __attribute__((address_space(3)))
#define GAS __attribute__((address_space(1)))
typedef unsigned short bf16_t;
typedef short bf16x8 __attribute__((ext_vector_type(8)));
typedef float f32x4 __attribute__((ext_vector_type(4)));
typedef float f32x2 __attribute__((ext_vector_type(2)));
typedef unsigned u32x4 __attribute__((ext_vector_type(4)));
typedef unsigned u32x2 __attribute__((ext_vector_type(2)));
typedef int i32x4 __attribute__((ext_vector_type(4)));

constexpr int DM = 4096, SEQ = 2048, NB = 4, MP = NB * SEQ, NSQ = 128, DSEQ = 4, MS = NSQ * DSEQ, M = MP + MS;
constexpr int DRNN = 2048, DSSM = 2048, NH = 32, HP = 64, NG = 4, NST = 128, DXBC = 3072, DFF = 12288, INC = 9248;
constexpr int N1P = 9472;
constexpr int C_RGX = 0, C_RGG = 2048, C_Z = 4096, C_XBC = 6144, C_DT = 9216;
constexpr float EPS = 1e-6f;
constexpr int NCH = MP / 128;

constexpr size_t O_Y = 0;
constexpr size_t O_PRGH = (size_t)M * DM;
constexpr size_t O_PRGC = O_PRGH + (size_t)NB * DRNN;
constexpr size_t O_PSH = O_PRGC + (size_t)NB * 3 * DRNN;
constexpr size_t O_PSC = O_PSH + (size_t)NB * NH * HP * NST;
constexpr size_t O_PFC = O_PSC + (size_t)NB * 3 * DXBC;
constexpr size_t O_SRGH = O_PFC + (size_t)NB * 2 * DFF;
constexpr size_t O_SRGC = O_SRGH + (size_t)NSQ * DRNN;
constexpr size_t O_SSH = O_SRGC + (size_t)NSQ * 3 * DRNN;
constexpr size_t O_SSC = O_SSH + (size_t)NSQ * NH * HP * NST;
constexpr size_t O_SFC = O_SSC + (size_t)NSQ * 3 * DXBC;
constexpr size_t O_END = O_SFC + (size_t)NSQ * 2 * DFF;

constexpr size_t al256(size_t x) { return (x + 255) & ~(size_t)255; }
constexpr size_t WS_CTL = 0, CTL_BYTES = 1u << 20;
constexpr size_t WS_BT1 = WS_CTL + CTL_BYTES;
constexpr size_t WS_BT2 = WS_BT1 + al256((size_t)N1P * DM * 2);
constexpr size_t WS_BT3 = WS_BT2 + al256((size_t)DM * DM * 2);
constexpr size_t WS_BT4 = WS_BT3 + al256((size_t)2 * DFF * DM * 2);
constexpr size_t WS_BTG = WS_BT4 + al256((size_t)DM * DFF * 2);
constexpr size_t WS_SP8 = WS_BTG + al256((size_t)16 * 256 * 256 * 2);
constexpr size_t WS_RS1 = WS_SP8 + al256((size_t)DRNN * 4);
constexpr size_t WS_HALO = WS_RS1 + al256((size_t)M * 4);
constexpr size_t WS_RF3 = WS_HALO + al256((size_t)34 * 96 * 2 * 128 * 4);
constexpr size_t WS_DTR = WS_RF3 + al256((size_t)M * 4);
constexpr size_t WS_SA4 = WS_DTR + al256((size_t)M * NH * 4);
constexpr size_t WS_SW4 = WS_SA4 + al256((size_t)M * 4);
constexpr size_t WS_HALO1 = WS_SW4 + al256((size_t)DM * 4);
constexpr size_t WS_CAT = WS_HALO1 + al256((size_t)34 * 37 * 3 * 256 * 4);
constexpr size_t WS_X1 = WS_CAT + al256((size_t)M * DM * 2);
constexpr size_t WS_X2B = WS_X1 + al256((size_t)M * DM * 2);
constexpr size_t WS_X1B = WS_X1 + al256((size_t)M * DM * 4);
constexpr size_t WS_OV = WS_X1B + al256((size_t)M * DM * 2);
constexpr size_t WS_XB = WS_OV;
constexpr size_t WS_PROJ = WS_XB + al256((size_t)M * DM * 2);
constexpr size_t WS_G2 = WS_PROJ;
constexpr size_t WS_XCB = WS_PROJ + al256((size_t)M * INC * 2);
constexpr size_t WS_AB = WS_XCB + al256((size_t)M * DRNN * 2);
constexpr size_t WS_XS = WS_AB + al256((size_t)M * DRNN * 8);
constexpr size_t WS_BC = WS_XS + al256((size_t)M * DSSM * 2);
constexpr size_t WS_XST = WS_BC + al256((size_t)M * 1024 * 2);
constexpr size_t WS_BTT = WS_XST + al256((size_t)NCH * 2048 * 128 * 2);
constexpr size_t WS_DTA = WS_BTT + al256((size_t)NCH * 512 * 128 * 2);
constexpr size_t WS_CUM = WS_DTA + al256((size_t)M * NH * 4);
constexpr size_t WS_YD = WS_CUM + al256((size_t)M * NH * 4);
constexpr size_t WS_ST = WS_YD + al256((size_t)M * DSSM * 4);
constexpr size_t WS_DEC = WS_ST + al256((size_t)NCH * NH * HP * NST * 4);
constexpr size_t WS_HPB = WS_DEC + al256((size_t)NCH * NH * 4);
constexpr size_t WS_SSQRG = WS_HPB + al256((size_t)NCH * NH * HP * NST * 2);
constexpr size_t WS_ENDA = WS_SSQRG + al256((size_t)M * 64 * 4);
constexpr size_t WS_PART = WS_OV;
constexpr size_t WS_GATE = WS_OV;
constexpr size_t WS_VAL = WS_GATE + al256((size_t)M * DFF * 2);
constexpr size_t WS_ACT = WS_VAL + al256((size_t)M * DFF * 2);
constexpr size_t WS_BT3Q = WS_VAL;
constexpr size_t WS_ACTQ = WS_ACT + al256((size_t)M * DFF * 2);
constexpr size_t WS_BT4Q = WS_ACTQ + al256((size_t)M * DFF);
constexpr size_t WS_ENDB = WS_BT4Q + al256((size_t)DM * DFF);
constexpr size_t WS_END0 = WS_ENDA > WS_ENDB ? WS_ENDA : WS_ENDB;
constexpr size_t WS_CATQ = WS_X1B + al256((size_t)M * DM);
constexpr size_t WS_BT2Q = WS_END0;
constexpr size_t WS_SA2 = WS_BT2Q + al256((size_t)DM * DM);
constexpr size_t WS_SW2 = WS_SA2 + al256((size_t)M * 4);
constexpr size_t WS_END = WS_SW2 + al256((size_t)DM * 4);
static_assert(WS_END <= (size_t)1536 * 1024 * 1024, "d_ws map exceeds the guaranteed 1536 MiB");
constexpr int CW_BAR = 1024;
constexpr int CW_SSQ1 = 20480;
constexpr int CW_SSQ2 = CW_SSQ1 + M + 64;
constexpr int CW_HFLAG = CW_SSQ2 + M + 64;
constexpr int CW_HFLAG1 = CW_HFLAG + 34 * 96 + 64;
constexpr int CW_CMAX3 = CW_HFLAG1 + 34 * 37 + 64;
constexpr int CW_CMAX4 = CW_CMAX3 + 2 * DFF;
constexpr int CW_RMAX4 = CW_CMAX4 + DM;
constexpr int CW_DUMMY = CW_RMAX4 + M + 64;
constexpr int CW_TMO = 16;
static_assert((size_t)(CW_DUMMY + M) * 4 <= CTL_BYTES && CW_BAR + 5 * 3456 <= CW_SSQ1, "ctl");
static_assert(((34 * 96) / 8) % 8 == 0 && (34 * 96) % 8 == 0, "up-GEMM unit order: every XCD chunk must start on a sequence-start row panel");

constexpr int RING_BYTES = 131072, LDS_BYTES = 163840, LDSCTL_OFF = LDS_BYTES - 256;

__device__ __forceinline__ unsigned cvt_pk_bf16(float lo, float hi) { unsigned r; asm("v_cvt_pk_bf16_f32 %0, %1, %2" : "=v"(r) : "v"(lo), "v"(hi)); return r; }
__device__ __forceinline__ float bf_lo(unsigned w) { return __uint_as_float(w << 16); }
__device__ __forceinline__ float bf_hi(unsigned w) { return __uint_as_float(w & 0xffff0000u); }
__device__ __forceinline__ float bf2f(bf16_t b) { return __uint_as_float(((unsigned)b) << 16); }
__device__ __forceinline__ f32x4 ld_bf4(const bf16_t* p) { const u32x2 w = *(const u32x2*)p; return (f32x4){bf_lo(w.x), bf_hi(w.x), bf_lo(w.y), bf_hi(w.y)}; }
__device__ __forceinline__ float frcp(float x) { return __builtin_amdgcn_rcpf(x); }
__device__ __forceinline__ float sigmoidf_(float x) { return frcp(1.0f + __expf(-x)); }
__device__ __forceinline__ float siluf_(float x) { return x * sigmoidf_(x); }
__device__ __forceinline__ float gelu_tanh(float x) { const float u = 0.7978845608028654f * (x + 0.044715f * x * x * x); return x * sigmoidf_(2.0f * u); }
__device__ __forceinline__ float softplusf_(float x) { return fmaxf(x, 0.0f) + log1pf(__expf(-fabsf(x))); }
__device__ __forceinline__ float neg_expm1_small(float x, float ehalf  ) {
    const float p = x * (1.0f + x * (0.5f + x * (0.16666667f + x * (0.041666668f + x * (0.008333334f + x * (0.0013888889f + x * 0.0001984127f))))));
    return x > -0.5f ? -p : 1.0f - ehalf * ehalf;
}
__device__ __forceinline__ float wave_sum(float v) {
#pragma unroll
    for (int o = 1; o < 64; o <<= 1) v += __shfl_xor(v, o);
    return v;
}
__device__ __forceinline__ unsigned q8_pack4(float a, float b, float c, float d, float inv) {
    const unsigned ua = __float_as_uint(fmaf(a, inv, 12582912.0f)), ub = __float_as_uint(fmaf(b, inv, 12582912.0f)), uc = __float_as_uint(fmaf(c, inv, 12582912.0f)), ud = __float_as_uint(fmaf(d, inv, 12582912.0f));
    return (ua & 255u) | ((ub & 255u) << 8) | ((uc & 255u) << 16) | (ud << 24);
}
__device__ __forceinline__ u32x4 q8_pack16(const u32x4 lo, const u32x4 hi, float inv) {
    u32x4 o; o.x = q8_pack4(bf_lo(lo.x), bf_hi(lo.x), bf_lo(lo.y), bf_hi(lo.y), inv); o.y = q8_pack4(bf_lo(lo.z), bf_hi(lo.z), bf_lo(lo.w), bf_hi(lo.w), inv);
    o.z = q8_pack4(bf_lo(hi.x), bf_hi(hi.x), bf_lo(hi.y), bf_hi(hi.y), inv); o.w = q8_pack4(bf_lo(hi.z), bf_hi(hi.z), bf_lo(hi.w), bf_hi(hi.w), inv); return o;
}
__device__ __forceinline__ void quant_rows_i8(const bf16_t* src, unsigned char* dst, const unsigned* rmax, int R, int C, size_t gt, size_t NT) {
    const size_t per = (size_t)C / 8, tot = (size_t)R * per;
    for (size_t it0 = gt; it0 < tot; it0 += 8 * NT) { u32x4 w[8]; float inv[8];
#pragma unroll
        for (int k = 0; k < 8; ++k) { const size_t it = it0 + k * NT; if (it < tot) { w[k] = __builtin_nontemporal_load((const u32x4*)(src + it * 8));
                inv[k] = 127.0f / fmaxf(__uint_as_float(rmax[(int)(it / per)]) * 1.004f, 1e-30f); } }
#pragma unroll
        for (int k = 0; k < 8; ++k) { const size_t it = it0 + k * NT; if (it < tot) { u32x2 o; o.x = q8_pack4(bf_lo(w[k].x), bf_hi(w[k].x), bf_lo(w[k].y), bf_hi(w[k].y), inv[k]); o.y = q8_pack4(bf_lo(w[k].z), bf_hi(w[k].z), bf_lo(w[k].w), bf_hi(w[k].w), inv[k]);
                *(u32x2*)(dst + it * 8) = o; } } }
}
__device__ __forceinline__ void fwht32(float (&x)[32]) {
    f32x2 v[16];
#pragma unroll
    for (int i = 0; i < 16; ++i) v[i] = (f32x2){x[2 * i] + x[2 * i + 1], x[2 * i] - x[2 * i + 1]};
#pragma unroll
    for (int h = 1; h < 16; h <<= 1) {
#pragma unroll
        for (int i = 0; i < 16; ++i) if ((i & h) == 0) { const f32x2 a = v[i], b = v[i + h]; v[i] = a + b; v[i + h] = a - b; } }
#pragma unroll
    for (int i = 0; i < 16; ++i) { x[2 * i] = v[i][0]; x[2 * i + 1] = v[i][1]; }
}
template <int NC = 6, bool RGN = false>
__device__ __forceinline__ void rotq_rows_i8(const bf16_t* src, unsigned char* dst, float* scale, int R, int gw, int NGW, int lane, const float* ssq = nullptr) {
    constexpr int RL = 2048 * NC;
    for (int r = gw; r < R; r += NGW) { const bf16_t* sr = src + (size_t)r * RL; u32x4 pk[NC][4]; float mx = 0.f;
        float sq = 0.f; if constexpr (RGN) sq = ssq[(size_t)r * 64 + lane];
#pragma unroll
        for (int i = 0; i < NC; ++i)
#pragma unroll
            for (int q = 0; q < 4; ++q) pk[i][q] = __builtin_nontemporal_load((const u32x4*)(sr + 2048 * i + 8 * (lane + 64 * q)));
#pragma unroll
        for (int i = 0; i < NC; ++i) { float x[32];
#pragma unroll
            for (int q = 0; q < 4; ++q) { const u32x4 w = pk[i][q]; x[8 * q] = bf_lo(w.x); x[8 * q + 1] = bf_hi(w.x); x[8 * q + 2] = bf_lo(w.y); x[8 * q + 3] = bf_hi(w.y); x[8 * q + 4] = bf_lo(w.z); x[8 * q + 5] = bf_hi(w.z); x[8 * q + 6] = bf_lo(w.w); x[8 * q + 7] = bf_hi(w.w); }
            fwht32(x);
            if constexpr (RGN) { if (i == 0) { const float rs = rsqrtf(wave_sum(sq) * (1.0f / DRNN) + EPS);
#pragma unroll
                    for (int e = 0; e < 32; ++e) x[e] *= rs; } }
#pragma unroll
            for (int q = 0; q < 4; ++q) { pk[i][q].x = cvt_pk_bf16(x[8 * q], x[8 * q + 1]); pk[i][q].y = cvt_pk_bf16(x[8 * q + 2], x[8 * q + 3]); pk[i][q].z = cvt_pk_bf16(x[8 * q + 4], x[8 * q + 5]); pk[i][q].w = cvt_pk_bf16(x[8 * q + 6], x[8 * q + 7]); }
#pragma unroll
            for (int e = 0; e < 32; ++e) mx = fmaxf(mx, fabsf(x[e])); }
#pragma unroll
        for (int o = 1; o < 64; o <<= 1) mx = fmaxf(mx, __shfl_xor(mx, o));
        mx = fmaxf(mx * 1.004f, 1e-30f);
        if (lane == 0) scale[r] = mx * (0.17677669529663687f / 127.0f);
        const float inv = 127.0f / mx;
#pragma unroll
        for (int i = 0; i < NC; ++i) { unsigned char* d = dst + (size_t)r * RL + 2048 * i + 8 * lane;
#pragma unroll
            for (int q = 0; q < 4; ++q) { const u32x4 w = pk[i][q]; u32x2 o; o.x = q8_pack4(bf_lo(w.x), bf_hi(w.x), bf_lo(w.y), bf_hi(w.y), inv); o.y = q8_pack4(bf_lo(w.z), bf_hi(w.z), bf_lo(w.w), bf_hi(w.w), inv);
                *(u32x2*)(d + 512 * q) = o; } } }
}
#define FULL_FENCE() do { asm volatile("" ::: "memory"); __builtin_amdgcn_sched_barrier(0); } while (0)
#define LDS_BARRIER() do { asm volatile("s_waitcnt lgkmcnt(0)" ::: "memory"); __builtin_amdgcn_s_barrier(); asm volatile("" ::: "memory"); } while (0)
#define LDS_WAIT() asm volatile("s_waitcnt lgkmcnt(0)" ::: "memory")
#define VM_WAIT() asm volatile("s_waitcnt vmcnt(0)" ::: "memory")

#define XB_TMO      128
#define XB_XCNT(j)  (256  + 64 * (j))
#define XB_XSUB(j)  (1280 + 64 * (j))
#define XB_XGEN(j)  (2304 + 64 * (j))
#define XB_TOP      3328
#define XB_TOPGEN   3392
#define XCD_BAR_WORDS 3456
#define XB_SPIN_CAP (1u << 18)
__device__ __forceinline__ unsigned xb_ld(unsigned* p)              { return __hip_atomic_load(p, __ATOMIC_RELAXED, __HIP_MEMORY_SCOPE_AGENT); }
__device__ __forceinline__ unsigned xb_add(unsigned* p, unsigned v) { return __hip_atomic_fetch_add(p, v, __ATOMIC_RELAXED, __HIP_MEMORY_SCOPE_AGENT); }
__device__ __forceinline__ unsigned xb_xcc_id() { return (unsigned)__builtin_amdgcn_s_getreg((3 << 11) | 20) & 0xFu; }
#define XB_SPIN(cond, bar) do { unsigned _sp = 0; while (cond) { __builtin_amdgcn_s_sleep(1); \
    if ((++_sp & 255u) == 0u) { if (xb_ld(&(bar)[XB_TMO])) break; if (_sp > XB_SPIN_CAP) { atomicAdd(&(bar)[XB_TMO], 1u); break; } } } } while (0)
struct XcdBarrier { unsigned* bar; unsigned x; volatile LAS unsigned* st; };
__device__ __forceinline__ XcdBarrier xcd_barrier_post(unsigned* bar, volatile LAS unsigned* st) {
    XcdBarrier b; b.bar = bar; b.x = xb_xcc_id(); b.st = st;
    if (threadIdx.x == 0) (void)xb_add(&bar[XB_XCNT(b.x)], 1u);
    return b;
}
__device__ __forceinline__ void xcd_barrier_complete(unsigned* bar, unsigned x, unsigned& nloc, unsigned& nx) {
    const unsigned G = gridDim.x * gridDim.y * gridDim.z;
    unsigned sum, cnt, mine, sp = 0u;
    for (;;) {
        sum = 0u; cnt = 0u; mine = 0u;
#pragma unroll
        for (unsigned j = 0; j < 16; ++j) { const unsigned c = xb_ld(&bar[XB_XCNT(j)]); sum += c; cnt += (c > 0u) ? 1u : 0u; mine = (j == x) ? c : mine; }
        if (sum == G) break;
        __builtin_amdgcn_s_sleep(1);
        if ((++sp & 255u) == 0u) { if (xb_ld(&bar[XB_TMO])) break; if (sp > XB_SPIN_CAP) { atomicAdd(&bar[XB_TMO], 1u); break; } }
    }
    nloc = mine > 0u ? mine : 1u; nx = cnt > 0u ? cnt : 1u;
}
__device__ __forceinline__ void xcd_barrier(const XcdBarrier& b) {
    asm volatile("s_waitcnt vmcnt(0)" ::: "memory");
    __syncthreads();
    if (threadIdx.x == 0) {
        unsigned* bar = b.bar;
        __builtin_amdgcn_s_waitcnt(0);
        unsigned nloc = b.st[0], nx = b.st[1];
        if (nloc == 0u) { xcd_barrier_complete(bar, b.x, nloc, nx); b.st[0] = nloc; b.st[1] = nx; }
        const unsigned old = xb_add(&bar[XB_XSUB(b.x)], 1u);
        const unsigned gen = old / nloc;
        if (old + 1u == (gen + 1u) * nloc) {
            __builtin_amdgcn_fence(__ATOMIC_RELEASE, "agent");
            asm volatile("s_waitcnt vmcnt(0)" ::: "memory");
            const unsigned og = xb_add(&bar[XB_TOP], 1u);
            const unsigned tg = og / nx;
            if (og + 1u == (tg + 1u) * nx) xb_add(&bar[XB_TOPGEN], 1u);
            else XB_SPIN(xb_ld(&bar[XB_TOPGEN]) == tg, bar);
            __builtin_amdgcn_fence(__ATOMIC_ACQUIRE, "agent");
            xb_add(&bar[XB_XGEN(b.x)], 1u);
            asm volatile("s_waitcnt vmcnt(0)" ::: "memory");
        } else {
            XB_SPIN(xb_ld(&bar[XB_XGEN(b.x)]) == gen, bar);
            __builtin_amdgcn_fence(__ATOMIC_ACQUIRE, "agent");
            asm volatile("s_waitcnt vmcnt(0)" ::: "memory");
        }
    }
    __syncthreads();
}

namespace pg8 {
constexpr int BM = 256, BK = 64, HALF = 128, HTB = HALF * BK * 2, STAGE_BYTES = 8 * HTB, NXCD = 8, WGM = 8;
__host__ __device__ __forceinline__ int lds_byte(int r, int c) { const int st = (r >> 4) * 2 + (c >> 5), rr = r & 15, cc = c & 31, ob = rr * 64 + cc * 2; return st * 1024 + (ob ^ (((ob >> 9) & 1) << 5)); }
__host__ __device__ __forceinline__ void stage_rc(int b, int& R, int& C) { const int st = b / 1024, sb = b % 1024, swz = sb ^ (((sb >> 9) & 1) << 5); R = (st >> 1) * 16 + swz / 64; C = (st & 1) * 32 + (swz % 64) / 2; }
__host__ __device__ __forceinline__ int perm32(int rho) { const int n = rho >> 4, i = rho & 15; return 8 * (i >> 2) + 4 * n + (i & 3); }
struct Unit { int pm, pn, ks, tl; };
struct Gemm { const bf16_t* A; const bf16_t* Bt; int M, N, K, lda, ldb; };
struct GeomPlain {
    static __device__ __forceinline__ size_t a_off(const Gemm& g, const Unit& u) { return (size_t)u.pm * 256 * g.lda * 2; }
    static __device__ __forceinline__ size_t b_off(const Gemm& g, const Unit& u) { return (size_t)u.pn * 256 * g.ldb * 2; }
};
struct GeomGates {
    static __device__ __forceinline__ size_t a_off(const Gemm& g, const Unit& u) { return ((size_t)u.pm * 256 * g.lda + (size_t)(u.pn >> 1) * 256) * 2; }
    static __device__ __forceinline__ size_t b_off(const Gemm& g, const Unit& u) { return (size_t)u.pn * 256 * g.ldb * 2; }
};
struct StaticOrder {
    int nM, nN, nwg, G, c, limit;
    __host__ __device__ void init(int M, int N, int G_, int c_) { nM = M / BM; nN = N / BM; nwg = nM * nN; G = G_; c = c_; limit = nwg; }
    __host__ __device__ void tile_of(int L, Unit& u) const {
        int wgid = L; { const int q = nwg / NXCD, r = nwg % NXCD, xcd = wgid % NXCD, off = wgid / NXCD; wgid = (xcd < r ? xcd * (q + 1) : r * (q + 1) + (xcd - r) * q) + off; }
        tile_of_wgid(wgid, u);
    }
    __host__ __device__ void tile_of_wgid(int wgid, Unit& u) const {
        const int nig = WGM * nN, gid = wgid / nig, fm = gid * WGM, gsz = (nM - fm) < WGM ? (nM - fm) : WGM;
        u.pm = fm + ((wgid % nig) % gsz); u.pn = (wgid % nig) / gsz; u.ks = 0; u.tl = 0;
    }
    __host__ __device__ bool next(int i, Unit& u) const { const long L = (long)i * G + c; if (L >= limit) return false; tile_of((int)L, u); return true; }
};
struct ChunkOrder {
    StaticOrder base; int per_lo, n_hi;
    __host__ __device__ bool next(int i, Unit& u) const {
        const int G = base.G, c = base.c; int wgid;
        if (per_lo > 0) { const int x = c & 7, j = c >> 3; wgid = i * G + x * per_lo + (x < n_hi ? x : n_hi) + j; } else wgid = i * G + c;
        if (wgid >= base.nwg) return false; base.tile_of_wgid(wgid, u); return true;
    }
};
struct SplitOrder {
    StaticOrder base; int first, nrem, c;
    __host__ __device__ bool next(int i, Unit& u) const { if (i > 0 || c >= nrem * 8) return false; base.tile_of(first + c % nrem, u); u.tl = c % nrem; u.ks = c / nrem; return true; }
};
struct GeomSplit {
    static __device__ __forceinline__ size_t a_off(const Gemm& g, const Unit& u) { return ((size_t)u.pm * 256 * g.lda + (size_t)u.ks * g.K) * 2; }
    static __device__ __forceinline__ size_t b_off(const Gemm& g, const Unit& u) { return ((size_t)u.pn * 256 * g.ldb + (size_t)u.ks * g.K) * 2; }
};

template <class Epi, class Geom, class Sched, bool ALIGN_EPI, bool I8 = false>
__device__ __forceinline__ void gemm_phase(LAS unsigned char* lds, const Gemm g, const Sched& S, const Epi& E) {
    const int tid = threadIdx.x, wid = __builtin_amdgcn_readfirstlane(tid >> 6), lane = tid & 63, wr = wid >> 2, wc = wid & 3, fr = lane & 15, fq = lane >> 4;
    const int K = g.K, nt = K / BK;
    unsigned voffA[2], voffB[2];
#pragma unroll
    for (int i = 0; i < 2; ++i) { int R, C; stage_rc(tid * 16 + i * 8192, R, C); const int Rb = Epi::PERM ? ((R & ~31) + perm32(R & 31)) : R;
        voffA[i] = (unsigned)(R * g.lda + C) * 2u; voffB[i] = (unsigned)(Rb * g.ldb + C) * 2u; }
    const size_t kstep = (size_t)(BK * 2);
    const size_t hsA = (size_t)HALF * g.lda * 2, hsB = (size_t)HALF * g.ldb * 2;
    const unsigned ldsw = (unsigned)wid * 1024u;
    const int aoff = lds_byte(wr * 64 + fr, fq * 8), boff = lds_byte(wc * 32 + fr, fq * 8);
#define PG8_SA(b, h) (((b) * 2 + (h)) * HTB)
#define PG8_SB(b, h) ((4 + (b) * 2 + (h)) * HTB)
#define PG8_STAGE(bufoff, gbase, voff) do { _Pragma("unroll") for (int _i = 0; _i < 2; ++_i) \
        __builtin_amdgcn_global_load_lds((const unsigned*)((const char*)(gbase) + (voff)[_i]), (LAS unsigned*)(lds + (bufoff) + ldsw + _i * 8192), 16, 0, 0); } while (0)
#define PG8_LDA(dst, b, h) do { _Pragma("unroll") for (int m = 0; m < 4; ++m) _Pragma("unroll") for (int k = 0; k < 2; ++k) dst[m][k] = *(const LAS bf16x8*)(lds + PG8_SA(b, h) + aoff + m * 2048 + k * 1024); } while (0)
#define PG8_LDB(dst, b, h) do { _Pragma("unroll") for (int n = 0; n < 2; ++n) _Pragma("unroll") for (int k = 0; k < 2; ++k) dst[n][k] = *(const LAS bf16x8*)(lds + PG8_SB(b, h) + boff + n * 2048 + k * 1024); } while (0)
#define PG8_MMA(ai, bj, At, Bt) do { __builtin_amdgcn_s_setprio(1); _Pragma("unroll") for (int m = 0; m < 4; ++m) _Pragma("unroll") for (int n = 0; n < 2; ++n) _Pragma("unroll") for (int k = 0; k < 2; ++k) { \
        if constexpr (I8) acc[ai][bj][m][n] = __builtin_bit_cast(f32x4, __builtin_amdgcn_mfma_i32_16x16x64_i8(__builtin_bit_cast(i32x4, Bt[n][k]), __builtin_bit_cast(i32x4, At[m][k]), __builtin_bit_cast(i32x4, acc[ai][bj][m][n]), 0, 0, 0)); \
        else acc[ai][bj][m][n] = __builtin_amdgcn_mfma_f32_16x16x32_bf16(Bt[n][k], At[m][k], acc[ai][bj][m][n], 0, 0, 0); } __builtin_amdgcn_s_setprio(0); } while (0)
#define PG8_WAIT_V(n) asm volatile("s_waitcnt vmcnt(" #n ")" ::: "memory")
#define PG8_WAIT_L(n) asm volatile("s_waitcnt lgkmcnt(" #n ")" ::: "memory")
#define PG8_BAR __builtin_amdgcn_s_barrier()
#define PG8_SCHED __builtin_amdgcn_sched_barrier(0)
    Unit cur, nxt; int ui = 0;
    if (!S.next(0, cur)) return;
    f32x4 acc[2][2][4][2];
#pragma unroll
    for (int a = 0; a < 2; ++a)
#pragma unroll
        for (int b = 0; b < 2; ++b)
#pragma unroll
            for (int m = 0; m < 4; ++m)
#pragma unroll
                for (int n = 0; n < 2; ++n) acc[a][b][m][n] = (f32x4){0.f, 0.f, 0.f, 0.f};
    bf16x8 At[4][2], B0[2][2], B1[2][2];
    const char* cA = (const char*)g.A + Geom::a_off(g, cur); const char* cB = (const char*)g.Bt + Geom::b_off(g, cur);
    PG8_STAGE(PG8_SB(0, 0), cB, voffB); PG8_STAGE(PG8_SB(0, 1), cB + hsB, voffB); PG8_STAGE(PG8_SA(0, 0), cA, voffA); PG8_STAGE(PG8_SA(0, 1), cA + hsA, voffA);
    if (wr == 1) PG8_BAR;
    PG8_WAIT_V(2); PG8_BAR;
    PG8_STAGE(PG8_SB(1, 0), cB + kstep, voffB); PG8_STAGE(PG8_SA(1, 0), cA + kstep, voffA); PG8_STAGE(PG8_SB(1, 1), cB + hsB + kstep, voffB);
    PG8_WAIT_V(6); PG8_BAR;
    for (;;) {
        const bool has_next = S.next(ui + 1, nxt);
        const char* nA = has_next ? (const char*)g.A + Geom::a_off(g, nxt) : cA; const char* nB = has_next ? (const char*)g.Bt + Geom::b_off(g, nxt) : cB;
#pragma unroll 1
        for (int t = 0; t < nt; t += 2) {
            const bool last = (t == nt - 2);
            const char* a1 = cA + (size_t)(t + 1) * kstep;
            const char* a2 = last ? nA : cA + (size_t)(t + 2) * kstep; const char* b2 = last ? nB : cB + (size_t)(t + 2) * kstep;
            const char* a3 = a2 + kstep; const char* b3 = b2 + kstep;
            PG8_LDB(B0, 0, 0); PG8_LDB(B1, 0, 1); PG8_SCHED; PG8_LDA(At, 0, 0); PG8_STAGE(PG8_SA(1, 1), a1 + hsA, voffA);
            PG8_WAIT_V(8); PG8_WAIT_L(0); PG8_BAR; PG8_MMA(0, 0, At, B0); PG8_MMA(0, 1, At, B1); PG8_BAR; PG8_SCHED;
            PG8_LDA(At, 0, 1); PG8_STAGE(PG8_SB(0, 0), b2, voffB); PG8_STAGE(PG8_SB(0, 1), b2 + hsB, voffB); PG8_STAGE(PG8_SA(0, 0), a2, voffA);
            PG8_WAIT_V(8); PG8_WAIT_L(0); PG8_BAR; PG8_MMA(1, 0, At, B0); PG8_MMA(1, 1, At, B1); PG8_BAR; PG8_SCHED;
            PG8_LDB(B0, 1, 0); PG8_LDB(B1, 1, 1); PG8_SCHED; PG8_LDA(At, 1, 0); PG8_STAGE(PG8_SA(0, 1), a2 + hsA, voffA);
            PG8_WAIT_V(8); PG8_WAIT_L(0); PG8_BAR; PG8_MMA(0, 0, At, B0); PG8_MMA(0, 1, At, B1); PG8_BAR; PG8_SCHED;
            PG8_LDA(At, 1, 1); PG8_STAGE(PG8_SB(1, 0), b3, voffB); PG8_STAGE(PG8_SB(1, 1), b3 + hsB, voffB); PG8_STAGE(PG8_SA(1, 0), a3, voffA);
            PG8_WAIT_V(8); PG8_WAIT_L(0); PG8_BAR; PG8_MMA(1, 0, At, B0); PG8_MMA(1, 1, At, B1); PG8_BAR; PG8_SCHED;
        }
        if constexpr (ALIGN_EPI) { if (wr == 0) PG8_BAR; }
        E(acc, cur, wr, wc, fr, fq);
        if (!has_next) break;
#pragma unroll
        for (int a = 0; a < 2; ++a)
#pragma unroll
            for (int b = 0; b < 2; ++b)
#pragma unroll
                for (int m = 0; m < 4; ++m)
#pragma unroll
                    for (int n = 0; n < 2; ++n) acc[a][b][m][n] = (f32x4){0.f, 0.f, 0.f, 0.f};
        cur = nxt; cA = nA; cB = nB; ++ui;
        if constexpr (ALIGN_EPI) { if (wr == 1) PG8_BAR; }
    }
    PG8_WAIT_V(0);
    if constexpr (!ALIGN_EPI) { if (wr == 0) PG8_BAR; }
    PG8_BAR;
#undef PG8_SA
#undef PG8_SB
#undef PG8_STAGE
#undef PG8_LDA
#undef PG8_LDB
#undef PG8_MMA
#undef PG8_WAIT_V
#undef PG8_WAIT_L
#undef PG8_BAR
#undef PG8_SCHED
}
}

struct Args { const float* in[30]; float* out; unsigned char* ws; int ph_lo, ph_hi, li, rep; };
struct Frame {
    LAS unsigned char* lds; int tid, lane, wave, G;
    const float* in[30]; float* out; unsigned char* ws;
};
#define WSP(T, off) ((T*)(F.ws + (off)))

__device__ __forceinline__ float dpp_ror1(float v) { return __builtin_bit_cast(float, __builtin_amdgcn_update_dpp(0, __builtin_bit_cast(int, v), 0x121, 0xf, 0xf, false)); }
__device__ __forceinline__ float dpp_ror2(float v) { return __builtin_bit_cast(float, __builtin_amdgcn_update_dpp(0, __builtin_bit_cast(int, v), 0x122, 0xf, 0xf, false)); }
__device__ __forceinline__ float dpp_ror3(float v) { return __builtin_bit_cast(float, __builtin_amdgcn_update_dpp(0, __builtin_bit_cast(int, v), 0x123, 0xf, 0xf, false)); }
struct EpiProjConv {
    static constexpr bool PERM = true;
    unsigned char* wsb; float* out; const float *rgw, *rgb, *sdw, *sdb, *dtb, *st_rg, *st_sd; LAS float* H;
    __device__ __forceinline__ void operator()(f32x4 (&acc)[2][2][4][2], const pg8::Unit& u, int wr, int wc, int fr, int fq) const {
        unsigned char* ws = wsb;
        asm volatile("" : "+v"(fr), "+v"(fq), "+s"(ws));
        const float* rs = (const float*)(ws + WS_RS1); bf16_t* G2 = (bf16_t*)(ws + WS_G2); float* DTA = (float*)(ws + WS_DTA);
        unsigned long long* HALO = (unsigned long long*)(ws + WS_HALO1); unsigned* HFLAG = (unsigned*)(ws + WS_CTL) + CW_HFLAG1; unsigned* tmo = (unsigned*)(ws + WS_CTL) + CW_TMO;
        const int row0 = u.pm * 256 + wr * 64 + fr, cl0 = wc * 32 + 8 * fq, c0 = u.pn * 256 + cl0;
        { float sc[2][4];
#pragma unroll
          for (int ai = 0; ai < 2; ++ai)
#pragma unroll
              for (int m = 0; m < 4; ++m) sc[ai][m] = rs[row0 + ai * 128 + m * 16];
#pragma unroll
          for (int ai = 0; ai < 2; ++ai)
#pragma unroll
              for (int m = 0; m < 4; ++m)
#pragma unroll
                  for (int bj = 0; bj < 2; ++bj) { acc[ai][bj][m][0] *= sc[ai][m]; acc[ai][bj][m][1] *= sc[ai][m]; } }
        const int pn = u.pn;
        if (pn >= 8 && pn < 24) {
#pragma unroll
            for (int ai = 0; ai < 2; ++ai)
#pragma unroll
                for (int m = 0; m < 4; ++m) { const int row = row0 + ai * 128 + m * 16;
#pragma unroll
                    for (int bj = 0; bj < 2; ++bj) { f32x4 v0 = acc[ai][bj][m][0], v1 = acc[ai][bj][m][1];
                        if (pn < 16) { v0 = (f32x4){gelu_tanh(v0[0]), gelu_tanh(v0[1]), gelu_tanh(v0[2]), gelu_tanh(v0[3])}; v1 = (f32x4){gelu_tanh(v1[0]), gelu_tanh(v1[1]), gelu_tanh(v1[2]), gelu_tanh(v1[3])}; }
                        else { v0 = (f32x4){siluf_(v0[0]), siluf_(v0[1]), siluf_(v0[2]), siluf_(v0[3])}; v1 = (f32x4){siluf_(v1[0]), siluf_(v1[1]), siluf_(v1[2]), siluf_(v1[3])}; }
                        u32x4 w; w.x = cvt_pk_bf16(v0[0], v0[1]); w.y = cvt_pk_bf16(v0[2], v0[3]); w.z = cvt_pk_bf16(v1[0], v1[1]); w.w = cvt_pk_bf16(v1[2], v1[3]);
                        *(u32x4*)(G2 + (size_t)row * 4096 + (c0 - C_RGG) + bj * 128) = w; } }
            return; }
        if (pn >= 36) {
            if (wc == 0) { const f32x4 b0 = *(const f32x4*)(dtb + cl0), b1 = *(const f32x4*)(dtb + cl0 + 4);
#pragma unroll
                for (int ai = 0; ai < 2; ++ai)
#pragma unroll
                    for (int m = 0; m < 4; ++m) { const int row = row0 + ai * 128 + m * 16; const f32x4 v0 = acc[ai][0][m][0] + b0, v1 = acc[ai][0][m][1] + b1;
                        float* d = DTA + (size_t)row * NH + cl0;
                        *(f32x4*)d = (f32x4){softplusf_(v0[0]), softplusf_(v0[1]), softplusf_(v0[2]), softplusf_(v0[3])}; *(f32x4*)(d + 4) = (f32x4){softplusf_(v1[0]), softplusf_(v1[1]), softplusf_(v1[2]), softplusf_(v1[3])}; } }
            return; }
        const bool is_rg = pn < 8, prompt = u.pm < MP / 256;
        const int ch0 = is_rg ? c0 : c0 - C_XBC, CW = is_rg ? DRNN : DXBC;
        const float* cw = rgw + (is_rg ? (ptrdiff_t)0 : (sdw - rgw)); const float* cb = rgb + (is_rg ? (ptrdiff_t)0 : (sdb - rgb)); const float* stp = st_rg + (is_rg ? (ptrdiff_t)0 : (st_sd - st_rg));
        if ((u.pm & 7) == 7 || !prompt) {
#pragma unroll
            for (int ai = 0; ai < 2; ++ai)
#pragma unroll
                for (int m = 0; m < 4; ++m) { const int row = row0 + ai * 128 + m * 16; int j = -1; size_t base = 0;
                    if (row < MP) { const int t = row & (SEQ - 1); if (t >= SEQ - 3) { j = t - (SEQ - 3); base = (size_t)(row >> 11) * 3; } }
                    else { const int r = row - MP, t = r & 3; if (t >= 1) { j = t - 1; base = (size_t)(r >> 2) * 3; } }
                    if (j >= 0) { const size_t oo = is_rg ? (row < MP ? O_PRGC : O_SRGC) : (row < MP ? O_PSC : O_SSC); float* so = out + oo + (base + j) * CW + ch0;
#pragma unroll
                        for (int bj = 0; bj < 2; ++bj) { *(f32x4*)(so + bj * 128) = acc[ai][bj][m][0]; *(f32x4*)(so + bj * 128 + 4) = acc[ai][bj][m][1]; } } } }
        const int tile = u.pm * 37 + u.pn;
        if (prompt) {
            if (fr >= 13) {
#pragma unroll
                for (int ai = 0; ai < 2; ++ai)
#pragma unroll
                    for (int bj = 0; bj < 2; ++bj)
#pragma unroll
                        for (int n = 0; n < 2; ++n) *(LAS f32x4*)(H + ((2 * ai + wr) * 3 + (fr - 13)) * 256 + bj * 128 + cl0 + 4 * n) = acc[ai][bj][3][n];
                if (wr == 1 && (u.pm & 7) != 7) { unsigned long long* hp = HALO + ((size_t)tile * 3 + (fr - 13)) * 128 + (cl0 >> 1);
#pragma unroll
                    for (int bj = 0; bj < 2; ++bj)
#pragma unroll
                        for (int n = 0; n < 2; ++n) { const f32x4 g = acc[1][bj][3][n];
                            __hip_atomic_store(hp + bj * 64 + 2 * n, ((unsigned long long)__float_as_uint(g[1]) << 32) | __float_as_uint(g[0]), __ATOMIC_RELAXED, __HIP_MEMORY_SCOPE_AGENT);
                            __hip_atomic_store(hp + bj * 64 + 2 * n + 1, ((unsigned long long)__float_as_uint(g[3]) << 32) | __float_as_uint(g[2]), __ATOMIC_RELAXED, __HIP_MEMORY_SCOPE_AGENT); } }
            }
            if (wr == 1 && (u.pm & 7) != 7) { asm volatile("s_waitcnt vmcnt(0)" ::: "memory");
                if (fr == 0 && fq == 0) __hip_atomic_fetch_add(HFLAG + tile, 1u, __ATOMIC_RELAXED, __HIP_MEMORY_SCOPE_AGENT); }
            asm volatile("s_waitcnt lgkmcnt(0)" ::: "memory"); __builtin_amdgcn_s_barrier(); asm volatile("" ::: "memory");
        }
        const size_t dso = is_rg ? WS_XCB : (ch0 < DSSM ? WS_XS : WS_BC); const int ld = is_rg ? DRNN : (ch0 < DSSM ? DSSM : 1024);
        bf16_t* dst = (bf16_t*)(ws + dso) + (is_rg ? ch0 : (ch0 < DSSM ? ch0 : ch0 - DSSM));
#pragma unroll
        for (int ai = 0; ai < 2; ++ai)
#pragma unroll
            for (int bj = 0; bj < 2; ++bj) {
                f32x4 hal[2];
                hal[0] = hal[1] = (f32x4){0.f, 0.f, 0.f, 0.f};
                if (prompt) { const int b = 2 * ai + wr;
                    if (b >= 1) { if (fr >= 13) {
#pragma unroll
                            for (int n = 0; n < 2; ++n) hal[n] = *(const LAS f32x4*)(H + ((b - 1) * 3 + (fr - 13)) * 256 + bj * 128 + cl0 + 4 * n); } }
                    else if ((u.pm & 7) != 0) { unsigned* fl = HFLAG + (tile - 37); unsigned sp = 0;
                        while ((unsigned)__builtin_amdgcn_readfirstlane(__hip_atomic_load(fl, __ATOMIC_RELAXED, __HIP_MEMORY_SCOPE_AGENT)) < 4u) { __builtin_amdgcn_s_sleep(2);
                            if ((++sp & 1023u) == 0u) { if (__hip_atomic_load(tmo, __ATOMIC_RELAXED, __HIP_MEMORY_SCOPE_AGENT) != 0u) break; if (sp > (1u << 22)) { __hip_atomic_store(tmo, 1u, __ATOMIC_RELAXED, __HIP_MEMORY_SCOPE_AGENT); break; } } }
                        if (fr >= 13) { const unsigned long long* hp = HALO + ((size_t)(tile - 37) * 3 + (fr - 13)) * 128 + (cl0 >> 1) + bj * 64;
#pragma unroll
                            for (int n = 0; n < 2; ++n) { const unsigned long long a2 = __hip_atomic_load(hp + 2 * n, __ATOMIC_RELAXED, __HIP_MEMORY_SCOPE_AGENT), b2 = __hip_atomic_load(hp + 2 * n + 1, __ATOMIC_RELAXED, __HIP_MEMORY_SCOPE_AGENT);
                                hal[n] = (f32x4){__uint_as_float((unsigned)a2), __uint_as_float((unsigned)(a2 >> 32)), __uint_as_float((unsigned)b2), __uint_as_float((unsigned)(b2 >> 32))}; } } } }
#pragma unroll
                for (int n = 0; n < 2; ++n) { const int ch = ch0 + bj * 128 + 4 * n;
                    const f32x4 w0 = *(const f32x4*)(cw + ch), w1 = *(const f32x4*)(cw + CW + ch), w2 = *(const f32x4*)(cw + 2 * CW + ch), w3 = *(const f32x4*)(cw + 3 * CW + ch), bb = *(const f32x4*)(cb + ch);
#pragma unroll
                    for (int m = 0; m < 4; ++m) { const int row = row0 + ai * 128 + m * 16; const f32x4 g = acc[ai][bj][m][n]; f32x4 p1, p2, p3;
                        if (prompt) { const f32x4 gp = (m == 0) ? hal[n] : acc[ai][bj][m > 0 ? m - 1 : 0][n];
#pragma unroll
                            for (int j = 0; j < 4; ++j) { p1[j] = dpp_ror1(fr == 15 ? gp[j] : g[j]); p2[j] = dpp_ror2(fr >= 14 ? gp[j] : g[j]); p3[j] = dpp_ror3(fr >= 13 ? gp[j] : g[j]); } }
                        else { const int t = fr & 3; const float* sp = stp + (size_t)((row - MP) >> 2) * 3 * CW + ch;
                            const f32x4 b0 = *(const f32x4*)sp, b1 = *(const f32x4*)(sp + CW), b2 = *(const f32x4*)(sp + 2 * CW);
#pragma unroll
                            for (int j = 0; j < 4; ++j) { const float r1 = dpp_ror1(g[j]), r2 = dpp_ror2(g[j]), r3 = dpp_ror3(g[j]);
                                p1[j] = t >= 1 ? r1 : b2[j]; p2[j] = t >= 2 ? r2 : (t == 1 ? b2[j] : b1[j]); p3[j] = t >= 3 ? r3 : (t == 2 ? b2[j] : (t == 1 ? b1[j] : b0[j])); } }
                        float o[4];
#pragma unroll
                        for (int j = 0; j < 4; ++j) { const float y = bb[j] + w0[j] * p3[j] + w1[j] * p2[j] + w2[j] * p1[j] + w3[j] * g[j]; o[j] = is_rg ? y : siluf_(y); }
                        u32x2 w; w.x = cvt_pk_bf16(o[0], o[1]); w.y = cvt_pk_bf16(o[2], o[3]);
                        *(u32x2*)(dst + (size_t)row * ld + bj * 128 + 4 * n) = w; }
                    asm volatile("" ::: "memory"); } }
    }
};
struct EpiGates {
    static constexpr bool PERM = false;
    unsigned* AB; const bf16_t* XCB; const float *ba, *bi, *sp8;
    __device__ __forceinline__ void operator()(const f32x4 (&acc)[2][2][4][2], const pg8::Unit& u, int wr, int wc, int fr, int fq) const {
        const int row0 = u.pm * 256 + wr * 64 + fr, ch0 = (u.pn >> 1) * 256 + (u.pn & 1) * 128 + wc * 32 + 4 * fq;
        const unsigned base = (unsigned)row0 * DRNN + ch0;
        u32x2 xw[2][2][4]; f32x4 bav[2], biv[2], spv[2];
#pragma unroll
        for (int n = 0; n < 2; ++n) { const int ch = ch0 + n * 16; bav[n] = *(const f32x4*)(ba + ch); biv[n] = *(const f32x4*)(bi + ch); spv[n] = *(const f32x4*)(sp8 + ch);
#pragma unroll
            for (int ai = 0; ai < 2; ++ai)
#pragma unroll
                for (int m = 0; m < 4; ++m) xw[n][ai][m] = *(const u32x2*)((const char*)XCB + (size_t)((base + (unsigned)((ai * 128 + m * 16) * DRNN + n * 16)) * 2u)); }
#pragma unroll
        for (int n = 0; n < 2; ++n) {
#pragma unroll
            for (int ai = 0; ai < 2; ++ai)
#pragma unroll
                for (int m = 0; m < 4; ++m) { const unsigned off = base + (unsigned)((ai * 128 + m * 16) * DRNN + n * 16);
                    const u32x2 x2 = xw[n][ai][m];
                    const float xc[4] = {bf_lo(x2.x), bf_hi(x2.x), bf_lo(x2.y), bf_hi(x2.y)};
                    const f32x4 r4 = acc[ai][0][m][n] + bav[n], i4 = acc[ai][1][m][n] + biv[n];
                    float av[4], bv[4];
#pragma unroll
                    for (int j = 0; j < 4; ++j) { const float gr = sigmoidf_(r4[j]), gi = sigmoidf_(i4[j]); const float la = -gr * spv[n][j];
                        av[j] = __expf(la); bv[j] = __builtin_amdgcn_sqrtf(neg_expm1_small(2.0f * la, av[j])) * gi * xc[j]; }
                    u32x4 pk; pk.x = cvt_pk_bf16(1.0f - av[0], bv[0]); pk.y = cvt_pk_bf16(1.0f - av[1], bv[1]); pk.z = cvt_pk_bf16(1.0f - av[2], bv[2]); pk.w = cvt_pk_bf16(1.0f - av[3], bv[3]);
                    *(u32x4*)((char*)AB + (size_t)off * 4u) = pk; } }
    }
};
struct EpiX1 {
    static constexpr bool PERM = true;
    const float *xp, *xs; bf16_t* X1;
    __device__ __forceinline__ void operator()(const f32x4 (&acc)[2][2][4][2], const pg8::Unit& u, int wr, int wc, int fr, int fq) const {
        const int row0 = u.pm * 256 + wr * 64 + fr, col0 = u.pn * 256 + wc * 32 + 8 * fq;
#pragma unroll
        for (int am = 0; am < 4; ++am) { const int ai = am >> 1, m0 = 2 * (am & 1); f32x4 r[2][2][2];
#pragma unroll
            for (int mm = 0; mm < 2; ++mm) { const int row = row0 + ai * 128 + (m0 + mm) * 16; const float* xin = (row < MP ? xp + (size_t)row * DM : xs + (size_t)(row - MP) * DM) + col0;
#pragma unroll
                for (int bj = 0; bj < 2; ++bj)
#pragma unroll
                    for (int n = 0; n < 2; ++n) r[mm][bj][n] = *(const f32x4*)(xin + bj * 128 + 4 * n); }
#pragma unroll
            for (int mm = 0; mm < 2; ++mm) { bf16_t* o = X1 + (size_t)(row0 + ai * 128 + (m0 + mm) * 16) * DM + col0;
#pragma unroll
                for (int bj = 0; bj < 2; ++bj) { const f32x4 v0 = acc[ai][bj][m0 + mm][0] + r[mm][bj][0], v1 = acc[ai][bj][m0 + mm][1] + r[mm][bj][1];
                    u32x4 w; w.x = cvt_pk_bf16(v0[0], v0[1]); w.y = cvt_pk_bf16(v0[2], v0[3]); w.z = cvt_pk_bf16(v1[0], v1[1]); w.w = cvt_pk_bf16(v1[2], v1[3]);
                    *(u32x4*)(o + bj * 128) = w; } } }
    }
};
struct EpiUpConv {
    static constexpr bool PERM = true;
    bf16_t* ACT; const float* rf; const unsigned* cmax; float* out; const float *cw, *cb, *stf; LAS float* H; unsigned long long* HALO; unsigned* HFLAG; unsigned* tmo;
    __device__ __forceinline__ void operator()(f32x4 (&acc)[2][2][4][2], const pg8::Unit& u, int wr, int wc, int fr, int fq) const {
        const int row0 = u.pm * 256 + wr * 64 + fr, cl0 = wc * 32 + 8 * fq, ch0 = u.pn * 128 + cl0;
        float sc[2][4];
#pragma unroll
        for (int ai = 0; ai < 2; ++ai)
#pragma unroll
            for (int m = 0; m < 4; ++m) sc[ai][m] = rf[row0 + ai * 128 + m * 16];
        {
            f32x4 sw[2][2];
#pragma unroll
            for (int bj = 0; bj < 2; ++bj)
#pragma unroll
                for (int n = 0; n < 2; ++n) { const u32x4 c = *(const u32x4*)(cmax + u.pn * 256 + bj * 128 + cl0 + 4 * n); sw[bj][n] = (f32x4){__uint_as_float(c.x), __uint_as_float(c.y), __uint_as_float(c.z), __uint_as_float(c.w)} * (1.004f / 127.0f); }
#pragma unroll
            for (int ai = 0; ai < 2; ++ai)
#pragma unroll
                for (int m = 0; m < 4; ++m)
#pragma unroll
                    for (int bj = 0; bj < 2; ++bj)
#pragma unroll
                        for (int n = 0; n < 2; ++n) { const i32x4 q = __builtin_bit_cast(i32x4, acc[ai][bj][m][n]); acc[ai][bj][m][n] = (f32x4){(float)q[0], (float)q[1], (float)q[2], (float)q[3]} * sw[bj][n] * sc[ai][m]; }
        }
        if ((u.pm & 7) == 7 || u.pm >= MP / 256) {
#pragma unroll
            for (int ai = 0; ai < 2; ++ai)
#pragma unroll
                for (int m = 0; m < 4; ++m) { const int row = row0 + ai * 128 + m * 16; float* so = nullptr;
                    if (row < MP) { const int t = row & (SEQ - 1); if (t >= SEQ - 2) so = out + O_PFC + ((size_t)(row >> 11) * 2 + (t - (SEQ - 2))) * DFF + ch0; }
                    else { const int r = row - MP, t = r & 3; if (t >= 2) so = out + O_SFC + ((size_t)(r >> 2) * 2 + (t - 2)) * DFF + ch0; }
                    if (so) { *(f32x4*)so = acc[ai][0][m][0]; *(f32x4*)(so + 4) = acc[ai][0][m][1]; } } }
        const bool prompt = u.pm < MP / 256;
        if (prompt) {
            if (fr >= 14) {
#pragma unroll
                for (int ai = 0; ai < 2; ++ai)
#pragma unroll
                    for (int n = 0; n < 2; ++n) *(LAS f32x4*)(H + ((2 * ai + wr) * 2 + (fr - 14)) * 128 + cl0 + 4 * n) = acc[ai][0][3][n];
                if (wr == 1 && (u.pm & 7) != 7) { unsigned long long* hp = HALO + ((size_t)(u.pm * 96 + u.pn) * 2 + (fr - 14)) * 64 + (cl0 >> 1);
#pragma unroll
                    for (int n = 0; n < 2; ++n) { const f32x4 g = acc[1][0][3][n];
                        __hip_atomic_store(hp + 2 * n, ((unsigned long long)__float_as_uint(g[1]) << 32) | __float_as_uint(g[0]), __ATOMIC_RELAXED, __HIP_MEMORY_SCOPE_AGENT);
                        __hip_atomic_store(hp + 2 * n + 1, ((unsigned long long)__float_as_uint(g[3]) << 32) | __float_as_uint(g[2]), __ATOMIC_RELAXED, __HIP_MEMORY_SCOPE_AGENT); } }
            }
            if (wr == 1 && (u.pm & 7) != 7) { asm volatile("s_waitcnt vmcnt(0)" ::: "memory");
                if (fr == 0 && fq == 0) __hip_atomic_fetch_add(HFLAG + u.pm * 96 + u.pn, 1u, __ATOMIC_RELAXED, __HIP_MEMORY_SCOPE_AGENT); }
            asm volatile("s_waitcnt lgkmcnt(0)" ::: "memory"); __builtin_amdgcn_s_barrier(); asm volatile("" ::: "memory");
        }
#pragma unroll
        for (int ai = 0; ai < 2; ++ai) {
            f32x4 hal[2]; hal[0] = hal[1] = (f32x4){0.f, 0.f, 0.f, 0.f};
            if (prompt) { const int b = 2 * ai + wr;
                if (b >= 1) { if (fr >= 14) {
#pragma unroll
                        for (int n = 0; n < 2; ++n) hal[n] = *(const LAS f32x4*)(H + ((b - 1) * 2 + (fr - 14)) * 128 + cl0 + 4 * n); } }
                else if ((u.pm & 7) != 0) { unsigned* fl = HFLAG + (u.pm - 1) * 96 + u.pn; unsigned sp = 0;
                    while ((unsigned)__builtin_amdgcn_readfirstlane(__hip_atomic_load(fl, __ATOMIC_RELAXED, __HIP_MEMORY_SCOPE_AGENT)) < 4u) { __builtin_amdgcn_s_sleep(2);
                        if ((++sp & 1023u) == 0u) { if (__hip_atomic_load(tmo, __ATOMIC_RELAXED, __HIP_MEMORY_SCOPE_AGENT) != 0u) break; if (sp > (1u << 22)) { __hip_atomic_store(tmo, 1u, __ATOMIC_RELAXED, __HIP_MEMORY_SCOPE_AGENT); break; } } }
                    if (fr >= 14) { const unsigned long long* hp = HALO + ((size_t)((u.pm - 1) * 96 + u.pn) * 2 + (fr - 14)) * 64 + (cl0 >> 1);
#pragma unroll
                        for (int n = 0; n < 2; ++n) { const unsigned long long a = __hip_atomic_load(hp + 2 * n, __ATOMIC_RELAXED, __HIP_MEMORY_SCOPE_AGENT), b2 = __hip_atomic_load(hp + 2 * n + 1, __ATOMIC_RELAXED, __HIP_MEMORY_SCOPE_AGENT);
                            hal[n] = (f32x4){__uint_as_float((unsigned)a), __uint_as_float((unsigned)(a >> 32)), __uint_as_float((unsigned)b2), __uint_as_float((unsigned)(b2 >> 32))}; } } } }
#pragma unroll
            for (int n = 0; n < 2; ++n) {
                const f32x4 w0 = *(const f32x4*)(cw + ch0 + 4 * n), w1 = *(const f32x4*)(cw + DFF + ch0 + 4 * n), w2 = *(const f32x4*)(cw + 2 * DFF + ch0 + 4 * n), bb = *(const f32x4*)(cb + ch0 + 4 * n);
#pragma unroll
                for (int m = 0; m < 4; ++m) { const int row = row0 + ai * 128 + m * 16; const f32x4 g = acc[ai][0][m][n], vv = acc[ai][1][m][n]; f32x4 p1, p2;
                    if (prompt) { const f32x4 gp = (m == 0) ? hal[n] : acc[ai][0][m > 0 ? m - 1 : 0][n];
#pragma unroll
                        for (int j = 0; j < 4; ++j) { p1[j] = dpp_ror1(fr == 15 ? gp[j] : g[j]); p2[j] = dpp_ror2(fr >= 14 ? gp[j] : g[j]); } }
                    else { const int t = fr & 3; const float* sp = stf + (size_t)((row - MP) >> 2) * 2 * DFF + ch0 + 4 * n;
                        f32x4 b0 = (f32x4){0.f, 0.f, 0.f, 0.f}, b1 = b0; if (t == 0) b0 = *(const f32x4*)sp; if (t <= 1) b1 = *(const f32x4*)(sp + DFF);
#pragma unroll
                        for (int j = 0; j < 4; ++j) { const float r1 = dpp_ror1(g[j]), r2 = dpp_ror2(g[j]); p1[j] = t >= 1 ? r1 : b1[j]; p2[j] = t >= 2 ? r2 : (t == 1 ? b1[j] : b0[j]); } }
                    float o[4];
#pragma unroll
                    for (int j = 0; j < 4; ++j) { const float y = bb[j] + w0[j] * p2[j] + w1[j] * p1[j] + w2[j] * g[j]; o[j] = gelu_tanh(y) * vv[j]; }
                    u32x2 w; w.x = cvt_pk_bf16(o[0], o[1]); w.y = cvt_pk_bf16(o[2], o[3]);
                    *(u32x2*)(ACT + (size_t)row * DFF + ch0 + 4 * n) = w; } } }
    }
};
struct EpiX2 {
    static constexpr bool PERM = false;
    const bf16_t* X1; bf16_t* X2; const float *sa, *sw;
    __device__ __forceinline__ void operator()(const f32x4 (&acc)[2][2][4][2], const pg8::Unit& u, int wr, int wc, int fr, int fq) const {
        const int row0 = u.pm * 256 + wr * 64 + fr, col0 = u.pn * 256 + wc * 32 + 4 * fq;
        f32x4 swv[2][2];
#pragma unroll
        for (int bj = 0; bj < 2; ++bj)
#pragma unroll
            for (int n = 0; n < 2; ++n) swv[bj][n] = *(const f32x4*)(sw + col0 + bj * 128 + n * 16);
        float sav[2][4];
#pragma unroll
        for (int ai = 0; ai < 2; ++ai)
#pragma unroll
            for (int m = 0; m < 4; ++m) sav[ai][m] = sa[row0 + ai * 128 + m * 16];
#pragma unroll
        for (int am = 0; am < 4; ++am) { const int ai = am >> 1, m0 = 2 * (am & 1); f32x4 r[2][2][2];
#pragma unroll
            for (int mm = 0; mm < 2; ++mm) { const size_t off = (size_t)(row0 + ai * 128 + (m0 + mm) * 16) * DM + col0;
#pragma unroll
                for (int bj = 0; bj < 2; ++bj)
#pragma unroll
                    for (int n = 0; n < 2; ++n) r[mm][bj][n] = ld_bf4(X1 + off + bj * 128 + n * 16); }
#pragma unroll
            for (int mm = 0; mm < 2; ++mm) { const size_t off = (size_t)(row0 + ai * 128 + (m0 + mm) * 16) * DM + col0;
#pragma unroll
                for (int bj = 0; bj < 2; ++bj)
#pragma unroll
                    for (int n = 0; n < 2; ++n) { const i32x4 q = __builtin_bit_cast(i32x4, acc[ai][bj][m0 + mm][n]);
                        const f32x4 v = (f32x4){(float)q[0], (float)q[1], (float)q[2], (float)q[3]} * swv[bj][n] * sav[ai][m0 + mm] + r[mm][bj][n];
                        u32x2 w; w.x = cvt_pk_bf16(v[0], v[1]); w.y = cvt_pk_bf16(v[2], v[3]); *(u32x2*)(X2 + off + bj * 128 + n * 16) = w; } } }
    }
};
struct EpiX1Q {
    static constexpr bool PERM = false;
    const float *xp, *xs; bf16_t* X1; const float *sa, *sw;
    __device__ __forceinline__ void operator()(const f32x4 (&acc)[2][2][4][2], const pg8::Unit& u, int wr, int wc, int fr, int fq) const {
        const int row0 = u.pm * 256 + wr * 64 + fr, col0 = u.pn * 256 + wc * 32 + 4 * fq;
        f32x4 swv[2][2];
#pragma unroll
        for (int bj = 0; bj < 2; ++bj)
#pragma unroll
            for (int n = 0; n < 2; ++n) swv[bj][n] = *(const f32x4*)(sw + col0 + bj * 128 + n * 16);
        float sav[2][4];
#pragma unroll
        for (int ai = 0; ai < 2; ++ai)
#pragma unroll
            for (int m = 0; m < 4; ++m) sav[ai][m] = sa[row0 + ai * 128 + m * 16];
#pragma unroll
        for (int am = 0; am < 4; ++am) { const int ai = am >> 1, m0 = 2 * (am & 1); f32x4 r[2][2][2];
#pragma unroll
            for (int mm = 0; mm < 2; ++mm) { const int row = row0 + ai * 128 + (m0 + mm) * 16; const float* xin = (row < MP ? xp + (size_t)row * DM : xs + (size_t)(row - MP) * DM) + col0;
#pragma unroll
                for (int bj = 0; bj < 2; ++bj)
#pragma unroll
                    for (int n = 0; n < 2; ++n) r[mm][bj][n] = *(const f32x4*)(xin + bj * 128 + n * 16); }
#pragma unroll
            for (int mm = 0; mm < 2; ++mm) { const size_t off = (size_t)(row0 + ai * 128 + (m0 + mm) * 16) * DM + col0;
#pragma unroll
                for (int bj = 0; bj < 2; ++bj)
#pragma unroll
                    for (int n = 0; n < 2; ++n) { const i32x4 q = __builtin_bit_cast(i32x4, acc[ai][bj][m0 + mm][n]);
                        const f32x4 v = (f32x4){(float)q[0], (float)q[1], (float)q[2], (float)q[3]} * swv[bj][n] * sav[ai][m0 + mm] + r[mm][bj][n];
                        u32x2 w; w.x = cvt_pk_bf16(v[0], v[1]); w.y = cvt_pk_bf16(v[2], v[3]); *(u32x2*)(X1 + off + bj * 128 + n * 16) = w; } } }
    }
};
struct EpiPart {
    static constexpr bool PERM = false;
    float* P;
    __device__ __forceinline__ void operator()(const f32x4 (&acc)[2][2][4][2], const pg8::Unit& u, int wr, int wc, int fr, int fq) const {
        float* base = P + ((size_t)(u.tl * 8 + u.ks) << 16) + (size_t)(wr * 64 + fr) * 256 + wc * 32 + 4 * fq;
#pragma unroll
        for (int ai = 0; ai < 2; ++ai)
#pragma unroll
            for (int m = 0; m < 4; ++m)
#pragma unroll
                for (int bj = 0; bj < 2; ++bj)
#pragma unroll
                    for (int n = 0; n < 2; ++n) *(f32x4*)(base + (size_t)(ai * 128 + m * 16) * 256 + bj * 128 + n * 16) = acc[ai][bj][m][n];
    }
};
struct EpiPartQ {
    static constexpr bool PERM = false;
    bf16_t* P; const float *sa, *sw;
    __device__ __forceinline__ void operator()(const f32x4 (&acc)[2][2][4][2], const pg8::Unit& u, int wr, int wc, int fr, int fq) const {
        bf16_t* base = P + ((size_t)(u.tl * 8 + u.ks) << 16) + (size_t)(wr * 64 + fr) * 256 + wc * 32 + 4 * fq;
        const int row0 = u.pm * 256 + wr * 64 + fr, col0 = u.pn * 256 + wc * 32 + 4 * fq;
        f32x4 swv[2][2];
#pragma unroll
        for (int bj = 0; bj < 2; ++bj)
#pragma unroll
            for (int n = 0; n < 2; ++n) swv[bj][n] = *(const f32x4*)(sw + col0 + bj * 128 + n * 16);
#pragma unroll
        for (int ai = 0; ai < 2; ++ai)
#pragma unroll
            for (int m = 0; m < 4; ++m) { const float sav = sa[row0 + ai * 128 + m * 16];
#pragma unroll
                for (int bj = 0; bj < 2; ++bj)
#pragma unroll
                    for (int n = 0; n < 2; ++n) { const i32x4 q = __builtin_bit_cast(i32x4, acc[ai][bj][m][n]);
                        const f32x4 v = (f32x4){(float)q[0], (float)q[1], (float)q[2], (float)q[3]} * swv[bj][n] * sav;
                        u32x2 o; o.x = cvt_pk_bf16(v[0], v[1]); o.y = cvt_pk_bf16(v[2], v[3]);
                        *(u32x2*)(base + (size_t)(ai * 128 + m * 16) * 256 + bj * 128 + n * 16) = o; } }
    }
};

__device__ __forceinline__ void p0_transpose_item(const float* W, int N, int k0, int n0, const float* gk, bf16_t* WT, int ldt, int dst_row0, LAS float* scr, int lane, unsigned* cmax = nullptr) {
    const int lq = lane >> 4, n4 = lane & 15; const bool inb = (n0 + 4 * n4) < N;
    f32x4 v[16];
#pragma unroll
    for (int i = 0; i < 16; ++i) v[i] = inb ? __builtin_nontemporal_load((const f32x4*)(W + (size_t)(k0 + 4 * i + lq) * N + n0 + 4 * n4)) : (f32x4){0.f, 0.f, 0.f, 0.f};
    if (gk) {
#pragma unroll
        for (int i = 0; i < 16; ++i) v[i] *= gk[k0 + 4 * i + lq]; }
#pragma unroll
    for (int i = 0; i < 16; ++i) { const int k = 4 * i + lq; *(LAS f32x4*)(scr + k * 64 + 4 * ((n4 ^ (2 * (k >> 3))) & 15)) = v[i]; }
    LDS_WAIT(); asm volatile("" ::: "memory");
    const int c = lane & 7, np = lane >> 3;
#pragma unroll
    for (int j = 0; j < 8; ++j) { const int n = np + 8 * j; const LAS float* sp = scr + (8 * c) * 64 + 4 * ((((n >> 2) ^ (2 * c)) & 15)) + (n & 3);
        u32x4 o; o.x = cvt_pk_bf16(sp[0 * 64], sp[1 * 64]); o.y = cvt_pk_bf16(sp[2 * 64], sp[3 * 64]); o.z = cvt_pk_bf16(sp[4 * 64], sp[5 * 64]); o.w = cvt_pk_bf16(sp[6 * 64], sp[7 * 64]);
        if (n0 + n < N) *(u32x4*)(WT + (size_t)(dst_row0 + n) * ldt + k0 + 8 * c) = o;
        if (cmax) { float mx = fmaxf(fmaxf(fmaxf(fabsf(sp[0 * 64]), fabsf(sp[1 * 64])), fmaxf(fabsf(sp[2 * 64]), fabsf(sp[3 * 64]))), fmaxf(fmaxf(fabsf(sp[4 * 64]), fabsf(sp[5 * 64])), fmaxf(fabsf(sp[6 * 64]), fabsf(sp[7 * 64]))));
            mx = fmaxf(mx, __shfl_xor(mx, 1)); mx = fmaxf(mx, __shfl_xor(mx, 2)); mx = fmaxf(mx, __shfl_xor(mx, 4));
            if (c == 0) atomicMax(cmax + dst_row0 + n, __float_as_uint(mx)); } }
    LDS_WAIT(); asm volatile("" ::: "memory");
}
__device__ __forceinline__ void p0_late_weights(Frame& F, int gw, int NGW) {
    LAS float* scr = (LAS float*)(F.lds + F.wave * 16384);
    constexpr int I_OUT = (DM / 64) * (DM / 64), I_UP = (DM / 64) * (2 * DFF / 64), I_DN = (DFF / 64) * (DM / 64);
    for (int it = gw; it < I_UP + I_DN + I_OUT; it += NGW) {
        int r = it;
        if (r < I_UP) { const int nblk = 2 * DFF / 64, kb = r / nblk, nb = r % nblk; const int n0 = 64 * nb, half = n0 / DFF, j = n0 % DFF;
            p0_transpose_item(F.in[25], 2 * DFF, 64 * kb, n0, F.in[24], WSP(bf16_t, WS_BT3), DM, (j / 128) * 256 + half * 128 + (j % 128), scr, F.lane, (unsigned*)(F.ws + WS_CTL) + CW_CMAX3); continue; } r -= I_UP;
        if (r < I_DN) { const int nblk = DM / 64, kb = r / nblk, nb = r % nblk; p0_transpose_item(F.in[28], DM, 64 * kb, 64 * nb, nullptr, WSP(bf16_t, WS_BT4), DFF, 64 * nb, scr, F.lane); continue; } r -= I_DN;
        { const int nblk = DM / 64, kb = r / nblk, nb = r % nblk; const int k0 = 64 * kb;
          const float* gk = k0 < DRNN ? F.in[16] : F.in[22] - DRNN;
          p0_transpose_item(F.in[23], DM, k0, 64 * nb, gk, WSP(bf16_t, WS_BT2), DM, 64 * nb, scr, F.lane); }
    }
}
constexpr int G1_PER = 26, G1_HI = 2, NGEMM1 = 8 * G1_PER + G1_HI, NSTREAM = 256 - NGEMM1;
__device__ __forceinline__ void p0_prologue(Frame& F) {
    LAS float* scr = (LAS float*)(F.lds + F.wave * 16384);
    const int gw = F.wave * F.G + blockIdx.x, NGW = F.G * 8;
    constexpr int NB_IN = (INC + 63) / 64;
    constexpr int I_IN = (DM / 64) * NB_IN, I_G = 16 * 4 * 4;
    for (int it = gw; it < I_IN + I_G; it += NGW) {
        int r = it;
        if (r < I_IN) { const int kb = r / NB_IN, nb = r % NB_IN; p0_transpose_item(F.in[8], INC, 64 * kb, 64 * nb, F.in[7], WSP(bf16_t, WS_BT1), DM, 64 * nb, scr, F.lane); continue; } r -= I_IN;
        { const int mat = r / 16, rr = r % 16, kb = rr / 4, nb = rr % 4, gate = mat / 8, h = mat % 8, n0 = 64 * nb, hc = n0 / 128, idx = n0 % 128;
          const float* W = (gate ? F.in[13] : F.in[11]) + (size_t)h * 65536;
          p0_transpose_item(W, 256, 64 * kb, n0, nullptr, WSP(bf16_t, WS_BTG), 256, ((h * 2 + hc) * 2 + gate) * 128 + idx, scr, F.lane); }
    }
    if (F.G != 256) p0_late_weights(F, gw, NGW);
    bf16_t* XB = WSP(bf16_t, WS_XB); float* rs1 = WSP(float, WS_RS1);
    for (int m = gw; m < M; m += NGW) {
        const float* xr = (m < MP ? F.in[0] + (size_t)m * DM : F.in[1] + (size_t)(m - MP) * DM);
        f32x4 v[16]; float ss = 0.f;
#pragma unroll
        for (int j = 0; j < 16; ++j) { v[j] = __builtin_nontemporal_load((const f32x4*)(xr + 4 * (F.lane + 64 * j))); ss += (v[j][0] * v[j][0] + v[j][1] * v[j][1]) + (v[j][2] * v[j][2] + v[j][3] * v[j][3]); }
        ss = wave_sum(ss);
        if (F.lane == 0) rs1[m] = rsqrtf(ss * (1.0f / DM) + EPS);
#pragma unroll
        for (int j = 0; j < 16; ++j) { u32x2 w; w.x = cvt_pk_bf16(v[j][0], v[j][1]); w.y = cvt_pk_bf16(v[j][2], v[j][3]); *(u32x2*)(XB + (size_t)m * DM + 4 * (F.lane + 64 * j)) = w; }
    }
    { float* sp8 = WSP(float, WS_SP8); const int gt = blockIdx.x * 512 + F.tid; if (gt < DRNN) sp8[gt] = 8.0f * softplusf_(-F.in[15][gt]); }
}

constexpr int SI_W = 2048, SI_B = SI_W + 128 * 272, SI_X = SI_B + 128 * 272, SI_XP = 144, SI_END = SI_X + 128 * SI_XP;
static_assert(SI_END <= LDSCTL_OFF, "ssd intra LDS map");
typedef unsigned short u16x4 __attribute__((ext_vector_type(4)));
template <int PITCH>
__device__ __forceinline__ void tr_frags(unsigned a, bf16x8 (&f)[4]) {
    u16x4 r[8];
    asm volatile("ds_read_b64_tr_b16 %0, %8 offset:%9\n\tds_read_b64_tr_b16 %1, %8 offset:%10\n\tds_read_b64_tr_b16 %2, %8 offset:%11\n\tds_read_b64_tr_b16 %3, %8 offset:%12\n\t"
                 "ds_read_b64_tr_b16 %4, %8 offset:%13\n\tds_read_b64_tr_b16 %5, %8 offset:%14\n\tds_read_b64_tr_b16 %6, %8 offset:%15\n\tds_read_b64_tr_b16 %7, %8 offset:%16\n\ts_waitcnt lgkmcnt(0)"
                 : "=&v"(r[0]), "=&v"(r[1]), "=&v"(r[2]), "=&v"(r[3]), "=&v"(r[4]), "=&v"(r[5]), "=&v"(r[6]), "=&v"(r[7])
                 : "v"(a), "n"(0 * PITCH), "n"(4 * PITCH), "n"(32 * PITCH), "n"(36 * PITCH), "n"(64 * PITCH), "n"(68 * PITCH), "n"(96 * PITCH), "n"(100 * PITCH) : "memory");
#pragma unroll
    for (int ks = 0; ks < 4; ++ks) f[ks] = (bf16x8){(short)r[2 * ks][0], (short)r[2 * ks][1], (short)r[2 * ks][2], (short)r[2 * ks][3], (short)r[2 * ks + 1][0], (short)r[2 * ks + 1][1], (short)r[2 * ks + 1][2], (short)r[2 * ks + 1][3]};
}
struct SgPre { u32x4 x[2]; };
__device__ __forceinline__ void ssd_head_load(Frame& F, SgPre& P, int bc, int hd) {
    const int row0 = bc * 128, tid = F.tid; const bf16_t* XS = WSP(bf16_t, WS_XS);
#pragma unroll
    for (int k = 0; k < 2; ++k) { const int id = tid + 512 * k, r = id >> 3, c = id & 7; P.x[k] = *(const u32x4*)(XS + (size_t)(row0 + r) * DSSM + hd * 64 + 8 * c); }
}
__device__ __forceinline__ void ssd_group_unit(Frame& F, int bc, int g) {
    LAS float* SC = (LAS float*)(F.lds + SI_END);
    LAS bf16_t* Wl = (LAS bf16_t*)(F.lds + SI_W);
    const int row0 = bc * 128, w = F.wave, tid = F.tid, lane = F.lane, li = lane & 15, lq = lane >> 4;
    const unsigned ldsb = (unsigned)(size_t)F.lds;
    const unsigned tq = (unsigned)(8 * lq + (li >> 2)), tp = (unsigned)(4 * (li & 3));
    const bf16_t* BC = WSP(bf16_t, WS_BC);
    SgPre P; ssd_head_load(F, P, bc, 8 * g);
    { u32x4 bq[4];
#pragma unroll
      for (int k = 0; k < 4; ++k) { const int id = tid + 512 * k, r = id >> 4, c = id & 15; bq[k] = *(const u32x4*)(BC + (size_t)(row0 + r) * 1024 + g * 128 + 8 * c); }
      __syncthreads();
#pragma unroll
      for (int k = 0; k < 4; ++k) { const int id = tid + 512 * k, r = id >> 4, c = id & 15; *(LAS u32x4*)(F.lds + SI_B + r * 272 + 16 * c) = bq[k]; } }
    bf16x8 cf[4];
#pragma unroll
    for (int ks = 0; ks < 4; ++ks) cf[ks] = *(const bf16x8*)(BC + (size_t)(row0 + 16 * w + li) * 1024 + 512 + g * 128 + ks * 32 + 8 * lq);
    asm volatile("s_waitcnt lgkmcnt(0)" ::: "memory");
    __syncthreads();
    f32x4 Gr[8];
#pragma unroll
    for (int sb = 0; sb < 8; ++sb) { Gr[sb] = (f32x4){0.f, 0.f, 0.f, 0.f};
        if (sb <= w) {
#pragma unroll
            for (int ks = 0; ks < 4; ++ks) Gr[sb] = __builtin_amdgcn_mfma_f32_16x16x32_bf16(*(const LAS bf16x8*)(F.lds + SI_B + (16 * sb + li) * 272 + (ks * 32 + 8 * lq) * 2), cf[ks], Gr[sb], 0, 0, 0); } }
    { const int hdw = 8 * g + w; const float* DTA = WSP(float, WS_DTA);
      const float d0 = DTA[(size_t)(row0 + lane) * NH + hdw], d1 = DTA[(size_t)(row0 + 64 + lane) * NH + hdw];
      const float A = -__expf(F.in[20][hdw]);
      float a0 = d0 * A, a1 = d1 * A;
#pragma unroll
      for (int o = 1; o < 64; o <<= 1) { const float t0 = __shfl_up(a0, o), t1 = __shfl_up(a1, o); if (lane >= o) { a0 += t0; a1 += t1; } }
      a1 += __shfl(a0, 63);
      const float last = __shfl(a1, 63);
      LAS float* c = SC + w * 384;
      c[lane] = a0; c[64 + lane] = a1; c[128 + lane] = d0; c[192 + lane] = d1;
      c[256 + lane] = __expf(last - a0) * d0; c[320 + lane] = __expf(last - a1) * d1;
      float* CUM = WSP(float, WS_CUM);
      CUM[(size_t)(row0 + lane) * NH + hdw] = a0; CUM[(size_t)(row0 + 64 + lane) * NH + hdw] = a1;
      if (lane == 0) WSP(float, WS_DEC)[bc * NH + hdw] = __expf(last); }
    bf16x8 btr[4]; tr_frags<272>(ldsb + SI_B + tq * 272 + (16 * w + tp) * 2, btr);
#pragma unroll 1
    for (int hl = 0; hl < 8; ++hl) { const int hd = 8 * g + hl;
        LDS_BARRIER();
#pragma unroll
        for (int k = 0; k < 2; ++k) { const int id = tid + 512 * k, r = id >> 3, c = id & 7; *(LAS u32x4*)(F.lds + SI_X + r * SI_XP + 16 * c) = P.x[k]; }
        LAS float* cumS = SC + hl * 384; LAS float* dtS = cumS + 128; LAS float* decS = cumS + 256;
        LDS_BARRIER();
        ssd_head_load(F, P, bc, hl < 7 ? hd + 1 : hd);
        bf16x8 xf[4][4];
#pragma unroll
        for (int pb = 0; pb < 4; ++pb) tr_frags<SI_XP>(ldsb + SI_X + tq * SI_XP + (pb * 16 + tp) * 2, xf[pb]);
        { const int t = 16 * w + li; const float cum_t = cumS[t];
#pragma unroll
          for (int sb = 0; sb < 8; ++sb) if (sb <= w) {
              const f32x4 cs = *(const LAS f32x4*)(cumS + 16 * sb + 4 * lq), ds = *(const LAS f32x4*)(dtS + 16 * sb + 4 * lq); float wv[4];
#pragma unroll
              for (int r = 0; r < 4; ++r) { const int s2 = 16 * sb + 4 * lq + r; wv[r] = (s2 <= t) ? Gr[sb][r] * __expf(cum_t - cs[r]) * ds[r] : 0.f; }
              u32x2 pw; pw.x = cvt_pk_bf16(wv[0], wv[1]); pw.y = cvt_pk_bf16(wv[2], wv[3]);
              *(LAS u32x2*)(Wl + t * 136 + 16 * sb + 4 * lq) = pw; }
          if ((w & 1) == 0) *(LAS u32x2*)(Wl + t * 136 + 16 * (w + 1) + 4 * lq) = (u32x2){0u, 0u}; }
        asm volatile("s_waitcnt lgkmcnt(0)" ::: "memory");
        { f32x4 ay[4];
#pragma unroll
          for (int pb = 0; pb < 4; ++pb) ay[pb] = (f32x4){0.f, 0.f, 0.f, 0.f};
          const int nks = (w >> 1) + 1;
#pragma unroll
          for (int ks = 0; ks < 4; ++ks) if (ks < nks) { const bf16x8 wf = *(const LAS bf16x8*)(Wl + (16 * w + li) * 136 + ks * 32 + 8 * lq);
#pragma unroll
              for (int pb = 0; pb < 4; ++pb) ay[pb] = __builtin_amdgcn_mfma_f32_16x16x32_bf16(xf[pb][ks], wf, ay[pb], 0, 0, 0); }
          bf16_t* YD = WSP(bf16_t, WS_YD) + (size_t)(row0 + 16 * w + li) * DSSM + hd * 64 + 4 * lq;
#pragma unroll
          for (int pb = 0; pb < 4; ++pb) { u32x2 o; o.x = cvt_pk_bf16(ay[pb][0], ay[pb][1]); o.y = cvt_pk_bf16(ay[pb][2], ay[pb][3]); *(u32x2*)(YD + pb * 16) = o; } }
        { bf16x8 bt[4];
#pragma unroll
          for (int ks = 0; ks < 4; ++ks) { const u32x4 raw = __builtin_bit_cast(u32x4, btr[ks]);
              const f32x4 d0 = *(const LAS f32x4*)(decS + ks * 32 + 8 * lq), d1 = *(const LAS f32x4*)(decS + ks * 32 + 8 * lq + 4);
              u32x4 sc; sc.x = cvt_pk_bf16(bf_lo(raw.x) * d0[0], bf_hi(raw.x) * d0[1]); sc.y = cvt_pk_bf16(bf_lo(raw.y) * d0[2], bf_hi(raw.y) * d0[3]);
              sc.z = cvt_pk_bf16(bf_lo(raw.z) * d1[0], bf_hi(raw.z) * d1[1]); sc.w = cvt_pk_bf16(bf_lo(raw.w) * d1[2], bf_hi(raw.w) * d1[3]);
              bt[ks] = __builtin_bit_cast(bf16x8, sc); }
          float* ST = WSP(float, WS_ST) + ((size_t)(bc * NH + hd) * 64 + li) * 128 + 16 * w + 4 * lq;
#pragma unroll
          for (int pb = 0; pb < 4; ++pb) { f32x4 as = (f32x4){0.f, 0.f, 0.f, 0.f};
#pragma unroll
              for (int ks = 0; ks < 4; ++ks) as = __builtin_amdgcn_mfma_f32_16x16x32_bf16(bt[ks], xf[pb][ks], as, 0, 0, 0);
              *(f32x4*)(ST + (size_t)pb * 16 * 128) = as; } }
    }
}
__device__ __forceinline__ void ssd_intra_all(Frame& F) {
    for (int u = blockIdx.x; u < NCH * NG; u += F.G) ssd_group_unit(F, u >> 2, u & 3);
    __syncthreads();
}
struct SsPre { f32x4 h0[4]; float dt[4]; bf16_t x[4]; };
struct SsBC { u32x2 bq[4][4], cq[4][4]; };
__device__ __forceinline__ void ssd_sample_load(Frame& F, SsPre& P, int s, int hd) {
    const int tid = F.tid, p = tid >> 3, nq = tid & 7, r0 = MP + 4 * s;
    const float* DTA = WSP(float, WS_DTA); const bf16_t* XS = WSP(bf16_t, WS_XS);
    const float* h0p = F.in[4] + (((size_t)s * NH + hd) * 64 + p) * 128 + 4 * nq;
#pragma unroll
    for (int j = 0; j < 4; ++j) P.h0[j] = __builtin_nontemporal_load((const f32x4*)(h0p + 32 * j));
#pragma unroll
    for (int t = 0; t < 4; ++t) { P.dt[t] = DTA[(size_t)(r0 + t) * NH + hd]; P.x[t] = XS[(size_t)(r0 + t) * DSSM + hd * 64 + p]; }
}
__device__ __forceinline__ void ssd_sample_loadbc(Frame& F, SsBC& Q, int s, int g) {
    const int nq = F.tid & 7, r0 = MP + 4 * s; const bf16_t* BC = WSP(bf16_t, WS_BC);
#pragma unroll
    for (int t = 0; t < 4; ++t) { const bf16_t* br = BC + (size_t)(r0 + t) * 1024 + g * 128 + 4 * nq;
#pragma unroll
        for (int j = 0; j < 4; ++j) { Q.bq[t][j] = *(const u32x2*)(br + 32 * j); Q.cq[t][j] = *(const u32x2*)(br + 512 + 32 * j); } }
}
__device__ __forceinline__ void ssd_sample_compute(Frame& F, const SsPre& P, const SsBC& Q, int s, int hd, const LAS float* scb, const LAS float* atab) {
    const int tid = F.tid, p = tid >> 3, nq = tid & 7, r0 = MP + 4 * s;
    const u32x2 (&bq)[4][4] = Q.bq; const u32x2 (&cq)[4][4] = Q.cq;
    const float A = atab[hd];
    float dt[4], cum[4], x[4]; float run = 0.f;
#pragma unroll
    for (int t = 0; t < 4; ++t) { dt[t] = P.dt[t]; run += dt[t] * A; cum[t] = run; x[t] = bf2f(P.x[t]); }
    float yoff[4];
#pragma unroll
    for (int t = 0; t < 4; ++t) { float a = 0.f;
#pragma unroll
        for (int j = 0; j < 4; ++j) a += (bf_lo(cq[t][j].x) * P.h0[j][0] + bf_hi(cq[t][j].x) * P.h0[j][1]) + (bf_lo(cq[t][j].y) * P.h0[j][2] + bf_hi(cq[t][j].y) * P.h0[j][3]);
        yoff[t] = a; }
#pragma unroll
    for (int o = 1; o < 8; o <<= 1) {
#pragma unroll
        for (int t = 0; t < 4; ++t) yoff[t] += __shfl_xor(yoff[t], o); }
    if (nq == 0) {
        float* YD = WSP(float, WS_YD);
#pragma unroll
        for (int t = 0; t < 4; ++t) { float y = __expf(cum[t]) * yoff[t];
#pragma unroll
            for (int s2 = 0; s2 < 4; ++s2) if (s2 <= t) y += scb[t * (t + 1) / 2 + s2] * __expf(cum[t] - cum[s2]) * dt[s2] * x[s2];
            YD[(size_t)(r0 + t) * DSSM + hd * 64 + p] = y; }
    }
    const float dec3 = __expf(cum[3]); float cx[4];
#pragma unroll
    for (int t = 0; t < 4; ++t) cx[t] = __expf(cum[3] - cum[t]) * dt[t] * x[t];
    float* hp = F.out + O_SSH + (((size_t)s * NH + hd) * 64 + p) * 128 + 4 * nq;
#pragma unroll
    for (int j = 0; j < 4; ++j) { f32x4 hn = P.h0[j] * dec3;
#pragma unroll
        for (int t = 0; t < 4; ++t) { hn[0] += bf_lo(bq[t][j].x) * cx[t]; hn[1] += bf_hi(bq[t][j].x) * cx[t]; hn[2] += bf_lo(bq[t][j].y) * cx[t]; hn[3] += bf_hi(bq[t][j].y) * cx[t]; }
        __builtin_nontemporal_store(hn, (f32x4*)(hp + 32 * j)); }
}
__device__ __forceinline__ void ssd_sample_all(Frame& F) {
    LAS float* atab = (LAS float*)F.lds;
    LAS float* scb = atab + 32;
    if (F.tid < NH) atab[F.tid] = -__expf(F.in[20][F.tid]);
    const bf16_t* BC = WSP(bf16_t, WS_BC);
    int start, count; const int c = blockIdx.x;
    if (F.G == 256) { if (c < 32) { count = 10; start = 10 * c; } else { const int i = c - 32; count = i < 192 ? 17 : 16; start = 320 + (i < 192 ? 17 * i : 17 * 192 + 16 * (i - 192)); } }
    else { const int per = (NSQ * NH + F.G - 1) / F.G; start = c * per; count = NSQ * NH - start; count = count < 0 ? 0 : (count > per ? per : count); }
    SsBC Q; int cur = -1;
#pragma unroll 1
    for (int b0 = 0; b0 < count; b0 += 32) { const int nb = count - b0 < 32 ? count - b0 : 32;
        __syncthreads();
        if (F.tid < nb * 10) { const int k = F.tid / 10, pr = F.tid % 10, u = start + b0 + k;
            const int t = pr < 1 ? 0 : pr < 3 ? 1 : pr < 6 ? 2 : 3, s2 = pr - t * (t + 1) / 2, r0 = MP + 4 * (u >> 5), g = (u & 31) >> 3;
            const bf16_t* cr = BC + (size_t)(r0 + t) * 1024 + 512 + g * 128; const bf16_t* br = BC + (size_t)(r0 + s2) * 1024 + g * 128; float a = 0.f;
#pragma unroll
            for (int q = 0; q < 16; ++q) { const u32x4 cv = *(const u32x4*)(cr + 8 * q), bv = *(const u32x4*)(br + 8 * q);
                a += (bf_lo(cv.x) * bf_lo(bv.x) + bf_hi(cv.x) * bf_hi(bv.x)) + (bf_lo(cv.y) * bf_lo(bv.y) + bf_hi(cv.y) * bf_hi(bv.y)) + (bf_lo(cv.z) * bf_lo(bv.z) + bf_hi(cv.z) * bf_hi(bv.z)) + (bf_lo(cv.w) * bf_lo(bv.w) + bf_hi(cv.w) * bf_hi(bv.w)); }
            scb[k * 16 + pr] = a; }
        __syncthreads();
        SsPre A, B; const int ub = start + b0, ulast = ub + nb - 1;
        ssd_sample_load(F, A, ub >> 5, ub & 31);
        FULL_FENCE();
#pragma unroll 1
        for (int k = 0; k < nb; k += 2) {
            const int u = ub + k, u1 = u + 1 < ulast ? u + 1 : ulast, u2 = u + 2 < ulast ? u + 2 : ulast;
            if ((u >> 3) != cur) { ssd_sample_loadbc(F, Q, u >> 5, (u & 31) >> 3); cur = u >> 3; }
            ssd_sample_load(F, B, u1 >> 5, u1 & 31);
            FULL_FENCE();
            ssd_sample_compute(F, A, Q, u >> 5, u & 31, scb + k * 16, atab);
            FULL_FENCE();
            if (k + 1 < nb) { if ((u1 >> 3) != cur) { ssd_sample_loadbc(F, Q, u1 >> 5, (u1 & 31) >> 3); cur = u1 >> 3; }
                ssd_sample_load(F, A, u2 >> 5, u2 & 31);
                FULL_FENCE();
                ssd_sample_compute(F, B, Q, u1 >> 5, u1 & 31, scb + (k + 1) * 16, atab);
                FULL_FENCE(); }
        }
    }
}
__device__ __forceinline__ void p4_scan(Frame& F) {
    const unsigned* AB = WSP(unsigned, WS_AB); const bf16_t* G2 = WSP(bf16_t, WS_G2); bf16_t* CAT = WSP(bf16_t, WS_CAT); float* SSQ = WSP(float, WS_SSQRG);
    LAS f32x2* carr = (LAS f32x2*)F.lds;
    for (int u = blockIdx.x; u < NB * 64; u += F.G) {
        const int b = u >> 6, slab = u & 63, cl = F.tid & 31, seg = F.tid >> 5, ch = slab * 32 + cl, rowb = b * SEQ + seg * 128;
        float Ap = 1.f, hl = 0.f;
#pragma unroll 1
        for (int tt = 0; tt < 128; tt += 32) { unsigned v[32];
#pragma unroll
            for (int k = 0; k < 32; ++k) v[k] = AB[(size_t)(rowb + tt + k) * DRNN + ch];
#pragma unroll
            for (int k = 0; k < 32; ++k) { const float a = 1.0f - bf_lo(v[k]); Ap *= a; hl = a * hl + bf_hi(v[k]); } }
        __syncthreads();
        carr[seg * 32 + cl] = (f32x2){Ap, hl};
        __syncthreads();
        float h = 0.f;
        for (int s2 = 0; s2 < seg; ++s2) { const f32x2 c = carr[s2 * 32 + cl]; h = c[0] * h + c[1]; }
#pragma unroll 1
        for (int tt = 0; tt < 128; tt += 32) { unsigned v[32]; float gt[32];
#pragma unroll
            for (int k = 0; k < 32; ++k) { v[k] = AB[(size_t)(rowb + tt + k) * DRNN + ch]; gt[k] = bf2f(G2[(size_t)(rowb + tt + k) * 4096 + ch]); }
            float q[32];
#pragma unroll
            for (int k = 0; k < 32; ++k) { h = (1.0f - bf_lo(v[k])) * h + bf_hi(v[k]); const float o = h * gt[k];
                CAT[(size_t)(rowb + tt + k) * DM + ch] = (bf16_t)(cvt_pk_bf16(o, 0.f) & 0xffffu); q[k] = o * o; }
#define SCAN_BFLY(HB) do { const bool up = (cl & (HB)) != 0; _Pragma("unroll") for (int k = 0; k < (HB); ++k) { const float send = up ? q[k] : q[k + (HB)], keep = up ? q[k + (HB)] : q[k]; q[k] = keep + __shfl_xor(send, (HB)); } } while (0)
            SCAN_BFLY(16); SCAN_BFLY(8); SCAN_BFLY(4); SCAN_BFLY(2); SCAN_BFLY(1);
#undef SCAN_BFLY
            SSQ[(size_t)(rowb + tt + cl) * 64 + slab] = q[0]; }
        if (seg == 15) F.out[O_PRGH + (size_t)b * DRNN + ch] = h;
    }
    { const size_t gt = (size_t)blockIdx.x * 512 + F.tid, NT = (size_t)F.G * 512;
      for (size_t it = gt; it < (size_t)NSQ * DRNN; it += NT) { const int s = (int)(it >> 11), ch = (int)(it & 2047); float h = F.in[2][it];
#pragma unroll
          for (int t = 0; t < 4; ++t) { const int row = MP + 4 * s + t; const unsigned v = AB[(size_t)row * DRNN + ch]; h = (1.0f - bf_lo(v)) * h + bf_hi(v);
              const float o = h * bf2f(G2[(size_t)row * 4096 + ch]); CAT[(size_t)row * DM + ch] = (bf16_t)(cvt_pk_bf16(o, 0.f) & 0xffffu);
              const float q = wave_sum(o * o);
              if (F.lane == 0) { SSQ[(size_t)row * 64 + 2 * (ch >> 6)] = q; SSQ[(size_t)row * 64 + 2 * (ch >> 6) + 1] = 0.f; } }
          F.out[O_SRGH + it] = h; } }
    { const float* ST = WSP(float, WS_ST); const float* DEC = WSP(float, WS_DEC); bf16_t* HPB = WSP(bf16_t, WS_HPB);
      const size_t gt = (size_t)blockIdx.x * 512 + F.tid, NT = (size_t)F.G * 512;
      for (size_t it = gt; it < (size_t)NB * NH * 64 * 32; it += NT) { const int b = (int)(it >> 16), rem = (int)(it & 65535), hd = rem >> 11, e = rem & 2047;
          f32x4 h = (f32x4){0.f, 0.f, 0.f, 0.f}; f32x4 stv[16]; float dcv[16];
#pragma unroll
          for (int c = 0; c < 16; ++c) { const int bc = b * 16 + c; stv[c] = __builtin_nontemporal_load((const f32x4*)(ST + ((size_t)(bc * NH + hd) * 8192) + 4 * e)); dcv[c] = DEC[bc * NH + hd]; }
#pragma unroll
          for (int c = 0; c < 16; ++c) { const int bc = b * 16 + c; const size_t o = ((size_t)(bc * NH + hd) * 8192) + 4 * e;
              u32x2 w; w.x = cvt_pk_bf16(h[0], h[1]); w.y = cvt_pk_bf16(h[2], h[3]); *(u32x2*)(HPB + o) = w;
              h = h * dcv[c] + stv[c]; }
          *(f32x4*)(F.out + O_PSH + ((size_t)(b * NH + hd) * 8192) + 4 * e) = h; } }
}

constexpr int P5_HT_OFF = 8 * 16640;
static_assert(P5_HT_OFF + 64 * 272 <= LDSCTL_OFF, "P5 LDS map");
__device__ __forceinline__ void p5_unit(Frame& F, int g, int bc) {
    const int w = F.wave, lane = F.lane, li = lane & 15, lq = lane >> 4, row0 = bc * 128, row = row0 + 16 * w + li;
    const bf16_t* BC = WSP(bf16_t, WS_BC); bf16_t* CAT = WSP(bf16_t, WS_CAT);
    LAS unsigned char* U = F.lds + w * 16640;
    bf16x8 cf[4];
#pragma unroll
    for (int ks = 0; ks < 4; ++ks) cf[ks] = *(const bf16x8*)(BC + (size_t)row * 1024 + 512 + g * 128 + ks * 32 + 8 * lq);
    float ss = 0.f;
    const bf16_t* HPB = WSP(bf16_t, WS_HPB); const bf16_t* XS = WSP(bf16_t, WS_XS); const bf16_t* YD = WSP(bf16_t, WS_YD); const float* CUM = WSP(float, WS_CUM); const bf16_t* G2 = WSP(bf16_t, WS_G2);
    LAS unsigned char* HT = F.lds + P5_HT_OFF;
    u32x4 hq[2];
#pragma unroll
    for (int k = 0; k < 2; ++k) { const int id = F.tid + 512 * k; hq[k] = *(const u32x4*)(HPB + (size_t)(bc * NH + 8 * g) * 8192 + (id >> 4) * 128 + 8 * (id & 15)); }
#pragma unroll 1
    for (int hl = 0; hl < 8; ++hl) { const int hd = 8 * g + hl;
        LDS_BARRIER();
#pragma unroll
        for (int k = 0; k < 2; ++k) { const int id = F.tid + 512 * k; *(LAS u32x4*)(HT + (id >> 4) * 272 + 16 * (id & 15)) = hq[k]; }
        u32x2 yw[4], zw[4], xw[4];
        const float ecr = CUM[(size_t)row * NH + hd], Dh = F.in[21][hd];
#pragma unroll
        for (int pb = 0; pb < 4; ++pb) { const int ch = hd * 64 + pb * 16 + 4 * lq;
            yw[pb] = __builtin_nontemporal_load((const u32x2*)(YD + (size_t)row * DSSM + ch)); zw[pb] = *(const u32x2*)(G2 + (size_t)row * 4096 + 2048 + ch); xw[pb] = *(const u32x2*)(XS + (size_t)row * DSSM + ch); }
        { const int hn = hl < 7 ? hd + 1 : hd;
#pragma unroll
          for (int k = 0; k < 2; ++k) { const int id = F.tid + 512 * k; hq[k] = *(const u32x4*)(HPB + (size_t)(bc * NH + hn) * 8192 + (id >> 4) * 128 + 8 * (id & 15)); } }
        LDS_BARRIER();
        const float ec = __expf(ecr);
#pragma unroll
        for (int pb = 0; pb < 4; ++pb) { f32x4 a = (f32x4){0.f, 0.f, 0.f, 0.f};
#pragma unroll
            for (int ks = 0; ks < 4; ++ks) a = __builtin_amdgcn_mfma_f32_16x16x32_bf16(*(const LAS bf16x8*)(HT + (pb * 16 + li) * 272 + (ks * 32 + 8 * lq) * 2), cf[ks], a, 0, 0, 0);
            const float xv[4] = {bf_lo(xw[pb].x), bf_hi(xw[pb].x), bf_lo(xw[pb].y), bf_hi(xw[pb].y)}; const float zv[4] = {bf_lo(zw[pb].x), bf_hi(zw[pb].x), bf_lo(zw[pb].y), bf_hi(zw[pb].y)}; float v[4];
            const float yv[4] = {bf_lo(yw[pb].x), bf_hi(yw[pb].x), bf_lo(yw[pb].y), bf_hi(yw[pb].y)};
#pragma unroll
            for (int r = 0; r < 4; ++r) { const float y = yv[r] + ec * a[r] + Dh * xv[r]; v[r] = y * zv[r]; ss += v[r] * v[r]; }
            u32x2 o; o.x = cvt_pk_bf16(v[0], v[1]); o.y = cvt_pk_bf16(v[2], v[3]);
            *(LAS u32x2*)(U + li * 1040 + (hl * 64 + pb * 16 + 4 * lq) * 2) = o; }
    }
    ss += __shfl_xor(ss, 16); ss += __shfl_xor(ss, 32);
    const float rs = rsqrtf(ss * (1.0f / 512.0f) + EPS);
    asm volatile("s_waitcnt lgkmcnt(0)" ::: "memory");
#pragma unroll 4
    for (int j = 0; j < 16; ++j) { const float rj = __shfl(rs, j); u32x4 v = *(const LAS u32x4*)(U + j * 1040 + lane * 16);
        v.x = cvt_pk_bf16(bf_lo(v.x) * rj, bf_hi(v.x) * rj); v.y = cvt_pk_bf16(bf_lo(v.y) * rj, bf_hi(v.y) * rj); v.z = cvt_pk_bf16(bf_lo(v.z) * rj, bf_hi(v.z) * rj); v.w = cvt_pk_bf16(bf_lo(v.w) * rj, bf_hi(v.w) * rj);
        *(u32x4*)(CAT + (size_t)(row0 + 16 * w + j) * DM + DRNN + g * 512 + lane * 8) = v; }
    asm volatile("s_waitcnt lgkmcnt(0)" ::: "memory");
}
__device__ __forceinline__ void p5_norms(Frame& F, bool rg_rows) {
    const int gw = F.wave * F.G + blockIdx.x, NGW = F.G * 8;
    if (rg_rows && gw < M) { const float* SSQ = WSP(float, WS_SSQRG); bf16_t* CAT = WSP(bf16_t, WS_CAT);
      const int rlast = gw + ((M - 1 - gw) / NGW) * NGW;
      float qa, qb; u32x4 ca[4], cb[4];
#define P5_RG_LOAD(q_, c_, r_) do { q_ = SSQ[(size_t)(r_) * 64 + F.lane]; _Pragma("unroll") for (int j = 0; j < 4; ++j) c_[j] = *(const u32x4*)(CAT + (size_t)(r_) * DM + 8 * (F.lane + 64 * j)); } while (0)
#define P5_RG_FIN(q_, c_, r_) do { const float rs = rsqrtf(wave_sum(q_) * (1.0f / DRNN) + EPS); _Pragma("unroll") for (int j = 0; j < 4; ++j) { u32x4 v = c_[j]; \
          v.x = cvt_pk_bf16(bf_lo(v.x) * rs, bf_hi(v.x) * rs); v.y = cvt_pk_bf16(bf_lo(v.y) * rs, bf_hi(v.y) * rs); v.z = cvt_pk_bf16(bf_lo(v.z) * rs, bf_hi(v.z) * rs); v.w = cvt_pk_bf16(bf_lo(v.w) * rs, bf_hi(v.w) * rs); \
          *(u32x4*)(CAT + (size_t)(r_) * DM + 8 * (F.lane + 64 * j)) = v; } } while (0)
      P5_RG_LOAD(qa, ca, gw);
#pragma unroll 1
      for (int row = gw; row <= rlast; row += 2 * NGW) {
          const int r1 = row + NGW < rlast ? row + NGW : rlast, r2 = row + 2 * NGW < rlast ? row + 2 * NGW : rlast;
          const bool two = row + NGW <= rlast;
          P5_RG_LOAD(qb, cb, r1);
          FULL_FENCE();
          P5_RG_FIN(qa, ca, row); FULL_FENCE();
          if (two) { P5_RG_LOAD(qa, ca, r2); FULL_FENCE(); P5_RG_FIN(qb, cb, r1); FULL_FENCE(); }
      }
#undef P5_RG_LOAD
#undef P5_RG_FIN
    }
    { const float* YD = WSP(float, WS_YD); const bf16_t* G2 = WSP(bf16_t, WS_G2); const bf16_t* XS = WSP(bf16_t, WS_XS); bf16_t* CAT = WSP(bf16_t, WS_CAT);
      for (int it = gw; it < MS * NG; it += NGW) { const int row = MP + (it >> 2), g = it & 3, ch = g * 512 + 8 * F.lane; const float Dh = F.in[21][ch >> 6];
          const f32x4 y0 = *(const f32x4*)(YD + (size_t)row * DSSM + ch), y1 = *(const f32x4*)(YD + (size_t)row * DSSM + ch + 4);
          const f32x4 z0 = ld_bf4(G2 + (size_t)row * 4096 + 2048 + ch), z1 = ld_bf4(G2 + (size_t)row * 4096 + 2048 + ch + 4);
          const u32x4 xw = *(const u32x4*)(XS + (size_t)row * DSSM + ch);
          const float xv[8] = {bf_lo(xw.x), bf_hi(xw.x), bf_lo(xw.y), bf_hi(xw.y), bf_lo(xw.z), bf_hi(xw.z), bf_lo(xw.w), bf_hi(xw.w)};
          float v[8]; float ss = 0.f;
#pragma unroll
          for (int e = 0; e < 8; ++e) { const float y = (e < 4 ? y0[e & 3] : y1[e & 3]) + Dh * xv[e]; const float z = e < 4 ? z0[e & 3] : z1[e & 3]; v[e] = y * z; ss += v[e] * v[e]; }
          const float rs = rsqrtf(wave_sum(ss) * (1.0f / 512.0f) + EPS);
          u32x4 o; o.x = cvt_pk_bf16(v[0] * rs, v[1] * rs); o.y = cvt_pk_bf16(v[2] * rs, v[3] * rs); o.z = cvt_pk_bf16(v[4] * rs, v[5] * rs); o.w = cvt_pk_bf16(v[6] * rs, v[7] * rs);
          *(u32x4*)(CAT + (size_t)row * DM + DRNN + ch) = o; } }
    for (int u = blockIdx.x; u < NCH * NG; u += F.G) p5_unit(F, u & 3, u >> 2);
}

constexpr int G3_BUSY = ((M / 256) * (2 * DFF / 256)) % 256;
static_assert(G3_BUSY > 0 && G3_BUSY < 256, "up GEMM tail");
constexpr int REM_FIRST = 512, REM_N = 32;
__device__ __forceinline__ void rem_table(Frame& F, LAS signed char* rem) {
    for (int i = F.tid; i < (M / 256) * 16; i += 512) rem[i] = -1;
    __syncthreads();
    if (F.G == 256 && F.tid < REM_N) { pg8::StaticOrder S; S.init(M, DM, F.G, 0); pg8::Unit u; S.tile_of(REM_FIRST + F.tid, u); rem[u.pm * 16 + u.pn] = (signed char)F.tid; }
    __syncthreads();
}
__device__ __forceinline__ void p7_row_load(const bf16_t* X1, int row, int lane, u32x2 (&w)[16]) {
#pragma unroll
    for (int j = 0; j < 16; ++j) w[j] = *(const u32x2*)(X1 + (size_t)row * DM + 256 * j + 4 * lane);
}
__device__ __forceinline__ void p7_row_finish(Frame& F, const LAS signed char* rem, int row, const u32x2 (&w)[16]) {
    const bf16_t* PART = WSP(bf16_t, WS_PART); bf16_t* X1 = WSP(bf16_t, WS_X1); unsigned char* X1Q = WSP(unsigned char, WS_X1B); float* RF3 = WSP(float, WS_RF3);
    bf16_t* xr = X1 + (size_t)row * DM; const float* xin = (row < MP ? F.in[0] + (size_t)row * DM : F.in[1] + (size_t)(row - MP) * DM);
    f32x4 v[16]; float ss = 0.f, mx = 0.f;
#pragma unroll
    for (int j = 0; j < 16; ++j) { const int c = 256 * j + 4 * F.lane; const int tl = rem[(row >> 8) * 16 + j];
        if (tl < 0) v[j] = (f32x4){bf_lo(w[j].x), bf_hi(w[j].x), bf_lo(w[j].y), bf_hi(w[j].y)};
        else { f32x4 a = *(const f32x4*)(xin + c);
#pragma unroll
            for (int ks = 0; ks < 8; ++ks) a += ld_bf4(PART + ((size_t)(tl * 8 + ks) << 16) + (row & 255) * 256 + 4 * F.lane);
            u32x2 q; q.x = cvt_pk_bf16(a[0], a[1]); q.y = cvt_pk_bf16(a[2], a[3]); *(u32x2*)(xr + c) = q;
            v[j] = (f32x4){bf_lo(q.x), bf_hi(q.x), bf_lo(q.y), bf_hi(q.y)}; }
        ss += (v[j][0] * v[j][0] + v[j][1] * v[j][1]) + (v[j][2] * v[j][2] + v[j][3] * v[j][3]);
        mx = fmaxf(mx, fmaxf(fmaxf(fabsf(v[j][0]), fabsf(v[j][1])), fmaxf(fabsf(v[j][2]), fabsf(v[j][3])))); }
    ss = wave_sum(ss);
#pragma unroll
    for (int o = 1; o < 64; o <<= 1) mx = fmaxf(mx, __shfl_xor(mx, o));
    mx = fmaxf(mx, 1e-30f);
    if (F.lane == 0) RF3[row] = rsqrtf(ss * (1.0f / DM) + EPS) * mx * (1.0f / 127.0f);
    const float inv = 127.0f / mx;
#pragma unroll
    for (int j = 0; j < 16; ++j) *(unsigned*)(X1Q + (size_t)row * DM + 256 * j + 4 * F.lane) = q8_pack4(v[j][0], v[j][1], v[j][2], v[j][3], inv);
}
__device__ __forceinline__ void p7_x1_rows(Frame& F) {
    LAS signed char* rem = (LAS signed char*)F.lds; rem_table(F, rem);
    const bf16_t* X1 = WSP(bf16_t, WS_X1);
    const int gw = F.wave * F.G + blockIdx.x, NGW = F.G * 8;
    if (gw >= M) return;
    const int rlast = gw + ((M - 1 - gw) / NGW) * NGW;
    u32x2 wa[16], wb[16];
    p7_row_load(X1, gw, F.lane, wa);
#pragma unroll 1
    for (int row = gw; row <= rlast; row += 2 * NGW) {
        const int r1 = row + NGW < rlast ? row + NGW : rlast, r2 = row + 2 * NGW < rlast ? row + 2 * NGW : rlast;
        p7_row_load(X1, r1, F.lane, wb); FULL_FENCE();
        p7_row_finish(F, rem, row, wa); FULL_FENCE();
        if (row + NGW <= rlast) { p7_row_load(X1, r2, F.lane, wa); FULL_FENCE(); p7_row_finish(F, rem, r1, wb); FULL_FENCE(); }
    }
}
__device__ __forceinline__ void pf_row_finish(Frame& F, const LAS signed char* rem, int row, const u32x2 (&w)[16], const f32x4 (&gfv)[16]) {
    const bf16_t* PART = WSP(bf16_t, WS_PART); const bf16_t* X1 = WSP(bf16_t, WS_X1);
    float* o = F.out + (size_t)row * DM; f32x4 v[16]; float ss = 0.f;
#pragma unroll
    for (int j = 0; j < 16; ++j) { const int c = 256 * j + 4 * F.lane; const int tl = rem[(row >> 8) * 16 + j];
        if (tl < 0) v[j] = (f32x4){bf_lo(w[j].x), bf_hi(w[j].x), bf_lo(w[j].y), bf_hi(w[j].y)};
        else { f32x4 a = ld_bf4(X1 + (size_t)row * DM + c);
#pragma unroll
            for (int ks = 0; ks < 8; ++ks) a += ld_bf4(PART + ((size_t)(tl * 8 + ks) << 16) + (row & 255) * 256 + 4 * F.lane);
            v[j] = a; }
        ss += (v[j][0] * v[j][0] + v[j][1] * v[j][1]) + (v[j][2] * v[j][2] + v[j][3] * v[j][3]); }
    const float rs = rsqrtf(wave_sum(ss) * (1.0f / DM) + EPS);
#pragma unroll
    for (int j = 0; j < 16; ++j) *(f32x4*)(o + 256 * j + 4 * F.lane) = v[j] * rs * gfv[j];
}
__device__ __forceinline__ void p_final(Frame& F) {
    LAS signed char* rem = (LAS signed char*)F.lds; rem_table(F, rem);
    const bf16_t* X2B = WSP(bf16_t, WS_X2B); const float* gf = F.in[29];
    const int gw = F.wave * F.G + blockIdx.x, NGW = F.G * 8;
    if (gw >= M) return;
    f32x4 gfv[16];
#pragma unroll
    for (int j = 0; j < 16; ++j) gfv[j] = *(const f32x4*)(gf + 256 * j + 4 * F.lane);
    const int rlast = gw + ((M - 1 - gw) / NGW) * NGW;
    u32x2 wa[16], wb[16];
    p7_row_load(X2B, gw, F.lane, wa);
#pragma unroll 1
    for (int row = gw; row <= rlast; row += 2 * NGW) {
        const int r1 = row + NGW < rlast ? row + NGW : rlast, r2 = row + 2 * NGW < rlast ? row + 2 * NGW : rlast;
        p7_row_load(X2B, r1, F.lane, wb); FULL_FENCE();
        pf_row_finish(F, rem, row, wa, gfv); FULL_FENCE();
        if (row + NGW <= rlast) { p7_row_load(X2B, r2, F.lane, wa); FULL_FENCE(); pf_row_finish(F, rem, r1, wb, gfv); FULL_FENCE(); }
    }
}

constexpr int NPH = 12;
__global__ void __launch_bounds__(512, 2) mk_fwd(Args args) {
    extern __shared__ __attribute__((aligned(16))) unsigned char lds_raw[];
    Frame F;
    F.lds = (LAS unsigned char*)lds_raw; F.tid = threadIdx.x; F.lane = F.tid & 63; F.wave = __builtin_amdgcn_readfirstlane(F.tid >> 6); F.G = gridDim.x;
#pragma unroll
    for (int i = 0; i < 30; ++i) F.in[i] = args.in[i];
    F.out = args.out; F.ws = args.ws;
    volatile LAS unsigned* MISC = (volatile LAS unsigned*)(F.lds + LDSCTL_OFF);
    if (F.tid < 64) MISC[F.tid] = 0u;
    __syncthreads();
    unsigned* ctl = (unsigned*)(F.ws + WS_CTL);
    XcdBarrier bar = xcd_barrier_post(ctl + CW_BAR + args.li * XCD_BAR_WORDS, MISC + 8);
    const int lo = args.ph_lo, hi = args.ph_hi;
#ifndef PH_MASK
#define PH_MASK 0xfff
#endif
#define IN(k) (((PH_MASK >> (k)) & 1) && lo <= (k) && (k) < hi)
#define SEAM(k) do { if (IN(k) && IN((k) + 1)) xcd_barrier(bar); } while (0)

    if (IN(0)) { p0_prologue(F); } SEAM(0);
    if (IN(1)) {
        const bool roles = (F.G == 256);
        const int x = (int)blockIdx.x & 7, j = (int)blockIdx.x >> 3; const bool is_gemm = !roles || j < G1_PER + (x < G1_HI ? 1 : 0);
        if (!is_gemm) { const int sidx = (j == G1_PER) ? x - G1_HI : (8 - G1_HI) + (j - G1_PER - 1) * 8 + x; p0_late_weights(F, sidx * 8 + F.wave, NSTREAM * 8); }
        else { pg8::Gemm g{WSP(bf16_t, WS_XB), WSP(bf16_t, WS_BT1), M, N1P, DM, DM, DM}; pg8::StaticOrder S0; S0.init(M, N1P, roles ? NGEMM1 : F.G, (int)blockIdx.x);
            pg8::ChunkOrder S{S0, roles ? G1_PER : ((F.G & 7) == 0 ? F.G >> 3 : 0), roles ? G1_HI : 0};
            EpiProjConv E{F.ws, F.out, F.in[9], F.in[10], F.in[17], F.in[18], F.in[19], F.in[3], F.in[5], (LAS float*)(F.lds + RING_BYTES)};
            pg8::gemm_phase<EpiProjConv, pg8::GeomPlain, pg8::ChunkOrder, true>(F.lds, g, S, E); } } SEAM(1);
    if (IN(3)) {
#ifndef P3_REP
#define P3_REP 0
#endif
        { pg8::Gemm g{WSP(bf16_t, WS_XCB), WSP(bf16_t, WS_BTG), M, 16 * 256, 256, DRNN, 256}; pg8::StaticOrder S; S.init(M, 16 * 256, F.G, (int)blockIdx.x);
          EpiGates E{WSP(unsigned, WS_AB), WSP(bf16_t, WS_XCB), F.in[12], F.in[14], WSP(float, WS_SP8)};
          pg8::gemm_phase<EpiGates, pg8::GeomGates, pg8::StaticOrder, true>(F.lds, g, S, E);
          if (P3_REP == 1) { pg8::gemm_phase<EpiGates, pg8::GeomGates, pg8::StaticOrder, true>(F.lds, g, S, E); pg8::gemm_phase<EpiGates, pg8::GeomGates, pg8::StaticOrder, true>(F.lds, g, S, E); pg8::gemm_phase<EpiGates, pg8::GeomGates, pg8::StaticOrder, true>(F.lds, g, S, E); }
        }
        ssd_intra_all(F);
        if (P3_REP == 2) { ssd_intra_all(F); ssd_intra_all(F); ssd_intra_all(F); }
        ssd_sample_all(F);
        if (P3_REP == 3) { ssd_sample_all(F); ssd_sample_all(F); ssd_sample_all(F); }
    } SEAM(3);
    if (IN(4)) { p4_scan(F); } SEAM(4);
    if (IN(5)) {
        rotq_rows_i8<2>(WSP(bf16_t, WS_BT2), WSP(unsigned char, WS_BT2Q), WSP(float, WS_SW2), DM, F.wave * F.G + (int)blockIdx.x, F.G * 8, F.lane);
        p5_norms(F, false);
        xcd_barrier(bar);
        rotq_rows_i8<2, true>(WSP(bf16_t, WS_CAT), WSP(unsigned char, WS_CATQ), WSP(float, WS_SA2), M, F.wave * F.G + (int)blockIdx.x, F.G * 8, F.lane, WSP(float, WS_SSQRG)); } SEAM(5);
    if (IN(6)) { pg8::Gemm g{WSP(bf16_t, WS_CATQ), WSP(bf16_t, WS_BT2Q), M, DM, DM / 2, DM / 2, DM / 2}; pg8::StaticOrder S; S.init(M, DM, F.G, (int)blockIdx.x);
        const bool split = (F.G == 256); if (split) S.limit = REM_FIRST;
        EpiX1Q E{F.in[0], F.in[1], WSP(bf16_t, WS_X1), WSP(float, WS_SA2), WSP(float, WS_SW2)};
        pg8::gemm_phase<EpiX1Q, pg8::GeomPlain, pg8::StaticOrder, true, true>(F.lds, g, S, E);
        if (split) { pg8::Gemm g2{WSP(bf16_t, WS_CATQ), WSP(bf16_t, WS_BT2Q), M, DM, DM / 16, DM / 2, DM / 2}; pg8::SplitOrder S2{S, REM_FIRST, REM_N, (int)blockIdx.x}; EpiPartQ E2{WSP(bf16_t, WS_PART), WSP(float, WS_SA2), WSP(float, WS_SW2)};
            pg8::gemm_phase<EpiPartQ, pg8::GeomSplit, pg8::SplitOrder, true, true>(F.lds, g2, S2, E2); } } SEAM(6);
    if (IN(7)) { p7_x1_rows(F);
        quant_rows_i8(WSP(bf16_t, WS_BT3), WSP(unsigned char, WS_BT3Q), ctl + CW_CMAX3, 2 * DFF, DM, (size_t)blockIdx.x * 512 + F.tid, (size_t)F.G * 512);
        if (F.G != 256) rotq_rows_i8(WSP(bf16_t, WS_BT4), WSP(unsigned char, WS_BT4Q), WSP(float, WS_SW4), DM, blockIdx.x * 8 + F.wave, F.G * 8, F.lane); } SEAM(7);
    if (IN(8)) { pg8::Gemm g{WSP(bf16_t, WS_X1B), WSP(bf16_t, WS_BT3Q), M, 2 * DFF, DM / 2, DM / 2, DM / 2}; pg8::StaticOrder S; S.init(M, 2 * DFF, F.G, (int)blockIdx.x);
        EpiUpConv E{WSP(bf16_t, WS_ACT), WSP(float, WS_RF3), ctl + CW_CMAX3, F.out, F.in[26], F.in[27], F.in[6], (LAS float*)(F.lds + RING_BYTES), WSP(unsigned long long, WS_HALO), ctl + CW_HFLAG, ctl + CW_TMO};
        pg8::gemm_phase<EpiUpConv, pg8::GeomPlain, pg8::StaticOrder, true, true>(F.lds, g, S, E);
        if (F.G == 256 && blockIdx.x >= G3_BUSY) rotq_rows_i8(WSP(bf16_t, WS_BT4), WSP(unsigned char, WS_BT4Q), WSP(float, WS_SW4), DM, ((int)blockIdx.x - G3_BUSY) * 8 + F.wave, (256 - G3_BUSY) * 8, F.lane); } SEAM(8);
    if (IN(9)) { rotq_rows_i8(WSP(bf16_t, WS_ACT), WSP(unsigned char, WS_ACTQ), WSP(float, WS_SA4), M, F.wave * F.G + (int)blockIdx.x, F.G * 8, F.lane); } SEAM(9);
    if (IN(10)) { pg8::Gemm g{WSP(bf16_t, WS_ACTQ), WSP(bf16_t, WS_BT4Q), M, DM, DFF / 2, DFF / 2, DFF / 2}; pg8::StaticOrder S; S.init(M, DM, F.G, (int)blockIdx.x);
        const bool split = (F.G == 256); if (split) S.limit = REM_FIRST;
        EpiX2 E{WSP(bf16_t, WS_X1), WSP(bf16_t, WS_X2B), WSP(float, WS_SA4), WSP(float, WS_SW4)};
        pg8::gemm_phase<EpiX2, pg8::GeomPlain, pg8::StaticOrder, true, true>(F.lds, g, S, E);
        if (split) { pg8::Gemm g2{WSP(bf16_t, WS_ACTQ), WSP(bf16_t, WS_BT4Q), M, DM, DFF / 16, DFF / 2, DFF / 2}; pg8::SplitOrder S2{S, REM_FIRST, REM_N, (int)blockIdx.x}; EpiPartQ E2{WSP(bf16_t, WS_PART), WSP(float, WS_SA4), WSP(float, WS_SW4)};
            pg8::gemm_phase<EpiPartQ, pg8::GeomSplit, pg8::SplitOrder, true, true>(F.lds, g2, S2, E2); } } SEAM(10);
    if (IN(11)) { p_final(F); }
#undef IN
#undef SEAM
}

extern "C" void kernel_launch(void* const* d_in, const int* in_sizes, int n_in, void* d_out, int out_size, void* d_ws, size_t ws_size, hipStream_t stream) {
    static int grid = 0;
    if (grid == 0) {
        if (n_in != 30 || (size_t)out_size != O_END || ws_size < WS_END) { fprintf(stderr, "kernel_launch: unexpected shapes (n_in %d out %d ws %zu need %zu)\n", n_in, out_size, ws_size, (size_t)WS_END); grid = -1; return; }
        int dev = 0, cus = 0, per_cu = 0;
        if (hipGetDevice(&dev) != hipSuccess || hipDeviceGetAttribute(&cus, hipDeviceAttributeMultiprocessorCount, dev) != hipSuccess) { grid = -1; return; }
        if (hipFuncSetAttribute((const void*)mk_fwd, hipFuncAttributeMaxDynamicSharedMemorySize, LDS_BYTES) != hipSuccess) { fprintf(stderr, "kernel_launch: hipFuncSetAttribute failed\n"); grid = -1; return; }
        if (hipOccupancyMaxActiveBlocksPerMultiprocessor(&per_cu, (const void*)mk_fwd, 512, LDS_BYTES) != hipSuccess || per_cu < 1) { fprintf(stderr, "kernel_launch: occupancy query says %d\n", per_cu); }
        (void)hipGetLastError();
        grid = cus;
    }
    if (grid < 0) return;
    (void)hipMemsetAsync((char*)d_ws + WS_CTL, 0, CTL_BYTES, stream);
    Args a{};
    for (int i = 0; i < 30; ++i) a.in[i] = (const float*)d_in[i];
    a.out = (float*)d_out; a.ws = (unsigned char*)d_ws;
#if PROBE_HI > PROBE_LO
    { const int cuts[5][3] = {{0, PROBE_HI, 0}, {PROBE_LO, PROBE_HI, 1}, {PROBE_LO, PROBE_HI, 1}, {PROBE_LO, PROBE_HI, 1}, {PROBE_HI, NPH, 0}};
      for (int li = 0; li < 5; ++li) { if (cuts[li][0] >= cuts[li][1]) continue; a.ph_lo = cuts[li][0]; a.ph_hi = cuts[li][1]; a.li = li; a.rep = cuts[li][2];
          hipLaunchKernelGGL(mk_fwd, dim3(grid), dim3(512), LDS_BYTES, stream, a); } }
#else
    a.ph_lo = 0; a.ph_hi = NPH; a.li = 0; a.rep = 0;
    hipLaunchKernelGGL(mk_fwd, dim3(grid), dim3(512), LDS_BYTES, stream, a);
#endif
}
```

```cpp
#include <hip/hip_runtime.h>
#include <cstdio>
#include <cstdint>
#include <cstddef>

#ifndef PROBE_LO
#define PROBE_LO 0
#define PROBE_HI 0
#endif

#define LAS __attribute__((address_space(3)))
#define GAS __attribute__((address_space(1)))
typedef unsigned short bf16_t;
typedef short bf16x8 __attribute__((ext_vector_type(8)));
typedef float f32x4 __attribute__((ext_vector_type(4)));
typedef float f32x2 __attribute__((ext_vector_type(2)));
typedef unsigned u32x4 __attribute__((ext_vector_type(4)));
typedef unsigned u32x2 __attribute__((ext_vector_type(2)));
typedef int i32x4 __attribute__((ext_vector_type(4)));

constexpr int DM = 4096, SEQ = 2048, NB = 4, MP = NB * SEQ, NSQ = 128, DSEQ = 4, MS = NSQ * DSEQ, M = MP + MS;
constexpr int DRNN = 2048, DSSM = 2048, NH = 32, HP = 64, NG = 4, NST = 128, DXBC = 3072, DFF = 12288, INC = 9248;
constexpr int N1P = 9472;
constexpr int C_RGX = 0, C_RGG = 2048, C_Z = 4096, C_XBC = 6144, C_DT = 9216;
constexpr float EPS = 1e-6f;
constexpr int NCH = MP / 128;

constexpr size_t O_Y = 0;
constexpr size_t O_PRGH = (size_t)M * DM;
constexpr size_t O_PRGC = O_PRGH + (size_t)NB * DRNN;
constexpr size_t O_PSH = O_PRGC + (size_t)NB * 3 * DRNN;
constexpr size_t O_PSC = O_PSH + (size_t)NB * NH * HP * NST;
constexpr size_t O_PFC = O_PSC + (size_t)NB * 3 * DXBC;
constexpr size_t O_SRGH = O_PFC + (size_t)NB * 2 * DFF;
constexpr size_t O_SRGC = O_SRGH + (size_t)NSQ * DRNN;
constexpr size_t O_SSH = O_SRGC + (size_t)NSQ * 3 * DRNN;
constexpr size_t O_SSC = O_SSH + (size_t)NSQ * NH * HP * NST;
constexpr size_t O_SFC = O_SSC + (size_t)NSQ * 3 * DXBC;
constexpr size_t O_END = O_SFC + (size_t)NSQ * 2 * DFF;

constexpr size_t al256(size_t x) { return (x + 255) & ~(size_t)255; }
constexpr size_t WS_CTL = 0, CTL_BYTES = 1u << 20;
constexpr size_t WS_BT1 = WS_CTL + CTL_BYTES;
constexpr size_t WS_BT2 = WS_BT1 + al256((size_t)N1P * DM * 2);
constexpr size_t WS_BT3 = WS_BT2 + al256((size_t)DM * DM * 2);
constexpr size_t WS_BT4 = WS_BT3 + al256((size_t)2 * DFF * DM * 2);
constexpr size_t WS_BTG = WS_BT4 + al256((size_t)DM * DFF * 2);
constexpr size_t WS_SP8 = WS_BTG + al256((size_t)16 * 256 * 256 * 2);
constexpr size_t WS_RS1 = WS_SP8 + al256((size_t)DRNN * 4);
constexpr size_t WS_HALO = WS_RS1 + al256((size_t)M * 4);
constexpr size_t WS_RF3 = WS_HALO + al256((size_t)34 * 96 * 2 * 128 * 4);
constexpr size_t WS_DTR = WS_RF3 + al256((size_t)M * 4);
constexpr size_t WS_SA4 = WS_DTR + al256((size_t)M * NH * 4);
constexpr size_t WS_SW4 = WS_SA4 + al256((size_t)M * 4);
constexpr size_t WS_HALO1 = WS_SW4 + al256((size_t)DM * 4);
constexpr size_t WS_CAT = WS_HALO1 + al256((size_t)34 * 37 * 3 * 256 * 4);
constexpr size_t WS_X1 = WS_CAT + al256((size_t)M * DM * 2);
constexpr size_t WS_X2B = WS_X1 + al256((size_t)M * DM * 2);
constexpr size_t WS_X1B = WS_X1 + al256((size_t)M * DM * 4);
constexpr size_t WS_OV = WS_X1B + al256((size_t)M * DM * 2);
constexpr size_t WS_XB = WS_OV;
constexpr size_t WS_PROJ = WS_XB + al256((size_t)M * DM * 2);
constexpr size_t WS_G2 = WS_PROJ;
constexpr size_t WS_XCB = WS_PROJ + al256((size_t)M * INC * 2);
constexpr size_t WS_AB = WS_XCB + al256((size_t)M * DRNN * 2);
constexpr size_t WS_XS = WS_AB + al256((size_t)M * DRNN * 8);
constexpr size_t WS_BC = WS_XS + al256((size_t)M * DSSM * 2);
constexpr size_t WS_XST = WS_BC + al256((size_t)M * 1024 * 2);
constexpr size_t WS_BTT = WS_XST + al256((size_t)NCH * 2048 * 128 * 2);
constexpr size_t WS_DTA = WS_BTT + al256((size_t)NCH * 512 * 128 * 2);
constexpr size_t WS_CUM = WS_DTA + al256((size_t)M * NH * 4);
constexpr size_t WS_YD = WS_CUM + al256((size_t)M * NH * 4);
constexpr size_t WS_ST = WS_YD + al256((size_t)M * DSSM * 4);
constexpr size_t WS_DEC = WS_ST + al256((size_t)NCH * NH * HP * NST * 4);
constexpr size_t WS_HPB = WS_DEC + al256((size_t)NCH * NH * 4);
constexpr size_t WS_SSQRG = WS_HPB + al256((size_t)NCH * NH * HP * NST * 2);
constexpr size_t WS_ENDA = WS_SSQRG + al256((size_t)M * 64 * 4);
constexpr size_t WS_PART = WS_OV;
constexpr size_t WS_GATE = WS_OV;
constexpr size_t WS_VAL = WS_GATE + al256((size_t)M * DFF * 2);
constexpr size_t WS_ACT = WS_VAL + al256((size_t)M * DFF * 2);
constexpr size_t WS_BT3Q = WS_VAL;
constexpr size_t WS_ACTQ = WS_ACT + al256((size_t)M * DFF * 2);
constexpr size_t WS_BT4Q = WS_ACTQ + al256((size_t)M * DFF);
constexpr size_t WS_ENDB = WS_BT4Q + al256((size_t)DM * DFF);
constexpr size_t WS_END0 = WS_ENDA > WS_ENDB ? WS_ENDA : WS_ENDB;
constexpr size_t WS_CATQ = WS_X1B + al256((size_t)M * DM);
constexpr size_t WS_BT2Q = WS_END0;
constexpr size_t WS_SA2 = WS_BT2Q + al256((size_t)DM * DM);
constexpr size_t WS_SW2 = WS_SA2 + al256((size_t)M * 4);
constexpr size_t WS_END = WS_SW2 + al256((size_t)DM * 4);
static_assert(WS_END <= (size_t)1536 * 1024 * 1024, "d_ws map exceeds the guaranteed 1536 MiB");
constexpr int CW_BAR = 1024;
constexpr int CW_SSQ1 = 20480;
constexpr int CW_SSQ2 = CW_SSQ1 + M + 64;
constexpr int CW_HFLAG = CW_SSQ2 + M + 64;
constexpr int CW_HFLAG1 = CW_HFLAG + 34 * 96 + 64;
constexpr int CW_CMAX3 = CW_HFLAG1 + 34 * 37 + 64;
constexpr int CW_CMAX4 = CW_CMAX3 + 2 * DFF;
constexpr int CW_RMAX4 = CW_CMAX4 + DM;
constexpr int CW_DUMMY = CW_RMAX4 + M + 64;
constexpr int CW_TMO = 16;
static_assert((size_t)(CW_DUMMY + M) * 4 <= CTL_BYTES && CW_BAR + 5 * 3456 <= CW_SSQ1, "ctl");
static_assert(((34 * 96) / 8) % 8 == 0 && (34 * 96) % 8 == 0, "up-GEMM unit order: every XCD chunk must start on a sequence-start row panel");

constexpr int RING_BYTES = 131072, LDS_BYTES = 163840, LDSCTL_OFF = LDS_BYTES - 256;

__device__ __forceinline__ unsigned cvt_pk_bf16(float lo, float hi) { unsigned r; asm("v_cvt_pk_bf16_f32 %0, %1, %2" : "=v"(r) : "v"(lo), "v"(hi)); return r; }
__device__ __forceinline__ float bf_lo(unsigned w) { return __uint_as_float(w << 16); }
__device__ __forceinline__ float bf_hi(unsigned w) { return __uint_as_float(w & 0xffff0000u); }
__device__ __forceinline__ float bf2f(bf16_t b) { return __uint_as_float(((unsigned)b) << 16); }
__device__ __forceinline__ f32x4 ld_bf4(const bf16_t* p) { const u32x2 w = *(const u32x2*)p; return (f32x4){bf_lo(w.x), bf_hi(w.x), bf_lo(w.y), bf_hi(w.y)}; }
__device__ __forceinline__ float frcp(float x) { return __builtin_amdgcn_rcpf(x); }
__device__ __forceinline__ float sigmoidf_(float x) { return frcp(1.0f + __expf(-x)); }
__device__ __forceinline__ float siluf_(float x) { return x * sigmoidf_(x); }
__device__ __forceinline__ float gelu_tanh(float x) { const float u = 0.7978845608028654f * (x + 0.044715f * x * x * x); return x * sigmoidf_(2.0f * u); }
__device__ __forceinline__ float softplusf_(float x) { return fmaxf(x, 0.0f) + log1pf(__expf(-fabsf(x))); }
__device__ __forceinline__ float neg_expm1_small(float x, float ehalf  ) {
    const float p = x * (1.0f + x * (0.5f + x * (0.16666667f + x * (0.041666668f + x * (0.008333334f + x * (0.0013888889f + x * 0.0001984127f))))));
    return x > -0.5f ? -p : 1.0f - ehalf * ehalf;
}
__device__ __forceinline__ float wave_sum(float v) {
#pragma unroll
    for (int o = 1; o < 64; o <<= 1) v += __shfl_xor(v, o);
    return v;
}
__device__ __forceinline__ unsigned q8_pack4(float a, float b, float c, float d, float inv) {
    const unsigned ua = __float_as_uint(fmaf(a, inv, 12582912.0f)), ub = __float_as_uint(fmaf(b, inv, 12582912.0f)), uc = __float_as_uint(fmaf(c, inv, 12582912.0f)), ud = __float_as_uint(fmaf(d, inv, 12582912.0f));
    return (ua & 255u) | ((ub & 255u) << 8) | ((uc & 255u) << 16) | (ud << 24);
}
__device__ __forceinline__ u32x4 q8_pack16(const u32x4 lo, const u32x4 hi, float inv) {
    u32x4 o; o.x = q8_pack4(bf_lo(lo.x), bf_hi(lo.x), bf_lo(lo.y), bf_hi(lo.y), inv); o.y = q8_pack4(bf_lo(lo.z), bf_hi(lo.z), bf_lo(lo.w), bf_hi(lo.w), inv);
    o.z = q8_pack4(bf_lo(hi.x), bf_hi(hi.x), bf_lo(hi.y), bf_hi(hi.y), inv); o.w = q8_pack4(bf_lo(hi.z), bf_hi(hi.z), bf_lo(hi.w), bf_hi(hi.w), inv); return o;
}
__device__ __forceinline__ void quant_rows_i8(const bf16_t* src, unsigned char* dst, const unsigned* rmax, int R, int C, size_t gt, size_t NT) {
    const size_t per = (size_t)C / 8, tot = (size_t)R * per;
    for (size_t it0 = gt; it0 < tot; it0 += 8 * NT) { u32x4 w[8]; float inv[8];
#pragma unroll
        for (int k = 0; k < 8; ++k) { const size_t it = it0 + k * NT; if (it < tot) { w[k] = __builtin_nontemporal_load((const u32x4*)(src + it * 8));
                inv[k] = 127.0f / fmaxf(__uint_as_float(rmax[(int)(it / per)]) * 1.004f, 1e-30f); } }
#pragma unroll
        for (int k = 0; k < 8; ++k) { const size_t it = it0 + k * NT; if (it < tot) { u32x2 o; o.x = q8_pack4(bf_lo(w[k].x), bf_hi(w[k].x), bf_lo(w[k].y), bf_hi(w[k].y), inv[k]); o.y = q8_pack4(bf_lo(w[k].z), bf_hi(w[k].z), bf_lo(w[k].w), bf_hi(w[k].w), inv[k]);
                *(u32x2*)(dst + it * 8) = o; } } }
}
__device__ __forceinline__ void fwht32(float (&x)[32]) {
    f32x2 v[16];
#pragma unroll
    for (int i = 0; i < 16; ++i) v[i] = (f32x2){x[2 * i] + x[2 * i + 1], x[2 * i] - x[2 * i + 1]};
#pragma unroll
    for (int h = 1; h < 16; h <<= 1) {
#pragma unroll
        for (int i = 0; i < 16; ++i) if ((i & h) == 0) { const f32x2 a = v[i], b = v[i + h]; v[i] = a + b; v[i + h] = a - b; } }
#pragma unroll
    for (int i = 0; i < 16; ++i) { x[2 * i] = v[i][0]; x[2 * i + 1] = v[i][1]; }
}
template <int NC = 6, bool RGN = false>
__device__ __forceinline__ void rotq_rows_i8(const bf16_t* src, unsigned char* dst, float* scale, int R, int gw, int NGW, int lane, const float* ssq = nullptr) {
    constexpr int RL = 2048 * NC;
    for (int r = gw; r < R; r += NGW) { const bf16_t* sr = src + (size_t)r * RL; u32x4 pk[NC][4]; float mx = 0.f;
        float sq = 0.f; if constexpr (RGN) sq = ssq[(size_t)r * 64 + lane];
#pragma unroll
        for (int i = 0; i < NC; ++i)
#pragma unroll
            for (int q = 0; q < 4; ++q) pk[i][q] = __builtin_nontemporal_load((const u32x4*)(sr + 2048 * i + 8 * (lane + 64 * q)));
#pragma unroll
        for (int i = 0; i < NC; ++i) { float x[32];
#pragma unroll
            for (int q = 0; q < 4; ++q) { const u32x4 w = pk[i][q]; x[8 * q] = bf_lo(w.x); x[8 * q + 1] = bf_hi(w.x); x[8 * q + 2] = bf_lo(w.y); x[8 * q + 3] = bf_hi(w.y); x[8 * q + 4] = bf_lo(w.z); x[8 * q + 5] = bf_hi(w.z); x[8 * q + 6] = bf_lo(w.w); x[8 * q + 7] = bf_hi(w.w); }
            fwht32(x);
            if constexpr (RGN) { if (i == 0) { const float rs = rsqrtf(wave_sum(sq) * (1.0f / DRNN) + EPS);
#pragma unroll
                    for (int e = 0; e < 32; ++e) x[e] *= rs; } }
#pragma unroll
            for (int q = 0; q < 4; ++q) { pk[i][q].x = cvt_pk_bf16(x[8 * q], x[8 * q + 1]); pk[i][q].y = cvt_pk_bf16(x[8 * q + 2], x[8 * q + 3]); pk[i][q].z = cvt_pk_bf16(x[8 * q + 4], x[8 * q + 5]); pk[i][q].w = cvt_pk_bf16(x[8 * q + 6], x[8 * q + 7]); }
#pragma unroll
            for (int e = 0; e < 32; ++e) mx = fmaxf(mx, fabsf(x[e])); }
#pragma unroll
        for (int o = 1; o < 64; o <<= 1) mx = fmaxf(mx, __shfl_xor(mx, o));
        mx = fmaxf(mx * 1.004f, 1e-30f);
        if (lane == 0) scale[r] = mx * (0.17677669529663687f / 127.0f);
        const float inv = 127.0f / mx;
#pragma unroll
        for (int i = 0; i < NC; ++i) { unsigned char* d = dst + (size_t)r * RL + 2048 * i + 8 * lane;
#pragma unroll
            for (int q = 0; q < 4; ++q) { const u32x4 w = pk[i][q]; u32x2 o; o.x = q8_pack4(bf_lo(w.x), bf_hi(w.x), bf_lo(w.y), bf_hi(w.y), inv); o.y = q8_pack4(bf_lo(w.z), bf_hi(w.z), bf_lo(w.w), bf_hi(w.w), inv);
                *(u32x2*)(d + 512 * q) = o; } } }
}
#define FULL_FENCE() do { asm volatile("" ::: "memory"); __builtin_amdgcn_sched_barrier(0); } while (0)
#define LDS_BARRIER() do { asm volatile("s_waitcnt lgkmcnt(0)" ::: "memory"); __builtin_amdgcn_s_barrier(); asm volatile("" ::: "memory"); } while (0)
#define LDS_WAIT() asm volatile("s_waitcnt lgkmcnt(0)" ::: "memory")
#define VM_WAIT() asm volatile("s_waitcnt vmcnt(0)" ::: "memory")

#define XB_TMO      128
#define XB_XCNT(j)  (256  + 64 * (j))
#define XB_XSUB(j)  (1280 + 64 * (j))
#define XB_XGEN(j)  (2304 + 64 * (j))
#define XB_TOP      3328
#define XB_TOPGEN   3392
#define XCD_BAR_WORDS 3456
#define XB_SPIN_CAP (1u << 18)
__device__ __forceinline__ unsigned xb_ld(unsigned* p)              { return __hip_atomic_load(p, __ATOMIC_RELAXED, __HIP_MEMORY_SCOPE_AGENT); }
__device__ __forceinline__ unsigned xb_add(unsigned* p, unsigned v) { return __hip_atomic_fetch_add(p, v, __ATOMIC_RELAXED, __HIP_MEMORY_SCOPE_AGENT); }
__device__ __forceinline__ unsigned xb_xcc_id() { return (unsigned)__builtin_amdgcn_s_getreg((3 << 11) | 20) & 0xFu; }
#define XB_SPIN(cond, bar) do { unsigned _sp = 0; while (cond) { __builtin_amdgcn_s_sleep(1); \
    if ((++_sp & 255u) == 0u) { if (xb_ld(&(bar)[XB_TMO])) break; if (_sp > XB_SPIN_CAP) { atomicAdd(&(bar)[XB_TMO], 1u); break; } } } } while (0)
struct XcdBarrier { unsigned* bar; unsigned x; volatile LAS unsigned* st; };
__device__ __forceinline__ XcdBarrier xcd_barrier_post(unsigned* bar, volatile LAS unsigned* st) {
    XcdBarrier b; b.bar = bar; b.x = xb_xcc_id(); b.st = st;
    if (threadIdx.x == 0) (void)xb_add(&bar[XB_XCNT(b.x)], 1u);
    return b;
}
__device__ __forceinline__ void xcd_barrier_complete(unsigned* bar, unsigned x, unsigned& nloc, unsigned& nx) {
    const unsigned G = gridDim.x * gridDim.y * gridDim.z;
    unsigned sum, cnt, mine, sp = 0u;
    for (;;) {
        sum = 0u; cnt = 0u; mine = 0u;
#pragma unroll
        for (unsigned j = 0; j < 16; ++j) { const unsigned c = xb_ld(&bar[XB_XCNT(j)]); sum += c; cnt += (c > 0u) ? 1u : 0u; mine = (j == x) ? c : mine; }
        if (sum == G) break;
        __builtin_amdgcn_s_sleep(1);
        if ((++sp & 255u) == 0u) { if (xb_ld(&bar[XB_TMO])) break; if (sp > XB_SPIN_CAP) { atomicAdd(&bar[XB_TMO], 1u); break; } }
    }
    nloc = mine > 0u ? mine : 1u; nx = cnt > 0u ? cnt : 1u;
}
__device__ __forceinline__ void xcd_barrier(const XcdBarrier& b) {
    asm volatile("s_waitcnt vmcnt(0)" ::: "memory");
    __syncthreads();
    if (threadIdx.x == 0) {
        unsigned* bar = b.bar;
        __builtin_amdgcn_s_waitcnt(0);
        unsigned nloc = b.st[0], nx = b.st[1];
        if (nloc == 0u) { xcd_barrier_complete(bar, b.x, nloc, nx); b.st[0] = nloc; b.st[1] = nx; }
        const unsigned old = xb_add(&bar[XB_XSUB(b.x)], 1u);
        const unsigned gen = old / nloc;
        if (old + 1u == (gen + 1u) * nloc) {
            __builtin_amdgcn_fence(__ATOMIC_RELEASE, "agent");
            asm volatile("s_waitcnt vmcnt(0)" ::: "memory");
            const unsigned og = xb_add(&bar[XB_TOP], 1u);
            const unsigned tg = og / nx;
            if (og + 1u == (tg + 1u) * nx) xb_add(&bar[XB_TOPGEN], 1u);
            else XB_SPIN(xb_ld(&bar[XB_TOPGEN]) == tg, bar);
            __builtin_amdgcn_fence(__ATOMIC_ACQUIRE, "agent");
            xb_add(&bar[XB_XGEN(b.x)], 1u);
            asm volatile("s_waitcnt vmcnt(0)" ::: "memory");
        } else {
            XB_SPIN(xb_ld(&bar[XB_XGEN(b.x)]) == gen, bar);
            __builtin_amdgcn_fence(__ATOMIC_ACQUIRE, "agent");
            asm volatile("s_waitcnt vmcnt(0)" ::: "memory");
        }
    }
    __syncthreads();
}

namespace pg8 {
constexpr int BM = 256, BK = 64, HALF = 128, HTB = HALF * BK * 2, STAGE_BYTES = 8 * HTB, NXCD = 8, WGM = 8;
__host__ __device__ __forceinline__ int lds_byte(int r, int c) { const int st = (r >> 4) * 2 + (c >> 5), rr = r & 15, cc = c & 31, ob = rr * 64 + cc * 2; return st * 1024 + (ob ^ (((ob >> 9) & 1) << 5)); }
__host__ __device__ __forceinline__ void stage_rc(int b, int& R, int& C) { const int st = b / 1024, sb = b % 1024, swz = sb ^ (((sb >> 9) & 1) << 5); R = (st >> 1) * 16 + swz / 64; C = (st & 1) * 32 + (swz % 64) / 2; }
__host__ __device__ __forceinline__ int perm32(int rho) { const int n = rho >> 4, i = rho & 15; return 8 * (i >> 2) + 4 * n + (i & 3); }
struct Unit { int pm, pn, ks, tl; };
struct Gemm { const bf16_t* A; const bf16_t* Bt; int M, N, K, lda, ldb; };
struct GeomPlain {
    static __device__ __forceinline__ size_t a_off(const Gemm& g, const Unit& u) { return (size_t)u.pm * 256 * g.lda * 2; }
    static __device__ __forceinline__ size_t b_off(const Gemm& g, const Unit& u) { return (size_t)u.pn * 256 * g.ldb * 2; }
};
struct GeomGates {
    static __device__ __forceinline__ size_t a_off(const Gemm& g, const Unit& u) { return ((size_t)u.pm * 256 * g.lda + (size_t)(u.pn >> 1) * 256) * 2; }
    static __device__ __forceinline__ size_t b_off(const Gemm& g, const Unit& u) { return (size_t)u.pn * 256 * g.ldb * 2; }
};
struct StaticOrder {
    int nM, nN, nwg, G, c, limit;
    __host__ __device__ void init(int M, int N, int G_, int c_) { nM = M / BM; nN = N / BM; nwg = nM * nN; G = G_; c = c_; limit = nwg; }
    __host__ __device__ void tile_of(int L, Unit& u) const {
        int wgid = L; { const int q = nwg / NXCD, r = nwg % NXCD, xcd = wgid % NXCD, off = wgid / NXCD; wgid = (xcd < r ? xcd * (q + 1) : r * (q + 1) + (xcd - r) * q) + off; }
        tile_of_wgid(wgid, u);
    }
    __host__ __device__ void tile_of_wgid(int wgid, Unit& u) const {
        const int nig = WGM * nN, gid = wgid / nig, fm = gid * WGM, gsz = (nM - fm) < WGM ? (nM - fm) : WGM;
        u.pm = fm + ((wgid % nig) % gsz); u.pn = (wgid % nig) / gsz; u.ks = 0; u.tl = 0;
    }
    __host__ __device__ bool next(int i, Unit& u) const { const long L = (long)i * G + c; if (L >= limit) return false; tile_of((int)L, u); return true; }
};
struct ChunkOrder {
    StaticOrder base; int per_lo, n_hi;
    __host__ __device__ bool next(int i, Unit& u) const {
        const int G = base.G, c = base.c; int wgid;
        if (per_lo > 0) { const int x = c & 7, j = c >> 3; wgid = i * G + x * per_lo + (x < n_hi ? x : n_hi) + j; } else wgid = i * G + c;
        if (wgid >= base.nwg) return false; base.tile_of_wgid(wgid, u); return true;
    }
};
struct SplitOrder {
    StaticOrder base; int first, nrem, c;
    __host__ __device__ bool next(int i, Unit& u) const { if (i > 0 || c >= nrem * 8) return false; base.tile_of(first + c % nrem, u); u.tl = c % nrem; u.ks = c / nrem; return true; }
};
struct GeomSplit {
    static __device__ __forceinline__ size_t a_off(const Gemm& g, const Unit& u) { return ((size_t)u.pm * 256 * g.lda + (size_t)u.ks * g.K) * 2; }
    static __device__ __forceinline__ size_t b_off(const Gemm& g, const Unit& u) { return ((size_t)u.pn * 256 * g.ldb + (size_t)u.ks * g.K) * 2; }
};

template <class Epi, class Geom, class Sched, bool ALIGN_EPI, bool I8 = false>
__device__ __forceinline__ void gemm_phase(LAS unsigned char* lds, const Gemm g, const Sched& S, const Epi& E) {
    const int tid = threadIdx.x, wid = __builtin_amdgcn_readfirstlane(tid >> 6), lane = tid & 63, wr = wid >> 2, wc = wid & 3, fr = lane & 15, fq = lane >> 4;
    const int K = g.K, nt = K / BK;
    unsigned voffA[2], voffB[2];
#pragma unroll
    for (int i = 0; i < 2; ++i) { int R, C; stage_rc(tid * 16 + i * 8192, R, C); const int Rb = Epi::PERM ? ((R & ~31) + perm32(R & 31)) : R;
        voffA[i] = (unsigned)(R * g.lda + C) * 2u; voffB[i] = (unsigned)(Rb * g.ldb + C) * 2u; }
    const size_t kstep = (size_t)(BK * 2);
    const size_t hsA = (size_t)HALF * g.lda * 2, hsB = (size_t)HALF * g.ldb * 2;
    const unsigned ldsw = (unsigned)wid * 1024u;
    const int aoff = lds_byte(wr * 64 + fr, fq * 8), boff = lds_byte(wc * 32 + fr, fq * 8);
#define PG8_SA(b, h) (((b) * 2 + (h)) * HTB)
#define PG8_SB(b, h) ((4 + (b) * 2 + (h)) * HTB)
#define PG8_STAGE(bufoff, gbase, voff) do { _Pragma("unroll") for (int _i = 0; _i < 2; ++_i) \
        __builtin_amdgcn_global_load_lds((const unsigned*)((const char*)(gbase) + (voff)[_i]), (LAS unsigned*)(lds + (bufoff) + ldsw + _i * 8192), 16, 0, 0); } while (0)
#define PG8_LDA(dst, b, h) do { _Pragma("unroll") for (int m = 0; m < 4; ++m) _Pragma("unroll") for (int k = 0; k < 2; ++k) dst[m][k] = *(const LAS bf16x8*)(lds + PG8_SA(b, h) + aoff + m * 2048 + k * 1024); } while (0)
#define PG8_LDB(dst, b, h) do { _Pragma("unroll") for (int n = 0; n < 2; ++n) _Pragma("unroll") for (int k = 0; k < 2; ++k) dst[n][k] = *(const LAS bf16x8*)(lds + PG8_SB(b, h) + boff + n * 2048 + k * 1024); } while (0)
#define PG8_MMA(ai, bj, At, Bt) do { __builtin_amdgcn_s_setprio(1); _Pragma("unroll") for (int m = 0; m < 4; ++m) _Pragma("unroll") for (int n = 0; n < 2; ++n) _Pragma("unroll") for (int k = 0; k < 2; ++k) { \
        if constexpr (I8) acc[ai][bj][m][n] = __builtin_bit_cast(f32x4, __builtin_amdgcn_mfma_i32_16x16x64_i8(__builtin_bit_cast(i32x4, Bt[n][k]), __builtin_bit_cast(i32x4, At[m][k]), __builtin_bit_cast(i32x4, acc[ai][bj][m][n]), 0, 0, 0)); \
        else acc[ai][bj][m][n] = __builtin_amdgcn_mfma_f32_16x16x32_bf16(Bt[n][k], At[m][k], acc[ai][bj][m][n], 0, 0, 0); } __builtin_amdgcn_s_setprio(0); } while (0)
#define PG8_WAIT_V(n) asm volatile("s_waitcnt vmcnt(" #n ")" ::: "memory")
#define PG8_WAIT_L(n) asm volatile("s_waitcnt lgkmcnt(" #n ")" ::: "memory")
#define PG8_BAR __builtin_amdgcn_s_barrier()
#define PG8_SCHED __builtin_amdgcn_sched_barrier(0)
    Unit cur, nxt; int ui = 0;
    if (!S.next(0, cur)) return;
    f32x4 acc[2][2][4][2];
#pragma unroll
    for (int a = 0; a < 2; ++a)
#pragma unroll
        for (int b = 0; b < 2; ++b)
#pragma unroll
            for (int m = 0; m < 4; ++m)
#pragma unroll
                for (int n = 0; n < 2; ++n) acc[a][b][m][n] = (f32x4){0.f, 0.f, 0.f, 0.f};
    bf16x8 At[4][2], B0[2][2], B1[2][2];
    const char* cA = (const char*)g.A + Geom::a_off(g, cur); const char* cB = (const char*)g.Bt + Geom::b_off(g, cur);
    PG8_STAGE(PG8_SB(0, 0), cB, voffB); PG8_STAGE(PG8_SB(0, 1), cB + hsB, voffB); PG8_STAGE(PG8_SA(0, 0), cA, voffA); PG8_STAGE(PG8_SA(0, 1), cA + hsA, voffA);
    if (wr == 1) PG8_BAR;
    PG8_WAIT_V(2); PG8_BAR;
    PG8_STAGE(PG8_SB(1, 0), cB + kstep, voffB); PG8_STAGE(PG8_SA(1, 0), cA + kstep, voffA); PG8_STAGE(PG8_SB(1, 1), cB + hsB + kstep, voffB);
    PG8_WAIT_V(6); PG8_BAR;
    for (;;) {
        const bool has_next = S.next(ui + 1, nxt);
        const char* nA = has_next ? (const char*)g.A + Geom::a_off(g, nxt) : cA; const char* nB = has_next ? (const char*)g.Bt + Geom::b_off(g, nxt) : cB;
#pragma unroll 1
        for (int t = 0; t < nt; t += 2) {
            const bool last = (t == nt - 2);
            const char* a1 = cA + (size_t)(t + 1) * kstep;
            const char* a2 = last ? nA : cA + (size_t)(t + 2) * kstep; const char* b2 = last ? nB : cB + (size_t)(t + 2) * kstep;
            const char* a3 = a2 + kstep; const char* b3 = b2 + kstep;
            PG8_LDB(B0, 0, 0); PG8_LDB(B1, 0, 1); PG8_SCHED; PG8_LDA(At, 0, 0); PG8_STAGE(PG8_SA(1, 1), a1 + hsA, voffA);
            PG8_WAIT_V(8); PG8_WAIT_L(0); PG8_BAR; PG8_MMA(0, 0, At, B0); PG8_MMA(0, 1, At, B1); PG8_BAR; PG8_SCHED;
            PG8_LDA(At, 0, 1); PG8_STAGE(PG8_SB(0, 0), b2, voffB); PG8_STAGE(PG8_SB(0, 1), b2 + hsB, voffB); PG8_STAGE(PG8_SA(0, 0), a2, voffA);
            PG8_WAIT_V(8); PG8_WAIT_L(0); PG8_BAR; PG8_MMA(1, 0, At, B0); PG8_MMA(1, 1, At, B1); PG8_BAR; PG8_SCHED;
            PG8_LDB(B0, 1, 0); PG8_LDB(B1, 1, 1); PG8_SCHED; PG8_LDA(At, 1, 0); PG8_STAGE(PG8_SA(0, 1), a2 + hsA, voffA);
            PG8_WAIT_V(8); PG8_WAIT_L(0); PG8_BAR; PG8_MMA(0, 0, At, B0); PG8_MMA(0, 1, At, B1); PG8_BAR; PG8_SCHED;
            PG8_LDA(At, 1, 1); PG8_STAGE(PG8_SB(1, 0), b3, voffB); PG8_STAGE(PG8_SB(1, 1), b3 + hsB, voffB); PG8_STAGE(PG8_SA(1, 0), a3, voffA);
            PG8_WAIT_V(8); PG8_WAIT_L(0); PG8_BAR; PG8_MMA(1, 0, At, B0); PG8_MMA(1, 1, At, B1); PG8_BAR; PG8_SCHED;
        }
        if constexpr (ALIGN_EPI) { if (wr == 0) PG8_BAR; }
        E(acc, cur, wr, wc, fr, fq);
        if (!has_next) break;
#pragma unroll
        for (int a = 0; a < 2; ++a)
#pragma unroll
            for (int b = 0; b < 2; ++b)
#pragma unroll
                for (int m = 0; m < 4; ++m)
#pragma unroll
                    for (int n = 0; n < 2; ++n) acc[a][b][m][n] = (f32x4){0.f, 0.f, 0.f, 0.f};
        cur = nxt; cA = nA; cB = nB; ++ui;
        if constexpr (ALIGN_EPI) { if (wr == 1) PG8_BAR; }
    }
    PG8_WAIT_V(0);
    if constexpr (!ALIGN_EPI) { if (wr == 0) PG8_BAR; }
    PG8_BAR;
#undef PG8_SA
#undef PG8_SB
#undef PG8_STAGE
#undef PG8_LDA
#undef PG8_LDB
#undef PG8_MMA
#undef PG8_WAIT_V
#undef PG8_WAIT_L
#undef PG8_BAR
#undef PG8_SCHED
}
}

struct Args { const float* in[30]; float* out; unsigned char* ws; int ph_lo, ph_hi, li, rep; };
struct Frame {
    LAS unsigned char* lds; int tid, lane, wave, G;
    const float* in[30]; float* out; unsigned char* ws;
};
#define WSP(T, off) ((T*)(F.ws + (off)))

__device__ __forceinline__ float dpp_ror1(float v) { return __builtin_bit_cast(float, __builtin_amdgcn_update_dpp(0, __builtin_bit_cast(int, v), 0x121, 0xf, 0xf, false)); }
__device__ __forceinline__ float dpp_ror2(float v) { return __builtin_bit_cast(float, __builtin_amdgcn_update_dpp(0, __builtin_bit_cast(int, v), 0x122, 0xf, 0xf, false)); }
__device__ __forceinline__ float dpp_ror3(float v) { return __builtin_bit_cast(float, __builtin_amdgcn_update_dpp(0, __builtin_bit_cast(int, v), 0x123, 0xf, 0xf, false)); }
struct EpiProjConv {
    static constexpr bool PERM = true;
    unsigned char* wsb; float* out; const float *rgw, *rgb, *sdw, *sdb, *dtb, *st_rg, *st_sd; LAS float* H;
    __device__ __forceinline__ void operator()(f32x4 (&acc)[2][2][4][2], const pg8::Unit& u, int wr, int wc, int fr, int fq) const {
        unsigned char* ws = wsb;
        asm volatile("" : "+v"(fr), "+v"(fq), "+s"(ws));
        const float* rs = (const float*)(ws + WS_RS1); bf16_t* G2 = (bf16_t*)(ws + WS_G2); float* DTA = (float*)(ws + WS_DTA);
        unsigned long long* HALO = (unsigned long long*)(ws + WS_HALO1); unsigned* HFLAG = (unsigned*)(ws + WS_CTL) + CW_HFLAG1; unsigned* tmo = (unsigned*)(ws + WS_CTL) + CW_TMO;
        const int row0 = u.pm * 256 + wr * 64 + fr, cl0 = wc * 32 + 8 * fq, c0 = u.pn * 256 + cl0;
        { float sc[2][4];
#pragma unroll
          for (int ai = 0; ai < 2; ++ai)
#pragma unroll
              for (int m = 0; m < 4; ++m) sc[ai][m] = rs[row0 + ai * 128 + m * 16];
#pragma unroll
          for (int ai = 0; ai < 2; ++ai)
#pragma unroll
              for (int m = 0; m < 4; ++m)
#pragma unroll
                  for (int bj = 0; bj < 2; ++bj) { acc[ai][bj][m][0] *= sc[ai][m]; acc[ai][bj][m][1] *= sc[ai][m]; } }
        const int pn = u.pn;
        if (pn >= 8 && pn < 24) {
#pragma unroll
            for (int ai = 0; ai < 2; ++ai)
#pragma unroll
                for (int m = 0; m < 4; ++m) { const int row = row0 + ai * 128 + m * 16;
#pragma unroll
                    for (int bj = 0; bj < 2; ++bj) { f32x4 v0 = acc[ai][bj][m][0], v1 = acc[ai][bj][m][1];
                        if (pn < 16) { v0 = (f32x4){gelu_tanh(v0[0]), gelu_tanh(v0[1]), gelu_tanh(v0[2]), gelu_tanh(v0[3])}; v1 = (f32x4){gelu_tanh(v1[0]), gelu_tanh(v1[1]), gelu_tanh(v1[2]), gelu_tanh(v1[3])}; }
                        else { v0 = (f32x4){siluf_(v0[0]), siluf_(v0[1]), siluf_(v0[2]), siluf_(v0[3])}; v1 = (f32x4){siluf_(v1[0]), siluf_(v1[1]), siluf_(v1[2]), siluf_(v1[3])}; }
                        u32x4 w; w.x = cvt_pk_bf16(v0[0], v0[1]); w.y = cvt_pk_bf16(v0[2], v0[3]); w.z = cvt_pk_bf16(v1[0], v1[1]); w.w = cvt_pk_bf16(v1[2], v1[3]);
                        *(u32x4*)(G2 + (size_t)row * 4096 + (c0 - C_RGG) + bj * 128) = w; } }
            return; }
        if (pn >= 36) {
            if (wc == 0) { const f32x4 b0 = *(const f32x4*)(dtb + cl0), b1 = *(const f32x4*)(dtb + cl0 + 4);
#pragma unroll
                for (int ai = 0; ai < 2; ++ai)
#pragma unroll
                    for (int m = 0; m < 4; ++m) { const int row = row0 + ai * 128 + m * 16; const f32x4 v0 = acc[ai][0][m][0] + b0, v1 = acc[ai][0][m][1] + b1;
                        float* d = DTA + (size_t)row * NH + cl0;
                        *(f32x4*)d = (f32x4){softplusf_(v0[0]), softplusf_(v0[1]), softplusf_(v0[2]), softplusf_(v0[3])}; *(f32x4*)(d + 4) = (f32x4){softplusf_(v1[0]), softplusf_(v1[1]), softplusf_(v1[2]), softplusf_(v1[3])}; } }
            return; }
        const bool is_rg = pn < 8, prompt = u.pm < MP / 256;
        const int ch0 = is_rg ? c0 : c0 - C_XBC, CW = is_rg ? DRNN : DXBC;
        const float* cw = rgw + (is_rg ? (ptrdiff_t)0 : (sdw - rgw)); const float* cb = rgb + (is_rg ? (ptrdiff_t)0 : (sdb - rgb)); const float* stp = st_rg + (is_rg ? (ptrdiff_t)0 : (st_sd - st_rg));
        if ((u.pm & 7) == 7 || !prompt) {
#pragma unroll
            for (int ai = 0; ai < 2; ++ai)
#pragma unroll
                for (int m = 0; m < 4; ++m) { const int row = row0 + ai * 128 + m * 16; int j = -1; size_t base = 0;
                    if (row < MP) { const int t = row & (SEQ - 1); if (t >= SEQ - 3) { j = t - (SEQ - 3); base = (size_t)(row >> 11) * 3; } }
                    else { const int r = row - MP, t = r & 3; if (t >= 1) { j = t - 1; base = (size_t)(r >> 2) * 3; } }
                    if (j >= 0) { const size_t oo = is_rg ? (row < MP ? O_PRGC : O_SRGC) : (row < MP ? O_PSC : O_SSC); float* so = out + oo + (base + j) * CW + ch0;
#pragma unroll
                        for (int bj = 0; bj < 2; ++bj) { *(f32x4*)(so + bj * 128) = acc[ai][bj][m][0]; *(f32x4*)(so + bj * 128 + 4) = acc[ai][bj][m][1]; } } } }
        const int tile = u.pm * 37 + u.pn;
        if (prompt) {
            if (fr >= 13) {
#pragma unroll
                for (int ai = 0; ai < 2; ++ai)
#pragma unroll
                    for (int bj = 0; bj < 2; ++bj)
#pragma unroll
                        for (int n = 0; n < 2; ++n) *(LAS f32x4*)(H + ((2 * ai + wr) * 3 + (fr - 13)) * 256 + bj * 128 + cl0 + 4 * n) = acc[ai][bj][3][n];
                if (wr == 1 && (u.pm & 7) != 7) { unsigned long long* hp = HALO + ((size_t)tile * 3 + (fr - 13)) * 128 + (cl0 >> 1);
#pragma unroll
                    for (int bj = 0; bj < 2; ++bj)
#pragma unroll
                        for (int n = 0; n < 2; ++n) { const f32x4 g = acc[1][bj][3][n];
                            __hip_atomic_store(hp + bj * 64 + 2 * n, ((unsigned long long)__float_as_uint(g[1]) << 32) | __float_as_uint(g[0]), __ATOMIC_RELAXED, __HIP_MEMORY_SCOPE_AGENT);
                            __hip_atomic_store(hp + bj * 64 + 2 * n + 1, ((unsigned long long)__float_as_uint(g[3]) << 32) | __float_as_uint(g[2]), __ATOMIC_RELAXED, __HIP_MEMORY_SCOPE_AGENT); } }
            }
            if (wr == 1 && (u.pm & 7) != 7) { asm volatile("s_waitcnt vmcnt(0)" ::: "memory");
                if (fr == 0 && fq == 0) __hip_atomic_fetch_add(HFLAG + tile, 1u, __ATOMIC_RELAXED, __HIP_MEMORY_SCOPE_AGENT); }
            asm volatile("s_waitcnt lgkmcnt(0)" ::: "memory"); __builtin_amdgcn_s_barrier(); asm volatile("" ::: "memory");
        }
        const size_t dso = is_rg ? WS_XCB : (ch0 < DSSM ? WS_XS : WS_BC); const int ld = is_rg ? DRNN : (ch0 < DSSM ? DSSM : 1024);
        bf16_t* dst = (bf16_t*)(ws + dso) + (is_rg ? ch0 : (ch0 < DSSM ? ch0 : ch0 - DSSM));
#pragma unroll
        for (int ai = 0; ai < 2; ++ai)
#pragma unroll
            for (int bj = 0; bj < 2; ++bj) {
                f32x4 hal[2];
                hal[0] = hal[1] = (f32x4){0.f, 0.f, 0.f, 0.f};
                if (prompt) { const int b = 2 * ai + wr;
                    if (b >= 1) { if (fr >= 13) {
#pragma unroll
                            for (int n = 0; n < 2; ++n) hal[n] = *(const LAS f32x4*)(H + ((b - 1) * 3 + (fr - 13)) * 256 + bj * 128 + cl0 + 4 * n); } }
                    else if ((u.pm & 7) != 0) { unsigned* fl = HFLAG + (tile - 37); unsigned sp = 0;
                        while ((unsigned)__builtin_amdgcn_readfirstlane(__hip_atomic_load(fl, __ATOMIC_RELAXED, __HIP_MEMORY_SCOPE_AGENT)) < 4u) { __builtin_amdgcn_s_sleep(2);
                            if ((++sp & 1023u) == 0u) { if (__hip_atomic_load(tmo, __ATOMIC_RELAXED, __HIP_MEMORY_SCOPE_AGENT) != 0u) break; if (sp > (1u << 22)) { __hip_atomic_store(tmo, 1u, __ATOMIC_RELAXED, __HIP_MEMORY_SCOPE_AGENT); break; } } }
                        if (fr >= 13) { const unsigned long long* hp = HALO + ((size_t)(tile - 37) * 3 + (fr - 13)) * 128 + (cl0 >> 1) + bj * 64;
#pragma unroll
                            for (int n = 0; n < 2; ++n) { const unsigned long long a2 = __hip_atomic_load(hp + 2 * n, __ATOMIC_RELAXED, __HIP_MEMORY_SCOPE_AGENT), b2 = __hip_atomic_load(hp + 2 * n + 1, __ATOMIC_RELAXED, __HIP_MEMORY_SCOPE_AGENT);
                                hal[n] = (f32x4){__uint_as_float((unsigned)a2), __uint_as_float((unsigned)(a2 >> 32)), __uint_as_float((unsigned)b2), __uint_as_float((unsigned)(b2 >> 32))}; } } } }
#pragma unroll
                for (int n = 0; n < 2; ++n) { const int ch = ch0 + bj * 128 + 4 * n;
                    const f32x4 w0 = *(const f32x4*)(cw + ch), w1 = *(const f32x4*)(cw + CW + ch), w2 = *(const f32x4*)(cw + 2 * CW + ch), w3 = *(const f32x4*)(cw + 3 * CW + ch), bb = *(const f32x4*)(cb + ch);
#pragma unroll
                    for (int m = 0; m < 4; ++m) { const int row = row0 + ai * 128 + m * 16; const f32x4 g = acc[ai][bj][m][n]; f32x4 p1, p2, p3;
                        if (prompt) { const f32x4 gp = (m == 0) ? hal[n] : acc[ai][bj][m > 0 ? m - 1 : 0][n];
#pragma unroll
                            for (int j = 0; j < 4; ++j) { p1[j] = dpp_ror1(fr == 15 ? gp[j] : g[j]); p2[j] = dpp_ror2(fr >= 14 ? gp[j] : g[j]); p3[j] = dpp_ror3(fr >= 13 ? gp[j] : g[j]); } }
                        else { const int t = fr & 3; const float* sp = stp + (size_t)((row - MP) >> 2) * 3 * CW + ch;
                            const f32x4 b0 = *(const f32x4*)sp, b1 = *(const f32x4*)(sp + CW), b2 = *(const f32x4*)(sp + 2 * CW);
#pragma unroll
                            for (int j = 0; j < 4; ++j) { const float r1 = dpp_ror1(g[j]), r2 = dpp_ror2(g[j]), r3 = dpp_ror3(g[j]);
                                p1[j] = t >= 1 ? r1 : b2[j]; p2[j] = t >= 2 ? r2 : (t == 1 ? b2[j] : b1[j]); p3[j] = t >= 3 ? r3 : (t == 2 ? b2[j] : (t == 1 ? b1[j] : b0[j])); } }
                        float o[4];
#pragma unroll
                        for (int j = 0; j < 4; ++j) { const float y = bb[j] + w0[j] * p3[j] + w1[j] * p2[j] + w2[j] * p1[j] + w3[j] * g[j]; o[j] = is_rg ? y : siluf_(y); }
                        u32x2 w; w.x = cvt_pk_bf16(o[0], o[1]); w.y = cvt_pk_bf16(o[2], o[3]);
                        *(u32x2*)(dst + (size_t)row * ld + bj * 128 + 4 * n) = w; }
                    asm volatile("" ::: "memory"); } }
    }
};
struct EpiGates {
    static constexpr bool PERM = false;
    unsigned* AB; const bf16_t* XCB; const float *ba, *bi, *sp8;
    __device__ __forceinline__ void operator()(const f32x4 (&acc)[2][2][4][2], const pg8::Unit& u, int wr, int wc, int fr, int fq) const {
        const int row0 = u.pm * 256 + wr * 64 + fr, ch0 = (u.pn >> 1) * 256 + (u.pn & 1) * 128 + wc * 32 + 4 * fq;
        const unsigned base = (unsigned)row0 * DRNN + ch0;
        u32x2 xw[2][2][4]; f32x4 bav[2], biv[2], spv[2];
#pragma unroll
        for (int n = 0; n < 2; ++n) { const int ch = ch0 + n * 16; bav[n] = *(const f32x4*)(ba + ch); biv[n] = *(const f32x4*)(bi + ch); spv[n] = *(const f32x4*)(sp8 + ch);
#pragma unroll
            for (int ai = 0; ai < 2; ++ai)
#pragma unroll
                for (int m = 0; m < 4; ++m) xw[n][ai][m] = *(const u32x2*)((const char*)XCB + (size_t)((base + (unsigned)((ai * 128 + m * 16) * DRNN + n * 16)) * 2u)); }
#pragma unroll
        for (int n = 0; n < 2; ++n) {
#pragma unroll
            for (int ai = 0; ai < 2; ++ai)
#pragma unroll
                for (int m = 0; m < 4; ++m) { const unsigned off = base + (unsigned)((ai * 128 + m * 16) * DRNN + n * 16);
                    const u32x2 x2 = xw[n][ai][m];
                    const float xc[4] = {bf_lo(x2.x), bf_hi(x2.x), bf_lo(x2.y), bf_hi(x2.y)};
                    const f32x4 r4 = acc[ai][0][m][n] + bav[n], i4 = acc[ai][1][m][n] + biv[n];
                    float av[4], bv[4];
#pragma unroll
                    for (int j = 0; j < 4; ++j) { const float gr = sigmoidf_(r4[j]), gi = sigmoidf_(i4[j]); const float la = -gr * spv[n][j];
                        av[j] = __expf(la); bv[j] = __builtin_amdgcn_sqrtf(neg_expm1_small(2.0f * la, av[j])) * gi * xc[j]; }
                    u32x4 pk; pk.x = cvt_pk_bf16(1.0f - av[0], bv[0]); pk.y = cvt_pk_bf16(1.0f - av[1], bv[1]); pk.z = cvt_pk_bf16(1.0f - av[2], bv[2]); pk.w = cvt_pk_bf16(1.0f - av[3], bv[3]);
                    *(u32x4*)((char*)AB + (size_t)off * 4u) = pk; } }
    }
};
struct EpiX1 {
    static constexpr bool PERM = true;
    const float *xp, *xs; bf16_t* X1;
    __device__ __forceinline__ void operator()(const f32x4 (&acc)[2][2][4][2], const pg8::Unit& u, int wr, int wc, int fr, int fq) const {
        const int row0 = u.pm * 256 + wr * 64 + fr, col0 = u.pn * 256 + wc * 32 + 8 * fq;
#pragma unroll
        for (int am = 0; am < 4; ++am) { const int ai = am >> 1, m0 = 2 * (am & 1); f32x4 r[2][2][2];
#pragma unroll
            for (int mm = 0; mm < 2; ++mm) { const int row = row0 + ai * 128 + (m0 + mm) * 16; const float* xin = (row < MP ? xp + (size_t)row * DM : xs + (size_t)(row - MP) * DM) + col0;
#pragma unroll
                for (int bj = 0; bj < 2; ++bj)
#pragma unroll
                    for (int n = 0; n < 2; ++n) r[mm][bj][n] = *(const f32x4*)(xin + bj * 128 + 4 * n); }
#pragma unroll
            for (int mm = 0; mm < 2; ++mm) { bf16_t* o = X1 + (size_t)(row0 + ai * 128 + (m0 + mm) * 16) * DM + col0;
#pragma unroll
                for (int bj = 0; bj < 2; ++bj) { const f32x4 v0 = acc[ai][bj][m0 + mm][0] + r[mm][bj][0], v1 = acc[ai][bj][m0 + mm][1] + r[mm][bj][1];
                    u32x4 w; w.x = cvt_pk_bf16(v0[0], v0[1]); w.y = cvt_pk_bf16(v0[2], v0[3]); w.z = cvt_pk_bf16(v1[0], v1[1]); w.w = cvt_pk_bf16(v1[2], v1[3]);
                    *(u32x4*)(o + bj * 128) = w; } } }
    }
};
struct EpiUpConv {
    static constexpr bool PERM = true;
    bf16_t* ACT; const float* rf; const unsigned* cmax; float* out; const float *cw, *cb, *stf; LAS float* H; unsigned long long* HALO; unsigned* HFLAG; unsigned* tmo;
    __device__ __forceinline__ void operator()(f32x4 (&acc)[2][2][4][2], const pg8::Unit& u, int wr, int wc, int fr, int fq) const {
        const int row0 = u.pm * 256 + wr * 64 + fr, cl0 = wc * 32 + 8 * fq, ch0 = u.pn * 128 + cl0;
        float sc[2][4];
#pragma unroll
        for (int ai = 0; ai < 2; ++ai)
#pragma unroll
            for (int m = 0; m < 4; ++m) sc[ai][m] = rf[row0 + ai * 128 + m * 16];
        {
            f32x4 sw[2][2];
#pragma unroll
            for (int bj = 0; bj < 2; ++bj)
#pragma unroll
                for (int n = 0; n < 2; ++n) { const u32x4 c = *(const u32x4*)(cmax + u.pn * 256 + bj * 128 + cl0 + 4 * n); sw[bj][n] = (f32x4){__uint_as_float(c.x), __uint_as_float(c.y), __uint_as_float(c.z), __uint_as_float(c.w)} * (1.004f / 127.0f); }
#pragma unroll
            for (int ai = 0; ai < 2; ++ai)
#pragma unroll
                for (int m = 0; m < 4; ++m)
#pragma unroll
                    for (int bj = 0; bj < 2; ++bj)
#pragma unroll
                        for (int n = 0; n < 2; ++n) { const i32x4 q = __builtin_bit_cast(i32x4, acc[ai][bj][m][n]); acc[ai][bj][m][n] = (f32x4){(float)q[0], (float)q[1], (float)q[2], (float)q[3]} * sw[bj][n] * sc[ai][m]; }
        }
        if ((u.pm & 7) == 7 || u.pm >= MP / 256) {
#pragma unroll
            for (int ai = 0; ai < 2; ++ai)
#pragma unroll
                for (int m = 0; m < 4; ++m) { const int row = row0 + ai * 128 + m * 16; float* so = nullptr;
                    if (row < MP) { const int t = row & (SEQ - 1); if (t >= SEQ - 2) so = out + O_PFC + ((size_t)(row >> 11) * 2 + (t - (SEQ - 2))) * DFF + ch0; }
                    else { const int r = row - MP, t = r & 3; if (t >= 2) so = out + O_SFC + ((size_t)(r >> 2) * 2 + (t - 2)) * DFF + ch0; }
                    if (so) { *(f32x4*)so = acc[ai][0][m][0]; *(f32x4*)(so + 4) = acc[ai][0][m][1]; } } }
        const bool prompt = u.pm < MP / 256;
        if (prompt) {
            if (fr >= 14) {
#pragma unroll
                for (int ai = 0; ai < 2; ++ai)
#pragma unroll
                    for (int n = 0; n < 2; ++n) *(LAS f32x4*)(H + ((2 * ai + wr) * 2 + (fr - 14)) * 128 + cl0 + 4 * n) = acc[ai][0][3][n];
                if (wr == 1 && (u.pm & 7) != 7) { unsigned long long* hp = HALO + ((size_t)(u.pm * 96 + u.pn) * 2 + (fr - 14)) * 64 + (cl0 >> 1);
#pragma unroll
                    for (int n = 0; n < 2; ++n) { const f32x4 g = acc[1][0][3][n];
                        __hip_atomic_store(hp + 2 * n, ((unsigned long long)__float_as_uint(g[1]) << 32) | __float_as_uint(g[0]), __ATOMIC_RELAXED, __HIP_MEMORY_SCOPE_AGENT);
                        __hip_atomic_store(hp + 2 * n + 1, ((unsigned long long)__float_as_uint(g[3]) << 32) | __float_as_uint(g[2]), __ATOMIC_RELAXED, __HIP_MEMORY_SCOPE_AGENT); } }
            }
            if (wr == 1 && (u.pm & 7) != 7) { asm volatile("s_waitcnt vmcnt(0)" ::: "memory");
                if (fr == 0 && fq == 0) __hip_atomic_fetch_add(HFLAG + u.pm * 96 + u.pn, 1u, __ATOMIC_RELAXED, __HIP_MEMORY_SCOPE_AGENT); }
            asm volatile("s_waitcnt lgkmcnt(0)" ::: "memory"); __builtin_amdgcn_s_barrier(); asm volatile("" ::: "memory");
        }
#pragma unroll
        for (int ai = 0; ai < 2; ++ai) {
            f32x4 hal[2]; hal[0] = hal[1] = (f32x4){0.f, 0.f, 0.f, 0.f};
            if (prompt) { const int b = 2 * ai + wr;
                if (b >= 1) { if (fr >= 14) {
#pragma unroll
                        for (int n = 0; n < 2; ++n) hal[n] = *(const LAS f32x4*)(H + ((b - 1) * 2 + (fr - 14)) * 128 + cl0 + 4 * n); } }
                else if ((u.pm & 7) != 0) { unsigned* fl = HFLAG + (u.pm - 1) * 96 + u.pn; unsigned sp = 0;
                    while ((unsigned)__builtin_amdgcn_readfirstlane(__hip_atomic_load(fl, __ATOMIC_RELAXED, __HIP_MEMORY_SCOPE_AGENT)) < 4u) { __builtin_amdgcn_s_sleep(2);
                        if ((++sp & 1023u) == 0u) { if (__hip_atomic_load(tmo, __ATOMIC_RELAXED, __HIP_MEMORY_SCOPE_AGENT) != 0u) break; if (sp > (1u << 22)) { __hip_atomic_store(tmo, 1u, __ATOMIC_RELAXED, __HIP_MEMORY_SCOPE_AGENT); break; } } }
                    if (fr >= 14) { const unsigned long long* hp = HALO + ((size_t)((u.pm - 1) * 96 + u.pn) * 2 + (fr - 14)) * 64 + (cl0 >> 1);
#pragma unroll
                        for (int n = 0; n < 2; ++n) { const unsigned long long a = __hip_atomic_load(hp + 2 * n, __ATOMIC_RELAXED, __HIP_MEMORY_SCOPE_AGENT), b2 = __hip_atomic_load(hp + 2 * n + 1, __ATOMIC_RELAXED, __HIP_MEMORY_SCOPE_AGENT);
                            hal[n] = (f32x4){__uint_as_float((unsigned)a), __uint_as_float((unsigned)(a >> 32)), __uint_as_float((unsigned)b2), __uint_as_float((unsigned)(b2 >> 32))}; } } } }
#pragma unroll
            for (int n = 0; n < 2; ++n) {
                const f32x4 w0 = *(const f32x4*)(cw + ch0 + 4 * n), w1 = *(const f32x4*)(cw + DFF + ch0 + 4 * n), w2 = *(const f32x4*)(cw + 2 * DFF + ch0 + 4 * n), bb = *(const f32x4*)(cb + ch0 + 4 * n);
#pragma unroll
                for (int m = 0; m < 4; ++m) { const int row = row0 + ai * 128 + m * 16; const f32x4 g = acc[ai][0][m][n], vv = acc[ai][1][m][n]; f32x4 p1, p2;
                    if (prompt) { const f32x4 gp = (m == 0) ? hal[n] : acc[ai][0][m > 0 ? m - 1 : 0][n];
#pragma unroll
                        for (int j = 0; j < 4; ++j) { p1[j] = dpp_ror1(fr == 15 ? gp[j] : g[j]); p2[j] = dpp_ror2(fr >= 14 ? gp[j] : g[j]); } }
                    else { const int t = fr & 3; const float* sp = stf + (size_t)((row - MP) >> 2) * 2 * DFF + ch0 + 4 * n;
                        f32x4 b0 = (f32x4){0.f, 0.f, 0.f, 0.f}, b1 = b0; if (t == 0) b0 = *(const f32x4*)sp; if (t <= 1) b1 = *(const f32x4*)(sp + DFF);
#pragma unroll
                        for (int j = 0; j < 4; ++j) { const float r1 = dpp_ror1(g[j]), r2 = dpp_ror2(g[j]); p1[j] = t >= 1 ? r1 : b1[j]; p2[j] = t >= 2 ? r2 : (t == 1 ? b1[j] : b0[j]); } }
                    float o[4];
#pragma unroll
                    for (int j = 0; j < 4; ++j) { const float y = bb[j] + w0[j] * p2[j] + w1[j] * p1[j] + w2[j] * g[j]; o[j] = gelu_tanh(y) * vv[j]; }
                    u32x2 w; w.x = cvt_pk_bf16(o[0], o[1]); w.y = cvt_pk_bf16(o[2], o[3]);
                    *(u32x2*)(ACT + (size_t)row * DFF + ch0 + 4 * n) = w; } } }
    }
};
struct EpiX2 {
    static constexpr bool PERM = false;
    const bf16_t* X1; bf16_t* X2; const float *sa, *sw;
    __device__ __forceinline__ void operator()(const f32x4 (&acc)[2][2][4][2], const pg8::Unit& u, int wr, int wc, int fr, int fq) const {
        const int row0 = u.pm * 256 + wr * 64 + fr, col0 = u.pn * 256 + wc * 32 + 4 * fq;
        f32x4 swv[2][2];
#pragma unroll
        for (int bj = 0; bj < 2; ++bj)
#pragma unroll
            for (int n = 0; n < 2; ++n) swv[bj][n] = *(const f32x4*)(sw + col0 + bj * 128 + n * 16);
        float sav[2][4];
#pragma unroll
        for (int ai = 0; ai < 2; ++ai)
#pragma unroll
            for (int m = 0; m < 4; ++m) sav[ai][m] = sa[row0 + ai * 128 + m * 16];
#pragma unroll
        for (int am = 0; am < 4; ++am) { const int ai = am >> 1, m0 = 2 * (am & 1); f32x4 r[2][2][2];
#pragma unroll
            for (int mm = 0; mm < 2; ++mm) { const size_t off = (size_t)(row0 + ai * 128 + (m0 + mm) * 16) * DM + col0;
#pragma unroll
                for (int bj = 0; bj < 2; ++bj)
#pragma unroll
                    for (int n = 0; n < 2; ++n) r[mm][bj][n] = ld_bf4(X1 + off + bj * 128 + n * 16); }
#pragma unroll
            for (int mm = 0; mm < 2; ++mm) { const size_t off = (size_t)(row0 + ai * 128 + (m0 + mm) * 16) * DM + col0;
#pragma unroll
                for (int bj = 0; bj < 2; ++bj)
#pragma unroll
                    for (int n = 0; n < 2; ++n) { const i32x4 q = __builtin_bit_cast(i32x4, acc[ai][bj][m0 + mm][n]);
                        const f32x4 v = (f32x4){(float)q[0], (float)q[1], (float)q[2], (float)q[3]} * swv[bj][n] * sav[ai][m0 + mm] + r[mm][bj][n];
                        u32x2 w; w.x = cvt_pk_bf16(v[0], v[1]); w.y = cvt_pk_bf16(v[2], v[3]); *(u32x2*)(X2 + off + bj * 128 + n * 16) = w; } } }
    }
};
struct EpiX1Q {
    static constexpr bool PERM = false;
    const float *xp, *xs; bf16_t* X1; const float *sa, *sw;
    __device__ __forceinline__ void operator()(const f32x4 (&acc)[2][2][4][2], const pg8::Unit& u, int wr, int wc, int fr, int fq) const {
        const int row0 = u.pm * 256 + wr * 64 + fr, col0 = u.pn * 256 + wc * 32 + 4 * fq;
        f32x4 swv[2][2];
#pragma unroll
        for (int bj = 0; bj < 2; ++bj)
#pragma unroll
            for (int n = 0; n < 2; ++n) swv[bj][n] = *(const f32x4*)(sw + col0 + bj * 128 + n * 16);
        float sav[2][4];
#pragma unroll
        for (int ai = 0; ai < 2; ++ai)
#pragma unroll
            for (int m = 0; m < 4; ++m) sav[ai][m] = sa[row0 + ai * 128 + m * 16];
#pragma unroll
        for (int am = 0; am < 4; ++am) { const int ai = am >> 1, m0 = 2 * (am & 1); f32x4 r[2][2][2];
#pragma unroll
            for (int mm = 0; mm < 2; ++mm) { const int row = row0 + ai * 128 + (m0 + mm) * 16; const float* xin = (row < MP ? xp + (size_t)row * DM : xs + (size_t)(row - MP) * DM) + col0;
#pragma unroll
                for (int bj = 0; bj < 2; ++bj)
#pragma unroll
                    for (int n = 0; n < 2; ++n) r[mm][bj][n] = *(const f32x4*)(xin + bj * 128 + n * 16); }
#pragma unroll
            for (int mm = 0; mm < 2; ++mm) { const size_t off = (size_t)(row0 + ai * 128 + (m0 + mm) * 16) * DM + col0;
#pragma unroll
                for (int bj = 0; bj < 2; ++bj)
#pragma unroll
                    for (int n = 0; n < 2; ++n) { const i32x4 q = __builtin_bit_cast(i32x4, acc[ai][bj][m0 + mm][n]);
                        const f32x4 v = (f32x4){(float)q[0], (float)q[1], (float)q[2], (float)q[3]} * swv[bj][n] * sav[ai][m0 + mm] + r[mm][bj][n];
                        u32x2 w; w.x = cvt_pk_bf16(v[0], v[1]); w.y = cvt_pk_bf16(v[2], v[3]); *(u32x2*)(X1 + off + bj * 128 + n * 16) = w; } } }
    }
};
struct EpiPart {
    static constexpr bool PERM = false;
    float* P;
    __device__ __forceinline__ void operator()(const f32x4 (&acc)[2][2][4][2], const pg8::Unit& u, int wr, int wc, int fr, int fq) const {
        float* base = P + ((size_t)(u.tl * 8 + u.ks) << 16) + (size_t)(wr * 64 + fr) * 256 + wc * 32 + 4 * fq;
#pragma unroll
        for (int ai = 0; ai < 2; ++ai)
#pragma unroll
            for (int m = 0; m < 4; ++m)
#pragma unroll
                for (int bj = 0; bj < 2; ++bj)
#pragma unroll
                    for (int n = 0; n < 2; ++n) *(f32x4*)(base + (size_t)(ai * 128 + m * 16) * 256 + bj * 128 + n * 16) = acc[ai][bj][m][n];
    }
};
struct EpiPartQ {
    static constexpr bool PERM = false;
    bf16_t* P; const float *sa, *sw;
    __device__ __forceinline__ void operator()(const f32x4 (&acc)[2][2][4][2], const pg8::Unit& u, int wr, int wc, int fr, int fq) const {
        bf16_t* base = P + ((size_t)(u.tl * 8 + u.ks) << 16) + (size_t)(wr * 64 + fr) * 256 + wc * 32 + 4 * fq;
        const int row0 = u.pm * 256 + wr * 64 + fr, col0 = u.pn * 256 + wc * 32 + 4 * fq;
        f32x4 swv[2][2];
#pragma unroll
        for (int bj = 0; bj < 2; ++bj)
#pragma unroll
            for (int n = 0; n < 2; ++n) swv[bj][n] = *(const f32x4*)(sw + col0 + bj * 128 + n * 16);
#pragma unroll
        for (int ai = 0; ai < 2; ++ai)
#pragma unroll
            for (int m = 0; m < 4; ++m) { const float sav = sa[row0 + ai * 128 + m * 16];
#pragma unroll
                for (int bj = 0; bj < 2; ++bj)
#pragma unroll
                    for (int n = 0; n < 2; ++n) { const i32x4 q = __builtin_bit_cast(i32x4, acc[ai][bj][m][n]);
                        const f32x4 v = (f32x4){(float)q[0], (float)q[1], (float)q[2], (float)q[3]} * swv[bj][n] * sav;
                        u32x2 o; o.x = cvt_pk_bf16(v[0], v[1]); o.y = cvt_pk_bf16(v[2], v[3]);
                        *(u32x2*)(base + (size_t)(ai * 128 + m * 16) * 256 + bj * 128 + n * 16) = o; } }
    }
};

__device__ __forceinline__ void p0_transpose_item(const float* W, int N, int k0, int n0, const float* gk, bf16_t* WT, int ldt, int dst_row0, LAS float* scr, int lane, unsigned* cmax = nullptr) {
    const int lq = lane >> 4, n4 = lane & 15; const bool inb = (n0 + 4 * n4) < N;
    f32x4 v[16];
#pragma unroll
    for (int i = 0; i < 16; ++i) v[i] = inb ? __builtin_nontemporal_load((const f32x4*)(W + (size_t)(k0 + 4 * i + lq) * N + n0 + 4 * n4)) : (f32x4){0.f, 0.f, 0.f, 0.f};
    if (gk) {
#pragma unroll
        for (int i = 0; i < 16; ++i) v[i] *= gk[k0 + 4 * i + lq]; }
#pragma unroll
    for (int i = 0; i < 16; ++i) { const int k = 4 * i + lq; *(LAS f32x4*)(scr + k * 64 + 4 * ((n4 ^ (2 * (k >> 3))) & 15)) = v[i]; }
    LDS_WAIT(); asm volatile("" ::: "memory");
    const int c = lane & 7, np = lane >> 3;
#pragma unroll
    for (int j = 0; j < 8; ++j) { const int n = np + 8 * j; const LAS float* sp = scr + (8 * c) * 64 + 4 * ((((n >> 2) ^ (2 * c)) & 15)) + (n & 3);
        u32x4 o; o.x = cvt_pk_bf16(sp[0 * 64], sp[1 * 64]); o.y = cvt_pk_bf16(sp[2 * 64], sp[3 * 64]); o.z = cvt_pk_bf16(sp[4 * 64], sp[5 * 64]); o.w = cvt_pk_bf16(sp[6 * 64], sp[7 * 64]);
        if (n0 + n < N) *(u32x4*)(WT + (size_t)(dst_row0 + n) * ldt + k0 + 8 * c) = o;
        if (cmax) { float mx = fmaxf(fmaxf(fmaxf(fabsf(sp[0 * 64]), fabsf(sp[1 * 64])), fmaxf(fabsf(sp[2 * 64]), fabsf(sp[3 * 64]))), fmaxf(fmaxf(fabsf(sp[4 * 64]), fabsf(sp[5 * 64])), fmaxf(fabsf(sp[6 * 64]), fabsf(sp[7 * 64]))));
            mx = fmaxf(mx, __shfl_xor(mx, 1)); mx = fmaxf(mx, __shfl_xor(mx, 2)); mx = fmaxf(mx, __shfl_xor(mx, 4));
            if (c == 0) atomicMax(cmax + dst_row0 + n, __float_as_uint(mx)); } }
    LDS_WAIT(); asm volatile("" ::: "memory");
}
__device__ __forceinline__ void p0_late_weights(Frame& F, int gw, int NGW) {
    LAS float* scr = (LAS float*)(F.lds + F.wave * 16384);
    constexpr int I_OUT = (DM / 64) * (DM / 64), I_UP = (DM / 64) * (2 * DFF / 64), I_DN = (DFF / 64) * (DM / 64);
    for (int it = gw; it < I_UP + I_DN + I_OUT; it += NGW) {
        int r = it;
        if (r < I_UP) { const int nblk = 2 * DFF / 64, kb = r / nblk, nb = r % nblk; const int n0 = 64 * nb, half = n0 / DFF, j = n0 % DFF;
            p0_transpose_item(F.in[25], 2 * DFF, 64 * kb, n0, F.in[24], WSP(bf16_t, WS_BT3), DM, (j / 128) * 256 + half * 128 + (j % 128), scr, F.lane, (unsigned*)(F.ws + WS_CTL) + CW_CMAX3); continue; } r -= I_UP;
        if (r < I_DN) { const int nblk = DM / 64, kb = r / nblk, nb = r % nblk; p0_transpose_item(F.in[28], DM, 64 * kb, 64 * nb, nullptr, WSP(bf16_t, WS_BT4), DFF, 64 * nb, scr, F.lane); continue; } r -= I_DN;
        { const int nblk = DM / 64, kb = r / nblk, nb = r % nblk; const int k0 = 64 * kb;
          const float* gk = k0 < DRNN ? F.in[16] : F.in[22] - DRNN;
          p0_transpose_item(F.in[23], DM, k0, 64 * nb, gk, WSP(bf16_t, WS_BT2), DM, 64 * nb, scr, F.lane); }
    }
}
constexpr int G1_PER = 26, G1_HI = 2, NGEMM1 = 8 * G1_PER + G1_HI, NSTREAM = 256 - NGEMM1;
__device__ __forceinline__ void p0_prologue(Frame& F) {
    LAS float* scr = (LAS float*)(F.lds + F.wave * 16384);
    const int gw = F.wave * F.G + blockIdx.x, NGW = F.G * 8;
    constexpr int NB_IN = (INC + 63) / 64;
    constexpr int I_IN = (DM / 64) * NB_IN, I_G = 16 * 4 * 4;
    for (int it = gw; it < I_IN + I_G; it += NGW) {
        int r = it;
        if (r < I_IN) { const int kb = r / NB_IN, nb = r % NB_IN; p0_transpose_item(F.in[8], INC, 64 * kb, 64 * nb, F.in[7], WSP(bf16_t, WS_BT1), DM, 64 * nb, scr, F.lane); continue; } r -= I_IN;
        { const int mat = r / 16, rr = r % 16, kb = rr / 4, nb = rr % 4, gate = mat / 8, h = mat % 8, n0 = 64 * nb, hc = n0 / 128, idx = n0 % 128;
          const float* W = (gate ? F.in[13] : F.in[11]) + (size_t)h * 65536;
          p0_transpose_item(W, 256, 64 * kb, n0, nullptr, WSP(bf16_t, WS_BTG), 256, ((h * 2 + hc) * 2 + gate) * 128 + idx, scr, F.lane); }
    }
    if (F.G != 256) p0_late_weights(F, gw, NGW);
    bf16_t* XB = WSP(bf16_t, WS_XB); float* rs1 = WSP(float, WS_RS1);
    for (int m = gw; m < M; m += NGW) {
        const float* xr = (m < MP ? F.in[0] + (size_t)m * DM : F.in[1] + (size_t)(m - MP) * DM);
        f32x4 v[16]; float ss = 0.f;
#pragma unroll
        for (int j = 0; j < 16; ++j) { v[j] = __builtin_nontemporal_load((const f32x4*)(xr + 4 * (F.lane + 64 * j))); ss += (v[j][0] * v[j][0] + v[j][1] * v[j][1]) + (v[j][2] * v[j][2] + v[j][3] * v[j][3]); }
        ss = wave_sum(ss);
        if (F.lane == 0) rs1[m] = rsqrtf(ss * (1.0f / DM) + EPS);
#pragma unroll
        for (int j = 0; j < 16; ++j) { u32x2 w; w.x = cvt_pk_bf16(v[j][0], v[j][1]); w.y = cvt_pk_bf16(v[j][2], v[j][3]); *(u32x2*)(XB + (size_t)m * DM + 4 * (F.lane + 64 * j)) = w; }
    }
    { float* sp8 = WSP(float, WS_SP8); const int gt = blockIdx.x * 512 + F.tid; if (gt < DRNN) sp8[gt] = 8.0f * softplusf_(-F.in[15][gt]); }
}

constexpr int SI_W = 2048, SI_B = SI_W + 128 * 272, SI_X = SI_B + 128 * 272, SI_XP = 144, SI_END = SI_X + 128 * SI_XP;
constexpr int SI_X2 = SI_END + 8 * 384 * 4;
static_assert(SI_X2 + 128 * SI_XP <= LDSCTL_OFF, "ssd intra LDS map");
typedef unsigned short u16x4 __attribute__((ext_vector_type(4)));
template <int PITCH>
__device__ __forceinline__ void tr_frags(unsigned a, bf16x8 (&f)[4]) {
    u16x4 r[8];
    asm volatile("ds_read_b64_tr_b16 %0, %8 offset:%9\n\tds_read_b64_tr_b16 %1, %8 offset:%10\n\tds_read_b64_tr_b16 %2, %8 offset:%11\n\tds_read_b64_tr_b16 %3, %8 offset:%12\n\t"
                 "ds_read_b64_tr_b16 %4, %8 offset:%13\n\tds_read_b64_tr_b16 %5, %8 offset:%14\n\tds_read_b64_tr_b16 %6, %8 offset:%15\n\tds_read_b64_tr_b16 %7, %8 offset:%16\n\ts_waitcnt lgkmcnt(0)"
                 : "=&v"(r[0]), "=&v"(r[1]), "=&v"(r[2]), "=&v"(r[3]), "=&v"(r[4]), "=&v"(r[5]), "=&v"(r[6]), "=&v"(r[7])
                 : "v"(a), "n"(0 * PITCH), "n"(4 * PITCH), "n"(32 * PITCH), "n"(36 * PITCH), "n"(64 * PITCH), "n"(68 * PITCH), "n"(96 * PITCH), "n"(100 * PITCH) : "memory");
#pragma unroll
    for (int ks = 0; ks < 4; ++ks) f[ks] = (bf16x8){(short)r[2 * ks][0], (short)r[2 * ks][1], (short)r[2 * ks][2], (short)r[2 * ks][3], (short)r[2 * ks + 1][0], (short)r[2 * ks + 1][1], (short)r[2 * ks + 1][2], (short)r[2 * ks + 1][3]};
}
struct SgPre { u32x4 x[2]; };
__device__ __forceinline__ void ssd_head_load(Frame& F, SgPre& P, int bc, int hd) {
    const int row0 = bc * 128, tid = F.tid; const bf16_t* XS = WSP(bf16_t, WS_XS);
#pragma unroll
    for (int k = 0; k < 2; ++k) { const int id = tid + 512 * k, r = id >> 3, c = id & 7; P.x[k] = *(const u32x4*)(XS + (size_t)(row0 + r) * DSSM + hd * 64 + 8 * c); }
}
__device__ __forceinline__ void ssd_group_unit(Frame& F, int bc, int g) {
    LAS float* SC = (LAS float*)(F.lds + SI_END);
    LAS bf16_t* Wl = (LAS bf16_t*)(F.lds + SI_W);
    const int row0 = bc * 128, w = F.wave, tid = F.tid, lane = F.lane, li = lane & 15, lq = lane >> 4;
    const unsigned ldsb = (unsigned)(size_t)F.lds;
    const unsigned tq = (unsigned)(8 * lq + (li >> 2)), tp = (unsigned)(4 * (li & 3));
    const bf16_t* BC = WSP(bf16_t, WS_BC);
    SgPre P; ssd_head_load(F, P, bc, 8 * g);
    { u32x4 bq[4];
#pragma unroll
      for (int k = 0; k < 4; ++k) { const int id = tid + 512 * k, r = id >> 4, c = id & 15; bq[k] = *(const u32x4*)(BC + (size_t)(row0 + r) * 1024 + g * 128 + 8 * c); }
      __syncthreads();
#pragma unroll
      for (int k = 0; k < 4; ++k) { const int id = tid + 512 * k, r = id >> 4, c = id & 15; *(LAS u32x4*)(F.lds + SI_B + r * 272 + 16 * c) = bq[k]; } }
    bf16x8 cf[4];
#pragma unroll
    for (int ks = 0; ks < 4; ++ks) cf[ks] = *(const bf16x8*)(BC + (size_t)(row0 + 16 * w + li) * 1024 + 512 + g * 128 + ks * 32 + 8 * lq);
    asm volatile("s_waitcnt lgkmcnt(0)" ::: "memory");
    __syncthreads();
    f32x4 Gr[8];
#pragma unroll
    for (int sb = 0; sb < 8; ++sb) { Gr[sb] = (f32x4){0.f, 0.f, 0.f, 0.f};
        if (sb <= w) {
#pragma unroll
            for (int ks = 0; ks < 4; ++ks) Gr[sb] = __builtin_amdgcn_mfma_f32_16x16x32_bf16(*(const LAS bf16x8*)(F.lds + SI_B + (16 * sb + li) * 272 + (ks * 32 + 8 * lq) * 2), cf[ks], Gr[sb], 0, 0, 0); } }
    { const int hdw = 8 * g + w; const float* DTA = WSP(float, WS_DTA);
      const float d0 = DTA[(size_t)(row0 + lane) * NH + hdw], d1 = DTA[(size_t)(row0 + 64 + lane) * NH + hdw];
      const float A = -__expf(F.in[20][hdw]);
      float a0 = d0 * A, a1 = d1 * A;
#pragma unroll
      for (int o = 1; o < 64; o <<= 1) { const float t0 = __shfl_up(a0, o), t1 = __shfl_up(a1, o); if (lane >= o) { a0 += t0; a1 += t1; } }
      a1 += __shfl(a0, 63);
      const float last = __shfl(a1, 63);
      LAS float* c = SC + w * 384;
      c[lane] = a0; c[64 + lane] = a1; c[128 + lane] = d0; c[192 + lane] = d1;
      c[256 + lane] = __expf(last - a0) * d0; c[320 + lane] = __expf(last - a1) * d1;
      float* CUM = WSP(float, WS_CUM);
      CUM[(size_t)(row0 + lane) * NH + hdw] = a0; CUM[(size_t)(row0 + 64 + lane) * NH + hdw] = a1;
      if (lane == 0) WSP(float, WS_DEC)[bc * NH + hdw] = __expf(last); }
    bf16x8 btr[4]; tr_frags<272>(ldsb + SI_B + tq * 272 + (16 * w + tp) * 2, btr);
#pragma unroll 1
    for (int hl = 0; hl < 8; ++hl) { const int hd = 8 * g + hl;
        const unsigned xb = (hl & 1) ? (unsigned)SI_X2 : (unsigned)SI_X;
#pragma unroll
        for (int k = 0; k < 2; ++k) { const int id = tid + 512 * k, r = id >> 3, c = id & 7; *(LAS u32x4*)(F.lds + xb + r * SI_XP + 16 * c) = P.x[k]; }
        LAS float* cumS = SC + hl * 384; LAS float* dtS = cumS + 128; LAS float* decS = cumS + 256;
        LDS_BARRIER();
        ssd_head_load(F, P, bc, hl < 7 ? hd + 1 : hd);
        bf16x8 xf[4][4];
#pragma unroll
        for (int pb = 0; pb < 4; ++pb) tr_frags<SI_XP>(ldsb + xb + tq * SI_XP + (pb * 16 + tp) * 2, xf[pb]);
        { const int t = 16 * w + li; const float cum_t = cumS[t];
#pragma unroll
          for (int sb = 0; sb < 8; ++sb) if (sb <= w) {
              const f32x4 cs = *(const LAS f32x4*)(cumS + 16 * sb + 4 * lq), ds = *(const LAS f32x4*)(dtS + 16 * sb + 4 * lq); float wv[4];
#pragma unroll
              for (int r = 0; r < 4; ++r) { const int s2 = 16 * sb + 4 * lq + r; wv[r] = (s2 <= t) ? Gr[sb][r] * __expf(cum_t - cs[r]) * ds[r] : 0.f; }
              u32x2 pw; pw.x = cvt_pk_bf16(wv[0], wv[1]); pw.y = cvt_pk_bf16(wv[2], wv[3]);
              *(LAS u32x2*)(Wl + t * 136 + 16 * sb + 4 * lq) = pw; }
          if ((w & 1) == 0) *(LAS u32x2*)(Wl + t * 136 + 16 * (w + 1) + 4 * lq) = (u32x2){0u, 0u}; }
        asm volatile("s_waitcnt lgkmcnt(0)" ::: "memory");
        { f32x4 ay[4];
#pragma unroll
          for (int pb = 0; pb < 4; ++pb) ay[pb] = (f32x4){0.f, 0.f, 0.f, 0.f};
          const int nks = (w >> 1) + 1;
#pragma unroll
          for (int ks = 0; ks < 4; ++ks) if (ks < nks) { const bf16x8 wf = *(const LAS bf16x8*)(Wl + (16 * w + li) * 136 + ks * 32 + 8 * lq);
#pragma unroll
              for (int pb = 0; pb < 4; ++pb) ay[pb] = __builtin_amdgcn_mfma_f32_16x16x32_bf16(xf[pb][ks], wf, ay[pb], 0, 0, 0); }
          bf16_t* YD = WSP(bf16_t, WS_YD) + (size_t)(row0 + 16 * w + li) * DSSM + hd * 64 + 4 * lq;
#pragma unroll
          for (int pb = 0; pb < 4; ++pb) { u32x2 o; o.x = cvt_pk_bf16(ay[pb][0], ay[pb][1]); o.y = cvt_pk_bf16(ay[pb][2], ay[pb][3]); *(u32x2*)(YD + pb * 16) = o; } }
        { bf16x8 bt[4];
#pragma unroll
          for (int ks = 0; ks < 4; ++ks) { const u32x4 raw = __builtin_bit_cast(u32x4, btr[ks]);
              const f32x4 d0 = *(const LAS f32x4*)(decS + ks * 32 + 8 * lq), d1 = *(const LAS f32x4*)(decS + ks * 32 + 8 * lq + 4);
              u32x4 sc; sc.x = cvt_pk_bf16(bf_lo(raw.x) * d0[0], bf_hi(raw.x) * d0[1]); sc.y = cvt_pk_bf16(bf_lo(raw.y) * d0[2], bf_hi(raw.y) * d0[3]);
              sc.z = cvt_pk_bf16(bf_lo(raw.z) * d1[0], bf_hi(raw.z) * d1[1]); sc.w = cvt_pk_bf16(bf_lo(raw.w) * d1[2], bf_hi(raw.w) * d1[3]);
              bt[ks] = __builtin_bit_cast(bf16x8, sc); }
          float* ST = WSP(float, WS_ST) + ((size_t)(bc * NH + hd) * 64 + li) * 128 + 16 * w + 4 * lq;
#pragma unroll
          for (int pb = 0; pb < 4; ++pb) { f32x4 as = (f32x4){0.f, 0.f, 0.f, 0.f};
#pragma unroll
              for (int ks = 0; ks < 4; ++ks) as = __builtin_amdgcn_mfma_f32_16x16x32_bf16(bt[ks], xf[pb][ks], as, 0, 0, 0);
              *(f32x4*)(ST + (size_t)pb * 16 * 128) = as; } }
    }
}
__device__ __forceinline__ void ssd_intra_all(Frame& F) {
    for (int u = blockIdx.x; u < NCH * NG; u += F.G) ssd_group_unit(F, u >> 2, u & 3);
    __syncthreads();
}
struct SsPre { f32x4 h0[4]; float dt[4]; bf16_t x[4]; };
struct SsBC { u32x2 bq[4][4], cq[4][4]; };
__device__ __forceinline__ void ssd_sample_load(Frame& F, SsPre& P, int s, int hd) {
    const int tid = F.tid, p = tid >> 3, nq = tid & 7, r0 = MP + 4 * s;
    const float* DTA = WSP(float, WS_DTA); const bf16_t* XS = WSP(bf16_t, WS_XS);
    const float* h0p = F.in[4] + (((size_t)s * NH + hd) * 64 + p) * 128 + 4 * nq;
#pragma unroll
    for (int j = 0; j < 4; ++j) P.h0[j] = __builtin_nontemporal_load((const f32x4*)(h0p + 32 * j));
#pragma unroll
    for (int t = 0; t < 4; ++t) { P.dt[t] = DTA[(size_t)(r0 + t) * NH + hd]; P.x[t] = XS[(size_t)(r0 + t) * DSSM + hd * 64 + p]; }
}
__device__ __forceinline__ void ssd_sample_loadbc(Frame& F, SsBC& Q, int s, int g) {
    const int nq = F.tid & 7, r0 = MP + 4 * s; const bf16_t* BC = WSP(bf16_t, WS_BC);
#pragma unroll
    for (int t = 0; t < 4; ++t) { const bf16_t* br = BC + (size_t)(r0 + t) * 1024 + g * 128 + 4 * nq;
#pragma unroll
        for (int j = 0; j < 4; ++j) { Q.bq[t][j] = *(const u32x2*)(br + 32 * j); Q.cq[t][j] = *(const u32x2*)(br + 512 + 32 * j); } }
}
__device__ __forceinline__ void ssd_sample_compute(Frame& F, const SsPre& P, const SsBC& Q, int s, int hd, const LAS float* scb, const LAS float* atab) {
    const int tid = F.tid, p = tid >> 3, nq = tid & 7, r0 = MP + 4 * s;
    const u32x2 (&bq)[4][4] = Q.bq; const u32x2 (&cq)[4][4] = Q.cq;
    const float A = atab[hd];
    float dt[4], cum[4], x[4]; float run = 0.f;
#pragma unroll
    for (int t = 0; t < 4; ++t) { dt[t] = P.dt[t]; run += dt[t] * A; cum[t] = run; x[t] = bf2f(P.x[t]); }
    float yoff[4];
#pragma unroll
    for (int t = 0; t < 4; ++t) { float a = 0.f;
#pragma unroll
        for (int j = 0; j < 4; ++j) a += (bf_lo(cq[t][j].x) * P.h0[j][0] + bf_hi(cq[t][j].x) * P.h0[j][1]) + (bf_lo(cq[t][j].y) * P.h0[j][2] + bf_hi(cq[t][j].y) * P.h0[j][3]);
        yoff[t] = a; }
#pragma unroll
    for (int o = 1; o < 8; o <<= 1) {
#pragma unroll
        for (int t = 0; t < 4; ++t) yoff[t] += __shfl_xor(yoff[t], o); }
    if (nq == 0) {
        float* YD = WSP(float, WS_YD);
#pragma unroll
        for (int t = 0; t < 4; ++t) { float y = __expf(cum[t]) * yoff[t];
#pragma unroll
            for (int s2 = 0; s2 < 4; ++s2) if (s2 <= t) y += scb[t * (t + 1) / 2 + s2] * __expf(cum[t] - cum[s2]) * dt[s2] * x[s2];
            YD[(size_t)(r0 + t) * DSSM + hd * 64 + p] = y; }
    }
    const float dec3 = __expf(cum[3]); float cx[4];
#pragma unroll
    for (int t = 0; t < 4; ++t) cx[t] = __expf(cum[3] - cum[t]) * dt[t] * x[t];
    float* hp = F.out + O_SSH + (((size_t)s * NH + hd) * 64 + p) * 128 + 4 * nq;
#pragma unroll
    for (int j = 0; j < 4; ++j) { f32x4 hn = P.h0[j] * dec3;
#pragma unroll
        for (int t = 0; t < 4; ++t) { hn[0] += bf_lo(bq[t][j].x) * cx[t]; hn[1] += bf_hi(bq[t][j].x) * cx[t]; hn[2] += bf_lo(bq[t][j].y) * cx[t]; hn[3] += bf_hi(bq[t][j].y) * cx[t]; }
        __builtin_nontemporal_store(hn, (f32x4*)(hp + 32 * j)); }
}
__device__ __forceinline__ void ssd_sample_all(Frame& F) {
    LAS float* atab = (LAS float*)F.lds;
    LAS float* scb = atab + 32;
    if (F.tid < NH) atab[F.tid] = -__expf(F.in[20][F.tid]);
    const bf16_t* BC = WSP(bf16_t, WS_BC);
    int start, count; const int c = blockIdx.x;
    if (F.G == 256) { if (c < 32) { count = 10; start = 10 * c; } else { const int i = c - 32; count = i < 192 ? 17 : 16; start = 320 + (i < 192 ? 17 * i : 17 * 192 + 16 * (i - 192)); } }
    else { const int per = (NSQ * NH + F.G - 1) / F.G; start = c * per; count = NSQ * NH - start; count = count < 0 ? 0 : (count > per ? per : count); }
    SsBC Q; int cur = -1;
#pragma unroll 1
    for (int b0 = 0; b0 < count; b0 += 32) { const int nb = count - b0 < 32 ? count - b0 : 32;
        __syncthreads();
        if (F.tid < nb * 10) { const int k = F.tid / 10, pr = F.tid % 10, u = start + b0 + k;
            const int t = pr < 1 ? 0 : pr < 3 ? 1 : pr < 6 ? 2 : 3, s2 = pr - t * (t + 1) / 2, r0 = MP + 4 * (u >> 5), g = (u & 31) >> 3;
            const bf16_t* cr = BC + (size_t)(r0 + t) * 1024 + 512 + g * 128; const bf16_t* br = BC + (size_t)(r0 + s2) * 1024 + g * 128; float a = 0.f;
#pragma unroll
            for (int q = 0; q < 16; ++q) { const u32x4 cv = *(const u32x4*)(cr + 8 * q), bv = *(const u32x4*)(br + 8 * q);
                a += (bf_lo(cv.x) * bf_lo(bv.x) + bf_hi(cv.x) * bf_hi(bv.x)) + (bf_lo(cv.y) * bf_lo(bv.y) + bf_hi(cv.y) * bf_hi(bv.y)) + (bf_lo(cv.z) * bf_lo(bv.z) + bf_hi(cv.z) * bf_hi(bv.z)) + (bf_lo(cv.w) * bf_lo(bv.w) + bf_hi(cv.w) * bf_hi(bv.w)); }
            scb[k * 16 + pr] = a; }
        __syncthreads();
        SsPre A, B; const int ub = start + b0, ulast = ub + nb - 1;
        ssd_sample_load(F, A, ub >> 5, ub & 31);
        FULL_FENCE();
#pragma unroll 1
        for (int k = 0; k < nb; k += 2) {
            const int u = ub + k, u1 = u + 1 < ulast ? u + 1 : ulast, u2 = u + 2 < ulast ? u + 2 : ulast;
            if ((u >> 3) != cur) { ssd_sample_loadbc(F, Q, u >> 5, (u & 31) >> 3); cur = u >> 3; }
            ssd_sample_load(F, B, u1 >> 5, u1 & 31);
            FULL_FENCE();
            ssd_sample_compute(F, A, Q, u >> 5, u & 31, scb + k * 16, atab);
            FULL_FENCE();
            if (k + 1 < nb) { if ((u1 >> 3) != cur) { ssd_sample_loadbc(F, Q, u1 >> 5, (u1 & 31) >> 3); cur = u1 >> 3; }
                ssd_sample_load(F, A, u2 >> 5, u2 & 31);
                FULL_FENCE();
                ssd_sample_compute(F, B, Q, u1 >> 5, u1 & 31, scb + (k + 1) * 16, atab);
                FULL_FENCE(); }
        }
    }
}
__device__ __forceinline__ void p4_scan(Frame& F) {
    const unsigned* AB = WSP(unsigned, WS_AB); const bf16_t* G2 = WSP(bf16_t, WS_G2); bf16_t* CAT = WSP(bf16_t, WS_CAT); float* SSQ = WSP(float, WS_SSQRG);
    LAS f32x2* carr = (LAS f32x2*)F.lds;
    for (int u = blockIdx.x; u < NB * 64; u += F.G) {
        const int b = u >> 6, slab = u & 63, cl = F.tid & 31, seg = F.tid >> 5, ch = slab * 32 + cl, rowb = b * SEQ + seg * 128;
        float Ap = 1.f, hl = 0.f;
#pragma unroll 1
        for (int tt = 0; tt < 128; tt += 32) { unsigned v[32];
#pragma unroll
            for (int k = 0; k < 32; ++k) v[k] = AB[(size_t)(rowb + tt + k) * DRNN + ch];
#pragma unroll
            for (int k = 0; k < 32; ++k) { const float a = 1.0f - bf_lo(v[k]); Ap *= a; hl = a * hl + bf_hi(v[k]); } }
        __syncthreads();
        carr[seg * 32 + cl] = (f32x2){Ap, hl};
        __syncthreads();
        float h = 0.f;
        for (int s2 = 0; s2 < seg; ++s2) { const f32x2 c = carr[s2 * 32 + cl]; h = c[0] * h + c[1]; }
#pragma unroll 1
        for (int tt = 0; tt < 128; tt += 32) { unsigned v[32]; float gt[32];
#pragma unroll
            for (int k = 0; k < 32; ++k) { v[k] = AB[(size_t)(rowb + tt + k) * DRNN + ch]; gt[k] = bf2f(G2[(size_t)(rowb + tt + k) * 4096 + ch]); }
            float q[32];
#pragma unroll
            for (int k = 0; k < 32; ++k) { h = (1.0f - bf_lo(v[k])) * h + bf_hi(v[k]); const float o = h * gt[k];
                CAT[(size_t)(rowb + tt + k) * DM + ch] = (bf16_t)(cvt_pk_bf16(o, 0.f) & 0xffffu); q[k] = o * o; }
#define SCAN_BFLY(HB) do { const bool up = (cl & (HB)) != 0; _Pragma("unroll") for (int k = 0; k < (HB); ++k) { const float send = up ? q[k] : q[k + (HB)], keep = up ? q[k + (HB)] : q[k]; q[k] = keep + __shfl_xor(send, (HB)); } } while (0)
            SCAN_BFLY(16); SCAN_BFLY(8); SCAN_BFLY(4); SCAN_BFLY(2); SCAN_BFLY(1);
#undef SCAN_BFLY
            SSQ[(size_t)(rowb + tt + cl) * 64 + slab] = q[0]; }
        if (seg == 15) F.out[O_PRGH + (size_t)b * DRNN + ch] = h;
    }
    { const size_t gt = (size_t)blockIdx.x * 512 + F.tid, NT = (size_t)F.G * 512;
      for (size_t it = gt; it < (size_t)NSQ * DRNN; it += NT) { const int s = (int)(it >> 11), ch = (int)(it & 2047); float h = F.in[2][it];
#pragma unroll
          for (int t = 0; t < 4; ++t) { const int row = MP + 4 * s + t; const unsigned v = AB[(size_t)row * DRNN + ch]; h = (1.0f - bf_lo(v)) * h + bf_hi(v);
              const float o = h * bf2f(G2[(size_t)row * 4096 + ch]); CAT[(size_t)row * DM + ch] = (bf16_t)(cvt_pk_bf16(o, 0.f) & 0xffffu);
              const float q = wave_sum(o * o);
              if (F.lane == 0) { SSQ[(size_t)row * 64 + 2 * (ch >> 6)] = q; SSQ[(size_t)row * 64 + 2 * (ch >> 6) + 1] = 0.f; } }
          F.out[O_SRGH + it] = h; } }
    { const float* ST = WSP(float, WS_ST); const float* DEC = WSP(float, WS_DEC); bf16_t* HPB = WSP(bf16_t, WS_HPB);
      const size_t gt = (size_t)blockIdx.x * 512 + F.tid, NT = (size_t)F.G * 512;
      for (size_t it = gt; it < (size_t)NB * NH * 64 * 32; it += NT) { const int b = (int)(it >> 16), rem = (int)(it & 65535), hd = rem >> 11, e = rem & 2047;
          f32x4 h = (f32x4){0.f, 0.f, 0.f, 0.f}; f32x4 stv[16]; float dcv[16];
#pragma unroll
          for (int c = 0; c < 16; ++c) { const int bc = b * 16 + c; stv[c] = __builtin_nontemporal_load((const f32x4*)(ST + ((size_t)(bc * NH + hd) * 8192) + 4 * e)); dcv[c] = DEC[bc * NH + hd]; }
#pragma unroll
          for (int c = 0; c < 16; ++c) { const int bc = b * 16 + c; const size_t o = ((size_t)(bc * NH + hd) * 8192) + 4 * e;
              u32x2 w; w.x = cvt_pk_bf16(h[0], h[1]); w.y = cvt_pk_bf16(h[2], h[3]); *(u32x2*)(HPB + o) = w;
              h = h * dcv[c] + stv[c]; }
          *(f32x4*)(F.out + O_PSH + ((size_t)(b * NH + hd) * 8192) + 4 * e) = h; } }
}

constexpr int P5_HT_OFF = 8 * 16640;
static_assert(P5_HT_OFF + 64 * 272 <= LDSCTL_OFF, "P5 LDS map");
__device__ __forceinline__ void p5_unit(Frame& F, int g, int bc) {
    const int w = F.wave, lane = F.lane, li = lane & 15, lq = lane >> 4, row0 = bc * 128, row = row0 + 16 * w + li;
    const bf16_t* BC = WSP(bf16_t, WS_BC); bf16_t* CAT = WSP(bf16_t, WS_CAT);
    LAS unsigned char* U = F.lds + w * 16640;
    bf16x8 cf[4];
#pragma unroll
    for (int ks = 0; ks < 4; ++ks) cf[ks] = *(const bf16x8*)(BC + (size_t)row * 1024 + 512 + g * 128 + ks * 32 + 8 * lq);
    float ss = 0.f;
    const bf16_t* HPB = WSP(bf16_t, WS_HPB); const bf16_t* XS = WSP(bf16_t, WS_XS); const bf16_t* YD = WSP(bf16_t, WS_YD); const float* CUM = WSP(float, WS_CUM); const bf16_t* G2 = WSP(bf16_t, WS_G2);
    LAS unsigned char* HT = F.lds + P5_HT_OFF;
    u32x4 hq[2];
#pragma unroll
    for (int k = 0; k < 2; ++k) { const int id = F.tid + 512 * k; hq[k] = *(const u32x4*)(HPB + (size_t)(bc * NH + 8 * g) * 8192 + (id >> 4) * 128 + 8 * (id & 15)); }
#pragma unroll 1
    for (int hl = 0; hl < 8; ++hl) { const int hd = 8 * g + hl;
        LDS_BARRIER();
#pragma unroll
        for (int k = 0; k < 2; ++k) { const int id = F.tid + 512 * k; *(LAS u32x4*)(HT + (id >> 4) * 272 + 16 * (id & 15)) = hq[k]; }
        u32x2 yw[4], zw[4], xw[4];
        const float ecr = CUM[(size_t)row * NH + hd], Dh = F.in[21][hd];
#pragma unroll
        for (int pb = 0; pb < 4; ++pb) { const int ch = hd * 64 + pb * 16 + 4 * lq;
            yw[pb] = __builtin_nontemporal_load((const u32x2*)(YD + (size_t)row * DSSM + ch)); zw[pb] = *(const u32x2*)(G2 + (size_t)row * 4096 + 2048 + ch); xw[pb] = *(const u32x2*)(XS + (size_t)row * DSSM + ch); }
        { const int hn = hl < 7 ? hd + 1 : hd;
#pragma unroll
          for (int k = 0; k < 2; ++k) { const int id = F.tid + 512 * k; hq[k] = *(const u32x4*)(HPB + (size_t)(bc * NH + hn) * 8192 + (id >> 4) * 128 + 8 * (id & 15)); } }
        LDS_BARRIER();
        const float ec = __expf(ecr);
#pragma unroll
        for (int pb = 0; pb < 4; ++pb) { f32x4 a = (f32x4){0.f, 0.f, 0.f, 0.f};
#pragma unroll
            for (int ks = 0; ks < 4; ++ks) a = __builtin_amdgcn_mfma_f32_16x16x32_bf16(*(const LAS bf16x8*)(HT + (pb * 16 + li) * 272 + (ks * 32 + 8 * lq) * 2), cf[ks], a, 0, 0, 0);
            const float xv[4] = {bf_lo(xw[pb].x), bf_hi(xw[pb].x), bf_lo(xw[pb].y), bf_hi(xw[pb].y)}; const float zv[4] = {bf_lo(zw[pb].x), bf_hi(zw[pb].x), bf_lo(zw[pb].y), bf_hi(zw[pb].y)}; float v[4];
            const float yv[4] = {bf_lo(yw[pb].x), bf_hi(yw[pb].x), bf_lo(yw[pb].y), bf_hi(yw[pb].y)};
#pragma unroll
            for (int r = 0; r < 4; ++r) { const float y = yv[r] + ec * a[r] + Dh * xv[r]; v[r] = y * zv[r]; ss += v[r] * v[r]; }
            u32x2 o; o.x = cvt_pk_bf16(v[0], v[1]); o.y = cvt_pk_bf16(v[2], v[3]);
            *(LAS u32x2*)(U + li * 1040 + (hl * 64 + pb * 16 + 4 * lq) * 2) = o; }
    }
    ss += __shfl_xor(ss, 16); ss += __shfl_xor(ss, 32);
    const float rs = rsqrtf(ss * (1.0f / 512.0f) + EPS);
    asm volatile("s_waitcnt lgkmcnt(0)" ::: "memory");
#pragma unroll 4
    for (int j = 0; j < 16; ++j) { const float rj = __shfl(rs, j); u32x4 v = *(const LAS u32x4*)(U + j * 1040 + lane * 16);
        v.x = cvt_pk_bf16(bf_lo(v.x) * rj, bf_hi(v.x) * rj); v.y = cvt_pk_bf16(bf_lo(v.y) * rj, bf_hi(v.y) * rj); v.z = cvt_pk_bf16(bf_lo(v.z) * rj, bf_hi(v.z) * rj); v.w = cvt_pk_bf16(bf_lo(v.w) * rj, bf_hi(v.w) * rj);
        *(u32x4*)(CAT + (size_t)(row0 + 16 * w + j) * DM + DRNN + g * 512 + lane * 8) = v; }
    asm volatile("s_waitcnt lgkmcnt(0)" ::: "memory");
}
__device__ __forceinline__ void p5_norms(Frame& F, bool rg_rows) {
    const int gw = F.wave * F.G + blockIdx.x, NGW = F.G * 8;
    if (rg_rows && gw < M) { const float* SSQ = WSP(float, WS_SSQRG); bf16_t* CAT = WSP(bf16_t, WS_CAT);
      const int rlast = gw + ((M - 1 - gw) / NGW) * NGW;
      float qa, qb; u32x4 ca[4], cb[4];
#define P5_RG_LOAD(q_, c_, r_) do { q_ = SSQ[(size_t)(r_) * 64 + F.lane]; _Pragma("unroll") for (int j = 0; j < 4; ++j) c_[j] = *(const u32x4*)(CAT + (size_t)(r_) * DM + 8 * (F.lane + 64 * j)); } while (0)
#define P5_RG_FIN(q_, c_, r_) do { const float rs = rsqrtf(wave_sum(q_) * (1.0f / DRNN) + EPS); _Pragma("unroll") for (int j = 0; j < 4; ++j) { u32x4 v = c_[j]; \
          v.x = cvt_pk_bf16(bf_lo(v.x) * rs, bf_hi(v.x) * rs); v.y = cvt_pk_bf16(bf_lo(v.y) * rs, bf_hi(v.y) * rs); v.z = cvt_pk_bf16(bf_lo(v.z) * rs, bf_hi(v.z) * rs); v.w = cvt_pk_bf16(bf_lo(v.w) * rs, bf_hi(v.w) * rs); \
          *(u32x4*)(CAT + (size_t)(r_) * DM + 8 * (F.lane + 64 * j)) = v; } } while (0)
      P5_RG_LOAD(qa, ca, gw);
#pragma unroll 1
      for (int row = gw; row <= rlast; row += 2 * NGW) {
          const int r1 = row + NGW < rlast ? row + NGW : rlast, r2 = row + 2 * NGW < rlast ? row + 2 * NGW : rlast;
          const bool two = row + NGW <= rlast;
          P5_RG_LOAD(qb, cb, r1);
          FULL_FENCE();
          P5_RG_FIN(qa, ca, row); FULL_FENCE();
          if (two) { P5_RG_LOAD(qa, ca, r2); FULL_FENCE(); P5_RG_FIN(qb, cb, r1); FULL_FENCE(); }
      }
#undef P5_RG_LOAD
#undef P5_RG_FIN
    }
    { const float* YD = WSP(float, WS_YD); const bf16_t* G2 = WSP(bf16_t, WS_G2); const bf16_t* XS = WSP(bf16_t, WS_XS); bf16_t* CAT = WSP(bf16_t, WS_CAT);
      for (int it = gw; it < MS * NG; it += NGW) { const int row = MP + (it >> 2), g = it & 3, ch = g * 512 + 8 * F.lane; const float Dh = F.in[21][ch >> 6];
          const f32x4 y0 = *(const f32x4*)(YD + (size_t)row * DSSM + ch), y1 = *(const f32x4*)(YD + (size_t)row * DSSM + ch + 4);
          const f32x4 z0 = ld_bf4(G2 + (size_t)row * 4096 + 2048 + ch), z1 = ld_bf4(G2 + (size_t)row * 4096 + 2048 + ch + 4);
          const u32x4 xw = *(const u32x4*)(XS + (size_t)row * DSSM + ch);
          const float xv[8] = {bf_lo(xw.x), bf_hi(xw.x), bf_lo(xw.y), bf_hi(xw.y), bf_lo(xw.z), bf_hi(xw.z), bf_lo(xw.w), bf_hi(xw.w)};
          float v[8]; float ss = 0.f;
#pragma unroll
          for (int e = 0; e < 8; ++e) { const float y = (e < 4 ? y0[e & 3] : y1[e & 3]) + Dh * xv[e]; const float z = e < 4 ? z0[e & 3] : z1[e & 3]; v[e] = y * z; ss += v[e] * v[e]; }
          const float rs = rsqrtf(wave_sum(ss) * (1.0f / 512.0f) + EPS);
          u32x4 o; o.x = cvt_pk_bf16(v[0] * rs, v[1] * rs); o.y = cvt_pk_bf16(v[2] * rs, v[3] * rs); o.z = cvt_pk_bf16(v[4] * rs, v[5] * rs); o.w = cvt_pk_bf16(v[6] * rs, v[7] * rs);
          *(u32x4*)(CAT + (size_t)row * DM + DRNN + ch) = o; } }
    for (int u = blockIdx.x; u < NCH * NG; u += F.G) p5_unit(F, u & 3, u >> 2);
}

constexpr int G3_BUSY = ((M / 256) * (2 * DFF / 256)) % 256;
static_assert(G3_BUSY > 0 && G3_BUSY < 256, "up GEMM tail");
constexpr int REM_FIRST = 512, REM_N = 32;
__device__ __forceinline__ void rem_table(Frame& F, LAS signed char* rem) {
    for (int i = F.tid; i < (M / 256) * 16; i += 512) rem[i] = -1;
    __syncthreads();
    if (F.G == 256 && F.tid < REM_N) { pg8::StaticOrder S; S.init(M, DM, F.G, 0); pg8::Unit u; S.tile_of(REM_FIRST + F.tid, u); rem[u.pm * 16 + u.pn] = (signed char)F.tid; }
    __syncthreads();
}
__device__ __forceinline__ void p7_row_load(const bf16_t* X1, int row, int lane, u32x2 (&w)[16]) {
#pragma unroll
    for (int j = 0; j < 16; ++j) w[j] = *(const u32x2*)(X1 + (size_t)row * DM + 256 * j + 4 * lane);
}
__device__ __forceinline__ void p7_row_finish(Frame& F, const LAS signed char* rem, int row, const u32x2 (&w)[16]) {
    const bf16_t* PART = WSP(bf16_t, WS_PART); bf16_t* X1 = WSP(bf16_t, WS_X1); unsigned char* X1Q = WSP(unsigned char, WS_X1B); float* RF3 = WSP(float, WS_RF3);
    bf16_t* xr = X1 + (size_t)row * DM; const float* xin = (row < MP ? F.in[0] + (size_t)row * DM : F.in[1] + (size_t)(row - MP) * DM);
    f32x4 v[16]; float ss = 0.f, mx = 0.f;
#pragma unroll
    for (int j = 0; j < 16; ++j) { const int c = 256 * j + 4 * F.lane; const int tl = rem[(row >> 8) * 16 + j];
        if (tl < 0) v[j] = (f32x4){bf_lo(w[j].x), bf_hi(w[j].x), bf_lo(w[j].y), bf_hi(w[j].y)};
        else { f32x4 a = *(const f32x4*)(xin + c);
#pragma unroll
            for (int ks = 0; ks < 8; ++ks) a += ld_bf4(PART + ((size_t)(tl * 8 + ks) << 16) + (row & 255) * 256 + 4 * F.lane);
            u32x2 q; q.x = cvt_pk_bf16(a[0], a[1]); q.y = cvt_pk_bf16(a[2], a[3]); *(u32x2*)(xr + c) = q;
            v[j] = (f32x4){bf_lo(q.x), bf_hi(q.x), bf_lo(q.y), bf_hi(q.y)}; }
        ss += (v[j][0] * v[j][0] + v[j][1] * v[j][1]) + (v[j][2] * v[j][2] + v[j][3] * v[j][3]);
        mx = fmaxf(mx, fmaxf(fmaxf(fabsf(v[j][0]), fabsf(v[j][1])), fmaxf(fabsf(v[j][2]), fabsf(v[j][3])))); }
    ss = wave_sum(ss);
#pragma unroll
    for (int o = 1; o < 64; o <<= 1) mx = fmaxf(mx, __shfl_xor(mx, o));
    mx = fmaxf(mx, 1e-30f);
    if (F.lane == 0) RF3[row] = rsqrtf(ss * (1.0f / DM) + EPS) * mx * (1.0f / 127.0f);
    const float inv = 127.0f / mx;
#pragma unroll
    for (int j = 0; j < 16; ++j) *(unsigned*)(X1Q + (size_t)row * DM + 256 * j + 4 * F.lane) = q8_pack4(v[j][0], v[j][1], v[j][2], v[j][3], inv);
}
__device__ __forceinline__ void p7_x1_rows(Frame& F) {
    LAS signed char* rem = (LAS signed char*)F.lds; rem_table(F, rem);
    const bf16_t* X1 = WSP(bf16_t, WS_X1);
    const int gw = F.wave * F.G + blockIdx.x, NGW = F.G * 8;
    if (gw >= M) return;
    const int rlast = gw + ((M - 1 - gw) / NGW) * NGW;
    u32x2 wa[16], wb[16];
    p7_row_load(X1, gw, F.lane, wa);
#pragma unroll 1
    for (int row = gw; row <= rlast; row += 2 * NGW) {
        const int r1 = row + NGW < rlast ? row + NGW : rlast, r2 = row + 2 * NGW < rlast ? row + 2 * NGW : rlast;
        p7_row_load(X1, r1, F.lane, wb); FULL_FENCE();
        p7_row_finish(F, rem, row, wa); FULL_FENCE();
        if (row + NGW <= rlast) { p7_row_load(X1, r2, F.lane, wa); FULL_FENCE(); p7_row_finish(F, rem, r1, wb); FULL_FENCE(); }
    }
}
__device__ __forceinline__ void pf_row_finish(Frame& F, const LAS signed char* rem, int row, const u32x2 (&w)[16], const f32x4 (&gfv)[16]) {
    const bf16_t* PART = WSP(bf16_t, WS_PART); const bf16_t* X1 = WSP(bf16_t, WS_X1);
    float* o = F.out + (size_t)row * DM; f32x4 v[16]; float ss = 0.f;
#pragma unroll
    for (int j = 0; j < 16; ++j) { const int c = 256 * j + 4 * F.lane; const int tl = rem[(row >> 8) * 16 + j];
        if (tl < 0) v[j] = (f32x4){bf_lo(w[j].x), bf_hi(w[j].x), bf_lo(w[j].y), bf_hi(w[j].y)};
        else { f32x4 a = ld_bf4(X1 + (size_t)row * DM + c);
#pragma unroll
            for (int ks = 0; ks < 8; ++ks) a += ld_bf4(PART + ((size_t)(tl * 8 + ks) << 16) + (row & 255) * 256 + 4 * F.lane);
            v[j] = a; }
        ss += (v[j][0] * v[j][0] + v[j][1] * v[j][1]) + (v[j][2] * v[j][2] + v[j][3] * v[j][3]); }
    const float rs = rsqrtf(wave_sum(ss) * (1.0f / DM) + EPS);
#pragma unroll
    for (int j = 0; j < 16; ++j) *(f32x4*)(o + 256 * j + 4 * F.lane) = v[j] * rs * gfv[j];
}
__device__ __forceinline__ void p_final(Frame& F) {
    LAS signed char* rem = (LAS signed char*)F.lds; rem_table(F, rem);
    const bf16_t* X2B = WSP(bf16_t, WS_X2B); const float* gf = F.in[29];
    const int gw = F.wave * F.G + blockIdx.x, NGW = F.G * 8;
    if (gw >= M) return;
    f32x4 gfv[16];
#pragma unroll
    for (int j = 0; j < 16; ++j) gfv[j] = *(const f32x4*)(gf + 256 * j + 4 * F.lane);
    const int rlast = gw + ((M - 1 - gw) / NGW) * NGW;
    u32x2 wa[16], wb[16];
    p7_row_load(X2B, gw, F.lane, wa);
#pragma unroll 1
    for (int row = gw; row <= rlast; row += 2 * NGW) {
        const int r1 = row + NGW < rlast ? row + NGW : rlast, r2 = row + 2 * NGW < rlast ? row + 2 * NGW : rlast;
        p7_row_load(X2B, r1, F.lane, wb); FULL_FENCE();
        pf_row_finish(F, rem, row, wa, gfv); FULL_FENCE();
        if (row + NGW <= rlast) { p7_row_load(X2B, r2, F.lane, wa); FULL_FENCE(); pf_row_finish(F, rem, r1, wb, gfv); FULL_FENCE(); }
    }
}

constexpr int NPH = 12;
__global__ void __launch_bounds__(512, 2) mk_fwd(Args args) {
    extern __shared__ __attribute__((aligned(16))) unsigned char lds_raw[];
    Frame F;
    F.lds = (LAS unsigned char*)lds_raw; F.tid = threadIdx.x; F.lane = F.tid & 63; F.wave = __builtin_amdgcn_readfirstlane(F.tid >> 6); F.G = gridDim.x;
#pragma unroll
    for (int i = 0; i < 30; ++i) F.in[i] = args.in[i];
    F.out = args.out; F.ws = args.ws;
    volatile LAS unsigned* MISC = (volatile LAS unsigned*)(F.lds + LDSCTL_OFF);
    if (F.tid < 64) MISC[F.tid] = 0u;
    __syncthreads();
    unsigned* ctl = (unsigned*)(F.ws + WS_CTL);
    XcdBarrier bar = xcd_barrier_post(ctl + CW_BAR + args.li * XCD_BAR_WORDS, MISC + 8);
    const int lo = args.ph_lo, hi = args.ph_hi;
#ifndef PH_MASK
#define PH_MASK 0xfff
#endif
#define IN(k) (((PH_MASK >> (k)) & 1) && lo <= (k) && (k) < hi)
#define SEAM(k) do { if (IN(k) && IN((k) + 1)) xcd_barrier(bar); } while (0)

    if (IN(0)) { p0_prologue(F); } SEAM(0);
    if (IN(1)) {
        const bool roles = (F.G == 256);
        const int x = (int)blockIdx.x & 7, j = (int)blockIdx.x >> 3; const bool is_gemm = !roles || j < G1_PER + (x < G1_HI ? 1 : 0);
        if (!is_gemm) { const int sidx = (j == G1_PER) ? x - G1_HI : (8 - G1_HI) + (j - G1_PER - 1) * 8 + x; p0_late_weights(F, sidx * 8 + F.wave, NSTREAM * 8); }
        else { pg8::Gemm g{WSP(bf16_t, WS_XB), WSP(bf16_t, WS_BT1), M, N1P, DM, DM, DM}; pg8::StaticOrder S0; S0.init(M, N1P, roles ? NGEMM1 : F.G, (int)blockIdx.x);
            pg8::ChunkOrder S{S0, roles ? G1_PER : ((F.G & 7) == 0 ? F.G >> 3 : 0), roles ? G1_HI : 0};
            EpiProjConv E{F.ws, F.out, F.in[9], F.in[10], F.in[17], F.in[18], F.in[19], F.in[3], F.in[5], (LAS float*)(F.lds + RING_BYTES)};
            pg8::gemm_phase<EpiProjConv, pg8::GeomPlain, pg8::ChunkOrder, true>(F.lds, g, S, E); } } SEAM(1);
    if (IN(3)) {
#ifndef P3_REP
#define P3_REP 0
#endif
        { pg8::Gemm g{WSP(bf16_t, WS_XCB), WSP(bf16_t, WS_BTG), M, 16 * 256, 256, DRNN, 256}; pg8::StaticOrder S; S.init(M, 16 * 256, F.G, (int)blockIdx.x);
          EpiGates E{WSP(unsigned, WS_AB), WSP(bf16_t, WS_XCB), F.in[12], F.in[14], WSP(float, WS_SP8)};
          pg8::gemm_phase<EpiGates, pg8::GeomGates, pg8::StaticOrder, true>(F.lds, g, S, E);
          if (P3_REP == 1) { pg8::gemm_phase<EpiGates, pg8::GeomGates, pg8::StaticOrder, true>(F.lds, g, S, E); pg8::gemm_phase<EpiGates, pg8::GeomGates, pg8::StaticOrder, true>(F.lds, g, S, E); pg8::gemm_phase<EpiGates, pg8::GeomGates, pg8::StaticOrder, true>(F.lds, g, S, E); }
        }
        ssd_intra_all(F);
        if (P3_REP == 2) { ssd_intra_all(F); ssd_intra_all(F); ssd_intra_all(F); }
        ssd_sample_all(F);
        if (P3_REP == 3) { ssd_sample_all(F); ssd_sample_all(F); ssd_sample_all(F); }
    } SEAM(3);
    if (IN(4)) { p4_scan(F); } SEAM(4);
    if (IN(5)) {
        rotq_rows_i8<2>(WSP(bf16_t, WS_BT2), WSP(unsigned char, WS_BT2Q), WSP(float, WS_SW2), DM, F.wave * F.G + (int)blockIdx.x, F.G * 8, F.lane);
        p5_norms(F, false);
        xcd_barrier(bar);
        rotq_rows_i8<2, true>(WSP(bf16_t, WS_CAT), WSP(unsigned char, WS_CATQ), WSP(float, WS_SA2), M, F.wave * F.G + (int)blockIdx.x, F.G * 8, F.lane, WSP(float, WS_SSQRG)); } SEAM(5);
    if (IN(6)) { pg8::Gemm g{WSP(bf16_t, WS_CATQ), WSP(bf16_t, WS_BT2Q), M, DM, DM / 2, DM / 2, DM / 2}; pg8::StaticOrder S; S.init(M, DM, F.G, (int)blockIdx.x);
        const bool split = (F.G == 256); if (split) S.limit = REM_FIRST;
        EpiX1Q E{F.in[0], F.in[1], WSP(bf16_t, WS_X1), WSP(float, WS_SA2), WSP(float, WS_SW2)};
        pg8::gemm_phase<EpiX1Q, pg8::GeomPlain, pg8::StaticOrder, true, true>(F.lds, g, S, E);
        if (split) { pg8::Gemm g2{WSP(bf16_t, WS_CATQ), WSP(bf16_t, WS_BT2Q), M, DM, DM / 16, DM / 2, DM / 2}; pg8::SplitOrder S2{S, REM_FIRST, REM_N, (int)blockIdx.x}; EpiPartQ E2{WSP(bf16_t, WS_PART), WSP(float, WS_SA2), WSP(float, WS_SW2)};
            pg8::gemm_phase<EpiPartQ, pg8::GeomSplit, pg8::SplitOrder, true, true>(F.lds, g2, S2, E2); } } SEAM(6);
    if (IN(7)) { p7_x1_rows(F);
        quant_rows_i8(WSP(bf16_t, WS_BT3), WSP(unsigned char, WS_BT3Q), ctl + CW_CMAX3, 2 * DFF, DM, (size_t)blockIdx.x * 512 + F.tid, (size_t)F.G * 512);
        if (F.G != 256) rotq_rows_i8(WSP(bf16_t, WS_BT4), WSP(unsigned char, WS_BT4Q), WSP(float, WS_SW4), DM, blockIdx.x * 8 + F.wave, F.G * 8, F.lane); } SEAM(7);
    if (IN(8)) { pg8::Gemm g{WSP(bf16_t, WS_X1B), WSP(bf16_t, WS_BT3Q), M, 2 * DFF, DM / 2, DM / 2, DM / 2}; pg8::StaticOrder S; S.init(M, 2 * DFF, F.G, (int)blockIdx.x);
        EpiUpConv E{WSP(bf16_t, WS_ACT), WSP(float, WS_RF3), ctl + CW_CMAX3, F.out, F.in[26], F.in[27], F.in[6], (LAS float*)(F.lds + RING_BYTES), WSP(unsigned long long, WS_HALO), ctl + CW_HFLAG, ctl + CW_TMO};
        pg8::gemm_phase<EpiUpConv, pg8::GeomPlain, pg8::StaticOrder, true, true>(F.lds, g, S, E);
        if (F.G == 256 && blockIdx.x >= G3_BUSY) rotq_rows_i8(WSP(bf16_t, WS_BT4), WSP(unsigned char, WS_BT4Q), WSP(float, WS_SW4), DM, ((int)blockIdx.x - G3_BUSY) * 8 + F.wave, (256 - G3_BUSY) * 8, F.lane); } SEAM(8);
    if (IN(9)) { rotq_rows_i8(WSP(bf16_t, WS_ACT), WSP(unsigned char, WS_ACTQ), WSP(float, WS_SA4), M, F.wave * F.G + (int)blockIdx.x, F.G * 8, F.lane); } SEAM(9);
    if (IN(10)) { pg8::Gemm g{WSP(bf16_t, WS_ACTQ), WSP(bf16_t, WS_BT4Q), M, DM, DFF / 2, DFF / 2, DFF / 2}; pg8::StaticOrder S; S.init(M, DM, F.G, (int)blockIdx.x);
        const bool split = (F.G == 256); if (split) S.limit = REM_FIRST;
        EpiX2 E{WSP(bf16_t, WS_X1), WSP(bf16_t, WS_X2B), WSP(float, WS_SA4), WSP(float, WS_SW4)};
        pg8::gemm_phase<EpiX2, pg8::GeomPlain, pg8::StaticOrder, true, true>(F.lds, g, S, E);
        if (split) { pg8::Gemm g2{WSP(bf16_t, WS_ACTQ), WSP(bf16_t, WS_BT4Q), M, DM, DFF / 16, DFF / 2, DFF / 2}; pg8::SplitOrder S2{S, REM_FIRST, REM_N, (int)blockIdx.x}; EpiPartQ E2{WSP(bf16_t, WS_PART), WSP(float, WS_SA4), WSP(float, WS_SW4)};
            pg8::gemm_phase<EpiPartQ, pg8::GeomSplit, pg8::SplitOrder, true, true>(F.lds, g2, S2, E2); } } SEAM(10);
    if (IN(11)) { p_final(F); }
#undef IN
#undef SEAM
}

extern "C" void kernel_launch(void* const* d_in, const int* in_sizes, int n_in, void* d_out, int out_size, void* d_ws, size_t ws_size, hipStream_t stream) {
    static int grid = 0;
    if (grid == 0) {
        if (n_in != 30 || (size_t)out_size != O_END || ws_size < WS_END) { fprintf(stderr, "kernel_launch: unexpected shapes (n_in %d out %d ws %zu need %zu)\n", n_in, out_size, ws_size, (size_t)WS_END); grid = -1; return; }
        int dev = 0, cus = 0, per_cu = 0;
        if (hipGetDevice(&dev) != hipSuccess || hipDeviceGetAttribute(&cus, hipDeviceAttributeMultiprocessorCount, dev) != hipSuccess) { grid = -1; return; }
        if (hipFuncSetAttribute((const void*)mk_fwd, hipFuncAttributeMaxDynamicSharedMemorySize, LDS_BYTES) != hipSuccess) { fprintf(stderr, "kernel_launch: hipFuncSetAttribute failed\n"); grid = -1; return; }
        if (hipOccupancyMaxActiveBlocksPerMultiprocessor(&per_cu, (const void*)mk_fwd, 512, LDS_BYTES) != hipSuccess || per_cu < 1) { fprintf(stderr, "kernel_launch: occupancy query says %d\n", per_cu); }
        (void)hipGetLastError();
        grid = cus;
    }
    if (grid < 0) return;
    (void)hipMemsetAsync((char*)d_ws + WS_CTL, 0, CTL_BYTES, stream);
    Args a{};
    for (int i = 0; i < 30; ++i) a.in[i] = (const float*)d_in[i];
    a.out = (float*)d_out; a.ws = (unsigned char*)d_ws;
#if PROBE_HI > PROBE_LO
    { const int cuts[5][3] = {{0, PROBE_HI, 0}, {PROBE_LO, PROBE_HI, 1}, {PROBE_LO, PROBE_HI, 1}, {PROBE_LO, PROBE_HI, 1}, {PROBE_HI, NPH, 0}};
      for (int li = 0; li < 5; ++li) { if (cuts[li][0] >= cuts[li][1]) continue; a.ph_lo = cuts[li][0]; a.ph_hi = cuts[li][1]; a.li = li; a.rep = cuts[li][2];
          hipLaunchKernelGGL(mk_fwd, dim3(grid), dim3(512), LDS_BYTES, stream, a); } }
#else
    a.ph_lo = 0; a.ph_hi = NPH; a.li = 0; a.rep = 0;
    hipLaunchKernelGGL(mk_fwd, dim3(grid), dim3(512), LDS_BYTES, stream, a);
#endif
}
```

```cpp
#include <hip/hip_runtime.h>
#include <cstdio>
#include <cstdint>
#include <cstddef>

#ifndef PROBE_LO
#define PROBE_LO 0
#define PROBE_HI 0
#endif

#define LAS __attribute__((address_space(3)))
#define GAS __attribute__((address_space(1)))
typedef unsigned short bf16_t;
typedef short bf16x8 __attribute__((ext_vector_type(8)));
typedef float f32x4 __attribute__((ext_vector_type(4)));
typedef float f32x2 __attribute__((ext_vector_type(2)));
typedef unsigned u32x4 __attribute__((ext_vector_type(4)));
typedef unsigned u32x2 __attribute__((ext_vector_type(2)));
typedef int i32x4 __attribute__((ext_vector_type(4)));

constexpr int DM = 4096, SEQ = 2048, NB = 4, MP = NB * SEQ, NSQ = 128, DSEQ = 4, MS = NSQ * DSEQ, M = MP + MS;
constexpr int DRNN = 2048, DSSM = 2048, NH = 32, HP = 64, NG = 4, NST = 128, DXBC = 3072, DFF = 12288, INC = 9248;
constexpr int N1P = 9472;
constexpr int C_RGX = 0, C_RGG = 2048, C_Z = 4096, C_XBC = 6144, C_DT = 9216;
constexpr float EPS = 1e-6f;
constexpr int NCH = MP / 128;

constexpr size_t O_Y = 0;
constexpr size_t O_PRGH = (size_t)M * DM;
constexpr size_t O_PRGC = O_PRGH + (size_t)NB * DRNN;
constexpr size_t O_PSH = O_PRGC + (size_t)NB * 3 * DRNN;
constexpr size_t O_PSC = O_PSH + (size_t)NB * NH * HP * NST;
constexpr size_t O_PFC = O_PSC + (size_t)NB * 3 * DXBC;
constexpr size_t O_SRGH = O_PFC + (size_t)NB * 2 * DFF;
constexpr size_t O_SRGC = O_SRGH + (size_t)NSQ * DRNN;
constexpr size_t O_SSH = O_SRGC + (size_t)NSQ * 3 * DRNN;
constexpr size_t O_SSC = O_SSH + (size_t)NSQ * NH * HP * NST;
constexpr size_t O_SFC = O_SSC + (size_t)NSQ * 3 * DXBC;
constexpr size_t O_END = O_SFC + (size_t)NSQ * 2 * DFF;

constexpr size_t al256(size_t x) { return (x + 255) & ~(size_t)255; }
constexpr size_t WS_CTL = 0, CTL_BYTES = 1u << 20;
constexpr size_t WS_BT1 = WS_CTL + CTL_BYTES;
constexpr size_t WS_BT2 = WS_BT1 + al256((size_t)N1P * DM * 2);
constexpr size_t WS_BT3 = WS_BT2 + al256((size_t)DM * DM * 2);
constexpr size_t WS_BT4 = WS_BT3 + al256((size_t)2 * DFF * DM * 2);
constexpr size_t WS_BTG = WS_BT4 + al256((size_t)DM * DFF * 2);
constexpr size_t WS_SP8 = WS_BTG + al256((size_t)16 * 256 * 256 * 2);
constexpr size_t WS_RS1 = WS_SP8 + al256((size_t)DRNN * 4);
constexpr size_t WS_HALO = WS_RS1 + al256((size_t)M * 4);
constexpr size_t WS_RF3 = WS_HALO + al256((size_t)34 * 96 * 2 * 128 * 4);
constexpr size_t WS_DTR = WS_RF3 + al256((size_t)M * 4);
constexpr size_t WS_SA4 = WS_DTR + al256((size_t)M * NH * 4);
constexpr size_t WS_SW4 = WS_SA4 + al256((size_t)M * 4);
constexpr size_t WS_HALO1 = WS_SW4 + al256((size_t)DM * 4);
constexpr size_t WS_CAT = WS_HALO1 + al256((size_t)34 * 37 * 3 * 256 * 4);
constexpr size_t WS_X1 = WS_CAT + al256((size_t)M * DM * 2);
constexpr size_t WS_X2B = WS_X1 + al256((size_t)M * DM * 2);
constexpr size_t WS_X1B = WS_X1 + al256((size_t)M * DM * 4);
constexpr size_t WS_OV = WS_X1B + al256((size_t)M * DM * 2);
constexpr size_t WS_XB = WS_OV;
constexpr size_t WS_PROJ = WS_XB + al256((size_t)M * DM * 2);
constexpr size_t WS_G2 = WS_PROJ;
constexpr size_t WS_XCB = WS_PROJ + al256((size_t)M * INC * 2);
constexpr size_t WS_AB = WS_XCB + al256((size_t)M * DRNN * 2);
constexpr size_t WS_XS = WS_AB + al256((size_t)M * DRNN * 8);
constexpr size_t WS_BC = WS_XS + al256((size_t)M * DSSM * 2);
constexpr size_t WS_XST = WS_BC + al256((size_t)M * 1024 * 2);
constexpr size_t WS_BTT = WS_XST + al256((size_t)NCH * 2048 * 128 * 2);
constexpr size_t WS_DTA = WS_BTT + al256((size_t)NCH * 512 * 128 * 2);
constexpr size_t WS_CUM = WS_DTA + al256((size_t)M * NH * 4);
constexpr size_t WS_YD = WS_CUM + al256((size_t)M * NH * 4);
constexpr size_t WS_ST = WS_YD + al256((size_t)M * DSSM * 4);
constexpr size_t WS_DEC = WS_ST + al256((size_t)NCH * NH * HP * NST * 4);
constexpr size_t WS_HPB = WS_DEC + al256((size_t)NCH * NH * 4);
constexpr size_t WS_SSQRG = WS_HPB + al256((size_t)NCH * NH * HP * NST * 2);
constexpr size_t WS_ENDA = WS_SSQRG + al256((size_t)M * 64 * 4);
constexpr size_t WS_PART = WS_OV;
constexpr size_t WS_GATE = WS_OV;
constexpr size_t WS_VAL = WS_GATE + al256((size_t)M * DFF * 2);
constexpr size_t WS_ACT = WS_VAL + al256((size_t)M * DFF * 2);
constexpr size_t WS_BT3Q = WS_VAL;
constexpr size_t WS_ACTQ = WS_ACT + al256((size_t)M * DFF * 2);
constexpr size_t WS_BT4Q = WS_ACTQ + al256((size_t)M * DFF);
constexpr size_t WS_ENDB = WS_BT4Q + al256((size_t)DM * DFF);
constexpr size_t WS_END0 = WS_ENDA > WS_ENDB ? WS_ENDA : WS_ENDB;
constexpr size_t WS_CATQ = WS_X1B + al256((size_t)M * DM);
constexpr size_t WS_BT2Q = WS_END0;
constexpr size_t WS_SA2 = WS_BT2Q + al256((size_t)DM * DM);
constexpr size_t WS_SW2 = WS_SA2 + al256((size_t)M * 4);
constexpr size_t WS_END = WS_SW2 + al256((size_t)DM * 4);
static_assert(WS_END <= (size_t)1536 * 1024 * 1024, "d_ws map exceeds the guaranteed 1536 MiB");
constexpr int CW_BAR = 1024;
constexpr int CW_SSQ1 = 20480;
constexpr int CW_SSQ2 = CW_SSQ1 + M + 64;
constexpr int CW_HFLAG = CW_SSQ2 + M + 64;
constexpr int CW_HFLAG1 = CW_HFLAG + 34 * 96 + 64;
constexpr int CW_CMAX3 = CW_HFLAG1 + 34 * 37 + 64;
constexpr int CW_CMAX4 = CW_CMAX3 + 2 * DFF;
constexpr int CW_RMAX4 = CW_CMAX4 + DM;
constexpr int CW_DUMMY = CW_RMAX4 + M + 64;
constexpr int CW_TMO = 16;
static_assert((size_t)(CW_DUMMY + M) * 4 <= CTL_BYTES && CW_BAR + 5 * 3456 <= CW_SSQ1, "ctl");
static_assert(((34 * 96) / 8) % 8 == 0 && (34 * 96) % 8 == 0, "up-GEMM unit order: every XCD chunk must start on a sequence-start row panel");

constexpr int RING_BYTES = 131072, LDS_BYTES = 163840, LDSCTL_OFF = LDS_BYTES - 256;

__device__ __forceinline__ unsigned cvt_pk_bf16(float lo, float hi) { unsigned r; asm("v_cvt_pk_bf16_f32 %0, %1, %2" : "=v"(r) : "v"(lo), "v"(hi)); return r; }
__device__ __forceinline__ float bf_lo(unsigned w) { return __uint_as_float(w << 16); }
__device__ __forceinline__ float bf_hi(unsigned w) { return __uint_as_float(w & 0xffff0000u); }
__device__ __forceinline__ float bf2f(bf16_t b) { return __uint_as_float(((unsigned)b) << 16); }
__device__ __forceinline__ f32x4 ld_bf4(const bf16_t* p) { const u32x2 w = *(const u32x2*)p; return (f32x4){bf_lo(w.x), bf_hi(w.x), bf_lo(w.y), bf_hi(w.y)}; }
__device__ __forceinline__ float frcp(float x) { return __builtin_amdgcn_rcpf(x); }
__device__ __forceinline__ float sigmoidf_(float x) { return frcp(1.0f + __expf(-x)); }
__device__ __forceinline__ float siluf_(float x) { return x * sigmoidf_(x); }
__device__ __forceinline__ float gelu_tanh(float x) { const float u = 0.7978845608028654f * (x + 0.044715f * x * x * x); return x * sigmoidf_(2.0f * u); }
__device__ __forceinline__ float softplusf_(float x) { return fmaxf(x, 0.0f) + log1pf(__expf(-fabsf(x))); }
__device__ __forceinline__ float neg_expm1_small(float x, float ehalf  ) {
    const float p = x * (1.0f + x * (0.5f + x * (0.16666667f + x * (0.041666668f + x * (0.008333334f + x * (0.0013888889f + x * 0.0001984127f))))));
    return x > -0.5f ? -p : 1.0f - ehalf * ehalf;
}
__device__ __forceinline__ float wave_sum(float v) {
#pragma unroll
    for (int o = 1; o < 64; o <<= 1) v += __shfl_xor(v, o);
    return v;
}
__device__ __forceinline__ unsigned q8_pack4(float a, float b, float c, float d, float inv) {
    const unsigned ua = __float_as_uint(fmaf(a, inv, 12582912.0f)), ub = __float_as_uint(fmaf(b, inv, 12582912.0f)), uc = __float_as_uint(fmaf(c, inv, 12582912.0f)), ud = __float_as_uint(fmaf(d, inv, 12582912.0f));
    return (ua & 255u) | ((ub & 255u) << 8) | ((uc & 255u) << 16) | (ud << 24);
}
__device__ __forceinline__ u32x4 q8_pack16(const u32x4 lo, const u32x4 hi, float inv) {
    u32x4 o; o.x = q8_pack4(bf_lo(lo.x), bf_hi(lo.x), bf_lo(lo.y), bf_hi(lo.y), inv); o.y = q8_pack4(bf_lo(lo.z), bf_hi(lo.z), bf_lo(lo.w), bf_hi(lo.w), inv);
    o.z = q8_pack4(bf_lo(hi.x), bf_hi(hi.x), bf_lo(hi.y), bf_hi(hi.y), inv); o.w = q8_pack4(bf_lo(hi.z), bf_hi(hi.z), bf_lo(hi.w), bf_hi(hi.w), inv); return o;
}
__device__ __forceinline__ void quant_rows_i8(const bf16_t* src, unsigned char* dst, const unsigned* rmax, int R, int C, size_t gt, size_t NT) {
    const size_t per = (size_t)C / 8, tot = (size_t)R * per;
    for (size_t it0 = gt; it0 < tot; it0 += 8 * NT) { u32x4 w[8]; float inv[8];
#pragma unroll
        for (int k = 0; k < 8; ++k) { const size_t it = it0 + k * NT; if (it < tot) { w[k] = __builtin_nontemporal_load((const u32x4*)(src + it * 8));
                inv[k] = 127.0f / fmaxf(__uint_as_float(rmax[(int)(it / per)]) * 1.004f, 1e-30f); } }
#pragma unroll
        for (int k = 0; k < 8; ++k) { const size_t it = it0 + k * NT; if (it < tot) { u32x2 o; o.x = q8_pack4(bf_lo(w[k].x), bf_hi(w[k].x), bf_lo(w[k].y), bf_hi(w[k].y), inv[k]); o.y = q8_pack4(bf_lo(w[k].z), bf_hi(w[k].z), bf_lo(w[k].w), bf_hi(w[k].w), inv[k]);
                *(u32x2*)(dst + it * 8) = o; } } }
}
__device__ __forceinline__ void fwht32(float (&x)[32]) {
    f32x2 v[16];
#pragma unroll
    for (int i = 0; i < 16; ++i) v[i] = (f32x2){x[2 * i] + x[2 * i + 1], x[2 * i] - x[2 * i + 1]};
#pragma unroll
    for (int h = 1; h < 16; h <<= 1) {
#pragma unroll
        for (int i = 0; i < 16; ++i) if ((i & h) == 0) { const f32x2 a = v[i], b = v[i + h]; v[i] = a + b; v[i + h] = a - b; } }
#pragma unroll
    for (int i = 0; i < 16; ++i) { x[2 * i] = v[i][0]; x[2 * i + 1] = v[i][1]; }
}
template <int NC = 6, bool RGN = false>
__device__ __forceinline__ void rotq_rows_i8(const bf16_t* src, unsigned char* dst, float* scale, int R, int gw, int NGW, int lane, const float* ssq = nullptr) {
    constexpr int RL = 2048 * NC;
    for (int r = gw; r < R; r += NGW) { const bf16_t* sr = src + (size_t)r * RL; u32x4 pk[NC][4]; float mx = 0.f;
        float sq = 0.f; if constexpr (RGN) sq = ssq[(size_t)r * 64 + lane];
#pragma unroll
        for (int i = 0; i < NC; ++i)
#pragma unroll
            for (int q = 0; q < 4; ++q) pk[i][q] = __builtin_nontemporal_load((const u32x4*)(sr + 2048 * i + 8 * (lane + 64 * q)));
#pragma unroll
        for (int i = 0; i < NC; ++i) { float x[32];
#pragma unroll
            for (int q = 0; q < 4; ++q) { const u32x4 w = pk[i][q]; x[8 * q] = bf_lo(w.x); x[8 * q + 1] = bf_hi(w.x); x[8 * q + 2] = bf_lo(w.y); x[8 * q + 3] = bf_hi(w.y); x[8 * q + 4] = bf_lo(w.z); x[8 * q + 5] = bf_hi(w.z); x[8 * q + 6] = bf_lo(w.w); x[8 * q + 7] = bf_hi(w.w); }
            fwht32(x);
            if constexpr (RGN) { if (i == 0) { const float rs = rsqrtf(wave_sum(sq) * (1.0f / DRNN) + EPS);
#pragma unroll
                    for (int e = 0; e < 32; ++e) x[e] *= rs; } }
#pragma unroll
            for (int q = 0; q < 4; ++q) { pk[i][q].x = cvt_pk_bf16(x[8 * q], x[8 * q + 1]); pk[i][q].y = cvt_pk_bf16(x[8 * q + 2], x[8 * q + 3]); pk[i][q].z = cvt_pk_bf16(x[8 * q + 4], x[8 * q + 5]); pk[i][q].w = cvt_pk_bf16(x[8 * q + 6], x[8 * q + 7]); }
#pragma unroll
            for (int e = 0; e < 32; ++e) mx = fmaxf(mx, fabsf(x[e])); }
#pragma unroll
        for (int o = 1; o < 64; o <<= 1) mx = fmaxf(mx, __shfl_xor(mx, o));
        mx = fmaxf(mx * 1.004f, 1e-30f);
        if (lane == 0) scale[r] = mx * (0.17677669529663687f / 127.0f);
        const float inv = 127.0f / mx;
#pragma unroll
        for (int i = 0; i < NC; ++i) { unsigned char* d = dst + (size_t)r * RL + 2048 * i + 8 * lane;
#pragma unroll
            for (int q = 0; q < 4; ++q) { const u32x4 w = pk[i][q]; u32x2 o; o.x = q8_pack4(bf_lo(w.x), bf_hi(w.x), bf_lo(w.y), bf_hi(w.y), inv); o.y = q8_pack4(bf_lo(w.z), bf_hi(w.z), bf_lo(w.w), bf_hi(w.w), inv);
                *(u32x2*)(d + 512 * q) = o; } } }
}
#define FULL_FENCE() do { asm volatile("" ::: "memory"); __builtin_amdgcn_sched_barrier(0); } while (0)
#define LDS_BARRIER() do { asm volatile("s_waitcnt lgkmcnt(0)" ::: "memory"); __builtin_amdgcn_s_barrier(); asm volatile("" ::: "memory"); } while (0)
#define LDS_WAIT() asm volatile("s_waitcnt lgkmcnt(0)" ::: "memory")
#define VM_WAIT() asm volatile("s_waitcnt vmcnt(0)" ::: "memory")

#define XB_TMO      128
#define XB_XCNT(j)  (256  + 64 * (j))
#define XB_XSUB(j)  (1280 + 64 * (j))
#define XB_XGEN(j)  (2304 + 64 * (j))
#define XB_TOP      3328
#define XB_TOPGEN   3392
#define XCD_BAR_WORDS 3456
#define XB_SPIN_CAP (1u << 18)
__device__ __forceinline__ unsigned xb_ld(unsigned* p)              { return __hip_atomic_load(p, __ATOMIC_RELAXED, __HIP_MEMORY_SCOPE_AGENT); }
__device__ __forceinline__ unsigned xb_add(unsigned* p, unsigned v) { return __hip_atomic_fetch_add(p, v, __ATOMIC_RELAXED, __HIP_MEMORY_SCOPE_AGENT); }
__device__ __forceinline__ unsigned xb_xcc_id() { return (unsigned)__builtin_amdgcn_s_getreg((3 << 11) | 20) & 0xFu; }
#define XB_SPIN(cond, bar) do { unsigned _sp = 0; while (cond) { __builtin_amdgcn_s_sleep(1); \
    if ((++_sp & 255u) == 0u) { if (xb_ld(&(bar)[XB_TMO])) break; if (_sp > XB_SPIN_CAP) { atomicAdd(&(bar)[XB_TMO], 1u); break; } } } } while (0)
struct XcdBarrier { unsigned* bar; unsigned x; volatile LAS unsigned* st; };
__device__ __forceinline__ XcdBarrier xcd_barrier_post(unsigned* bar, volatile LAS unsigned* st) {
    XcdBarrier b; b.bar = bar; b.x = xb_xcc_id(); b.st = st;
    if (threadIdx.x == 0) (void)xb_add(&bar[XB_XCNT(b.x)], 1u);
    return b;
}
__device__ __forceinline__ void xcd_barrier_complete(unsigned* bar, unsigned x, unsigned& nloc, unsigned& nx) {
    const unsigned G = gridDim.x * gridDim.y * gridDim.z;
    unsigned sum, cnt, mine, sp = 0u;
    for (;;) {
        sum = 0u; cnt = 0u; mine = 0u;
#pragma unroll
        for (unsigned j = 0; j < 16; ++j) { const unsigned c = xb_ld(&bar[XB_XCNT(j)]); sum += c; cnt += (c > 0u) ? 1u : 0u; mine = (j == x) ? c : mine; }
        if (sum == G) break;
        __builtin_amdgcn_s_sleep(1);
        if ((++sp & 255u) == 0u) { if (xb_ld(&bar[XB_TMO])) break; if (sp > XB_SPIN_CAP) { atomicAdd(&bar[XB_TMO], 1u); break; } }
    }
    nloc = mine > 0u ? mine : 1u; nx = cnt > 0u ? cnt : 1u;
}
__device__ __forceinline__ void xcd_barrier(const XcdBarrier& b) {
    asm volatile("s_waitcnt vmcnt(0)" ::: "memory");
    __syncthreads();
    if (threadIdx.x == 0) {
        unsigned* bar = b.bar;
        __builtin_amdgcn_s_waitcnt(0);
        unsigned nloc = b.st[0], nx = b.st[1];
        if (nloc == 0u) { xcd_barrier_complete(bar, b.x, nloc, nx); b.st[0] = nloc; b.st[1] = nx; }
        const unsigned old = xb_add(&bar[XB_XSUB(b.x)], 1u);
        const unsigned gen = old / nloc;
        if (old + 1u == (gen + 1u) * nloc) {
            __builtin_amdgcn_fence(__ATOMIC_RELEASE, "agent");
            asm volatile("s_waitcnt vmcnt(0)" ::: "memory");
            const unsigned og = xb_add(&bar[XB_TOP], 1u);
            const unsigned tg = og / nx;
            if (og + 1u == (tg + 1u) * nx) xb_add(&bar[XB_TOPGEN], 1u);
            else XB_SPIN(xb_ld(&bar[XB_TOPGEN]) == tg, bar);
            __builtin_amdgcn_fence(__ATOMIC_ACQUIRE, "agent");
            xb_add(&bar[XB_XGEN(b.x)], 1u);
            asm volatile("s_waitcnt vmcnt(0)" ::: "memory");
        } else {
            XB_SPIN(xb_ld(&bar[XB_XGEN(b.x)]) == gen, bar);
            __builtin_amdgcn_fence(__ATOMIC_ACQUIRE, "agent");
            asm volatile("s_waitcnt vmcnt(0)" ::: "memory");
        }
    }
    __syncthreads();
}

namespace pg8 {
constexpr int BM = 256, BK = 64, HALF = 128, HTB = HALF * BK * 2, STAGE_BYTES = 8 * HTB, NXCD = 8, WGM = 8;
__host__ __device__ __forceinline__ int lds_byte(int r, int c) { const int st = (r >> 4) * 2 + (c >> 5), rr = r & 15, cc = c & 31, ob = rr * 64 + cc * 2; return st * 1024 + (ob ^ (((ob >> 9) & 1) << 5)); }
__host__ __device__ __forceinline__ void stage_rc(int b, int& R, int& C) { const int st = b / 1024, sb = b % 1024, swz = sb ^ (((sb >> 9) & 1) << 5); R = (st >> 1) * 16 + swz / 64; C = (st & 1) * 32 + (swz % 64) / 2; }
__host__ __device__ __forceinline__ int perm32(int rho) { const int n = rho >> 4, i = rho & 15; return 8 * (i >> 2) + 4 * n + (i & 3); }
struct Unit { int pm, pn, ks, tl; };
struct Gemm { const bf16_t* A; const bf16_t* Bt; int M, N, K, lda, ldb; };
struct GeomPlain {
    static __device__ __forceinline__ size_t a_off(const Gemm& g, const Unit& u) { return (size_t)u.pm * 256 * g.lda * 2; }
    static __device__ __forceinline__ size_t b_off(const Gemm& g, const Unit& u) { return (size_t)u.pn * 256 * g.ldb * 2; }
};
struct GeomGates {
    static __device__ __forceinline__ size_t a_off(const Gemm& g, const Unit& u) { return ((size_t)u.pm * 256 * g.lda + (size_t)(u.pn >> 1) * 256) * 2; }
    static __device__ __forceinline__ size_t b_off(const Gemm& g, const Unit& u) { return (size_t)u.pn * 256 * g.ldb * 2; }
};
struct StaticOrder {
    int nM, nN, nwg, G, c, limit;
    __host__ __device__ void init(int M, int N, int G_, int c_) { nM = M / BM; nN = N / BM; nwg = nM * nN; G = G_; c = c_; limit = nwg; }
    __host__ __device__ void tile_of(int L, Unit& u) const {
        int wgid = L; { const int q = nwg / NXCD, r = nwg % NXCD, xcd = wgid % NXCD, off = wgid / NXCD; wgid = (xcd < r ? xcd * (q + 1) : r * (q + 1) + (xcd - r) * q) + off; }
        tile_of_wgid(wgid, u);
    }
    __host__ __device__ void tile_of_wgid(int wgid, Unit& u) const {
        const int nig = WGM * nN, gid = wgid / nig, fm = gid * WGM, gsz = (nM - fm) < WGM ? (nM - fm) : WGM;
        u.pm = fm + ((wgid % nig) % gsz); u.pn = (wgid % nig) / gsz; u.ks = 0; u.tl = 0;
    }
    __host__ __device__ bool next(int i, Unit& u) const { const long L = (long)i * G + c; if (L >= limit) return false; tile_of((int)L, u); return true; }
};
struct ChunkOrder {
    StaticOrder base; int per_lo, n_hi;
    __host__ __device__ bool next(int i, Unit& u) const {
        const int G = base.G, c = base.c; int wgid;
        if (per_lo > 0) { const int x = c & 7, j = c >> 3; wgid = i * G + x * per_lo + (x < n_hi ? x : n_hi) + j; } else wgid = i * G + c;
        if (wgid >= base.nwg) return false; base.tile_of_wgid(wgid, u); return true;
    }
};
struct SplitOrder {
    StaticOrder base; int first, nrem, c;
    __host__ __device__ bool next(int i, Unit& u) const { if (i > 0 || c >= nrem * 8) return false; base.tile_of(first + c % nrem, u); u.tl = c % nrem; u.ks = c / nrem; return true; }
};
struct GeomSplit {
    static __device__ __forceinline__ size_t a_off(const Gemm& g, const Unit& u) { return ((size_t)u.pm * 256 * g.lda + (size_t)u.ks * g.K) * 2; }
    static __device__ __forceinline__ size_t b_off(const Gemm& g, const Unit& u) { return ((size_t)u.pn * 256 * g.ldb + (size_t)u.ks * g.K) * 2; }
};

template <class Epi, class Geom, class Sched, bool ALIGN_EPI, bool I8 = false>
__device__ __forceinline__ void gemm_phase(LAS unsigned char* lds, const Gemm g, const Sched& S, const Epi& E) {
    const int tid = threadIdx.x, wid = __builtin_amdgcn_readfirstlane(tid >> 6), lane = tid & 63, wr = wid >> 2, wc = wid & 3, fr = lane & 15, fq = lane >> 4;
    const int K = g.K, nt = K / BK;
    unsigned voffA[2], voffB[2];
#pragma unroll
    for (int i = 0; i < 2; ++i) { int R, C; stage_rc(tid * 16 + i * 8192, R, C); const int Rb = Epi::PERM ? ((R & ~31) + perm32(R & 31)) : R;
        voffA[i] = (unsigned)(R * g.lda + C) * 2u; voffB[i] = (unsigned)(Rb * g.ldb + C) * 2u; }
    const size_t kstep = (size_t)(BK * 2);
    const size_t hsA = (size_t)HALF * g.lda * 2, hsB = (size_t)HALF * g.ldb * 2;
    const unsigned ldsw = (unsigned)wid * 1024u;
    const int aoff = lds_byte(wr * 64 + fr, fq * 8), boff = lds_byte(wc * 32 + fr, fq * 8);
#define PG8_SA(b, h) (((b) * 2 + (h)) * HTB)
#define PG8_SB(b, h) ((4 + (b) * 2 + (h)) * HTB)
#define PG8_STAGE(bufoff, gbase, voff) do { _Pragma("unroll") for (int _i = 0; _i < 2; ++_i) \
        __builtin_amdgcn_global_load_lds((const unsigned*)((const char*)(gbase) + (voff)[_i]), (LAS unsigned*)(lds + (bufoff) + ldsw + _i * 8192), 16, 0, 0); } while (0)
#define PG8_LDA(dst, b, h) do { _Pragma("unroll") for (int m = 0; m < 4; ++m) _Pragma("unroll") for (int k = 0; k < 2; ++k) dst[m][k] = *(const LAS bf16x8*)(lds + PG8_SA(b, h) + aoff + m * 2048 + k * 1024); } while (0)
#define PG8_LDB(dst, b, h) do { _Pragma("unroll") for (int n = 0; n < 2; ++n) _Pragma("unroll") for (int k = 0; k < 2; ++k) dst[n][k] = *(const LAS bf16x8*)(lds + PG8_SB(b, h) + boff + n * 2048 + k * 1024); } while (0)
#define PG8_MMA(ai, bj, At, Bt) do { __builtin_amdgcn_s_setprio(1); _Pragma("unroll") for (int m = 0; m < 4; ++m) _Pragma("unroll") for (int n = 0; n < 2; ++n) _Pragma("unroll") for (int k = 0; k < 2; ++k) { \
        if constexpr (I8) acc[ai][bj][m][n] = __builtin_bit_cast(f32x4, __builtin_amdgcn_mfma_i32_16x16x64_i8(__builtin_bit_cast(i32x4, Bt[n][k]), __builtin_bit_cast(i32x4, At[m][k]), __builtin_bit_cast(i32x4, acc[ai][bj][m][n]), 0, 0, 0)); \
        else acc[ai][bj][m][n] = __builtin_amdgcn_mfma_f32_16x16x32_bf16(Bt[n][k], At[m][k], acc[ai][bj][m][n], 0, 0, 0); } __builtin_amdgcn_s_setprio(0); } while (0)
#define PG8_WAIT_V(n) asm volatile("s_waitcnt vmcnt(" #n ")" ::: "memory")
#define PG8_WAIT_L(n) asm volatile("s_waitcnt lgkmcnt(" #n ")" ::: "memory")
#define PG8_BAR __builtin_amdgcn_s_barrier()
#define PG8_SCHED __builtin_amdgcn_sched_barrier(0)
    Unit cur, nxt; int ui = 0;
    if (!S.next(0, cur)) return;
    f32x4 acc[2][2][4][2];
#pragma unroll
    for (int a = 0; a < 2; ++a)
#pragma unroll
        for (int b = 0; b < 2; ++b)
#pragma unroll
            for (int m = 0; m < 4; ++m)
#pragma unroll
                for (int n = 0; n < 2; ++n) acc[a][b][m][n] = (f32x4){0.f, 0.f, 0.f, 0.f};
    bf16x8 At[4][2], B0[2][2], B1[2][2];
    const char* cA = (const char*)g.A + Geom::a_off(g, cur); const char* cB = (const char*)g.Bt + Geom::b_off(g, cur);
    PG8_STAGE(PG8_SB(0, 0), cB, voffB); PG8_STAGE(PG8_SB(0, 1), cB + hsB, voffB); PG8_STAGE(PG8_SA(0, 0), cA, voffA); PG8_STAGE(PG8_SA(0, 1), cA + hsA, voffA);
    if (wr == 1) PG8_BAR;
    PG8_WAIT_V(2); PG8_BAR;
    PG8_STAGE(PG8_SB(1, 0), cB + kstep, voffB); PG8_STAGE(PG8_SA(1, 0), cA + kstep, voffA); PG8_STAGE(PG8_SB(1, 1), cB + hsB + kstep, voffB);
    PG8_WAIT_V(6); PG8_BAR;
    for (;;) {
        const bool has_next = S.next(ui + 1, nxt);
        const char* nA = has_next ? (const char*)g.A + Geom::a_off(g, nxt) : cA; const char* nB = has_next ? (const char*)g.Bt + Geom::b_off(g, nxt) : cB;
#pragma unroll 1
        for (int t = 0; t < nt; t += 2) {
            const bool last = (t == nt - 2);
            const char* a1 = cA + (size_t)(t + 1) * kstep;
            const char* a2 = last ? nA : cA + (size_t)(t + 2) * kstep; const char* b2 = last ? nB : cB + (size_t)(t + 2) * kstep;
            const char* a3 = a2 + kstep; const char* b3 = b2 + kstep;
            PG8_LDB(B0, 0, 0); PG8_LDB(B1, 0, 1); PG8_SCHED; PG8_LDA(At, 0, 0); PG8_STAGE(PG8_SA(1, 1), a1 + hsA, voffA);
            PG8_WAIT_V(8); PG8_WAIT_L(0); PG8_BAR; PG8_MMA(0, 0, At, B0); PG8_MMA(0, 1, At, B1); PG8_BAR; PG8_SCHED;
            PG8_LDA(At, 0, 1); PG8_STAGE(PG8_SB(0, 0), b2, voffB); PG8_STAGE(PG8_SB(0, 1), b2 + hsB, voffB); PG8_STAGE(PG8_SA(0, 0), a2, voffA);
            PG8_WAIT_V(8); PG8_WAIT_L(0); PG8_BAR; PG8_MMA(1, 0, At, B0); PG8_MMA(1, 1, At, B1); PG8_BAR; PG8_SCHED;
            PG8_LDB(B0, 1, 0); PG8_LDB(B1, 1, 1); PG8_SCHED; PG8_LDA(At, 1, 0); PG8_STAGE(PG8_SA(0, 1), a2 + hsA, voffA);
            PG8_WAIT_V(8); PG8_WAIT_L(0); PG8_BAR; PG8_MMA(0, 0, At, B0); PG8_MMA(0, 1, At, B1); PG8_BAR; PG8_SCHED;
            PG8_LDA(At, 1, 1); PG8_STAGE(PG8_SB(1, 0), b3, voffB); PG8_STAGE(PG8_SB(1, 1), b3 + hsB, voffB); PG8_STAGE(PG8_SA(1, 0), a3, voffA);
            PG8_WAIT_V(8); PG8_WAIT_L(0); PG8_BAR; PG8_MMA(1, 0, At, B0); PG8_MMA(1, 1, At, B1); PG8_BAR; PG8_SCHED;
        }
        if constexpr (ALIGN_EPI) { if (wr == 0) PG8_BAR; }
        E(acc, cur, wr, wc, fr, fq);
        if (!has_next) break;
#pragma unroll
        for (int a = 0; a < 2; ++a)
#pragma unroll
            for (int b = 0; b < 2; ++b)
#pragma unroll
                for (int m = 0; m < 4; ++m)
#pragma unroll
                    for (int n = 0; n < 2; ++n) acc[a][b][m][n] = (f32x4){0.f, 0.f, 0.f, 0.f};
        cur = nxt; cA = nA; cB = nB; ++ui;
        if constexpr (ALIGN_EPI) { if (wr == 1) PG8_BAR; }
    }
    PG8_WAIT_V(0);
    if constexpr (!ALIGN_EPI) { if (wr == 0) PG8_BAR; }
    PG8_BAR;
#undef PG8_SA
#undef PG8_SB
#undef PG8_STAGE
#undef PG8_LDA
#undef PG8_LDB
#undef PG8_MMA
#undef PG8_WAIT_V
#undef PG8_WAIT_L
#undef PG8_BAR
#undef PG8_SCHED
}
}

struct Args { const float* in[30]; float* out; unsigned char* ws; int ph_lo, ph_hi, li, rep; };
struct Frame {
    LAS unsigned char* lds; int tid, lane, wave, G;
    const float* in[30]; float* out; unsigned char* ws;
};
#define WSP(T, off) ((T*)(F.ws + (off)))

__device__ __forceinline__ float dpp_ror1(float v) { return __builtin_bit_cast(float, __builtin_amdgcn_update_dpp(0, __builtin_bit_cast(int, v), 0x121, 0xf, 0xf, false)); }
__device__ __forceinline__ float dpp_ror2(float v) { return __builtin_bit_cast(float, __builtin_amdgcn_update_dpp(0, __builtin_bit_cast(int, v), 0x122, 0xf, 0xf, false)); }
__device__ __forceinline__ float dpp_ror3(float v) { return __builtin_bit_cast(float, __builtin_amdgcn_update_dpp(0, __builtin_bit_cast(int, v), 0x123, 0xf, 0xf, false)); }
struct EpiProjConv {
    static constexpr bool PERM = true;
    unsigned char* wsb; float* out; const float *rgw, *rgb, *sdw, *sdb, *dtb, *st_rg, *st_sd; LAS float* H;
    __device__ __forceinline__ void operator()(f32x4 (&acc)[2][2][4][2], const pg8::Unit& u, int wr, int wc, int fr, int fq) const {
        unsigned char* ws = wsb;
        asm volatile("" : "+v"(fr), "+v"(fq), "+s"(ws));
        const float* rs = (const float*)(ws + WS_RS1); bf16_t* G2 = (bf16_t*)(ws + WS_G2); float* DTA = (float*)(ws + WS_DTA);
        unsigned long long* HALO = (unsigned long long*)(ws + WS_HALO1); unsigned* HFLAG = (unsigned*)(ws + WS_CTL) + CW_HFLAG1; unsigned* tmo = (unsigned*)(ws + WS_CTL) + CW_TMO;
        const int row0 = u.pm * 256 + wr * 64 + fr, cl0 = wc * 32 + 8 * fq, c0 = u.pn * 256 + cl0;
        { float sc[2][4];
#pragma unroll
          for (int ai = 0; ai < 2; ++ai)
#pragma unroll
              for (int m = 0; m < 4; ++m) sc[ai][m] = rs[row0 + ai * 128 + m * 16];
#pragma unroll
          for (int ai = 0; ai < 2; ++ai)
#pragma unroll
              for (int m = 0; m < 4; ++m)
#pragma unroll
                  for (int bj = 0; bj < 2; ++bj) { acc[ai][bj][m][0] *= sc[ai][m]; acc[ai][bj][m][1] *= sc[ai][m]; } }
        const int pn = u.pn;
        if (pn >= 8 && pn < 24) {
#pragma unroll
            for (int ai = 0; ai < 2; ++ai)
#pragma unroll
                for (int m = 0; m < 4; ++m) { const int row = row0 + ai * 128 + m * 16;
#pragma unroll
                    for (int bj = 0; bj < 2; ++bj) { f32x4 v0 = acc[ai][bj][m][0], v1 = acc[ai][bj][m][1];
                        if (pn < 16) { v0 = (f32x4){gelu_tanh(v0[0]), gelu_tanh(v0[1]), gelu_tanh(v0[2]), gelu_tanh(v0[3])}; v1 = (f32x4){gelu_tanh(v1[0]), gelu_tanh(v1[1]), gelu_tanh(v1[2]), gelu_tanh(v1[3])}; }
                        else { v0 = (f32x4){siluf_(v0[0]), siluf_(v0[1]), siluf_(v0[2]), siluf_(v0[3])}; v1 = (f32x4){siluf_(v1[0]), siluf_(v1[1]), siluf_(v1[2]), siluf_(v1[3])}; }
                        u32x4 w; w.x = cvt_pk_bf16(v0[0], v0[1]); w.y = cvt_pk_bf16(v0[2], v0[3]); w.z = cvt_pk_bf16(v1[0], v1[1]); w.w = cvt_pk_bf16(v1[2], v1[3]);
                        *(u32x4*)(G2 + (size_t)row * 4096 + (c0 - C_RGG) + bj * 128) = w; } }
            return; }
        if (pn >= 36) {
            if (wc == 0) { const f32x4 b0 = *(const f32x4*)(dtb + cl0), b1 = *(const f32x4*)(dtb + cl0 + 4);
#pragma unroll
                for (int ai = 0; ai < 2; ++ai)
#pragma unroll
                    for (int m = 0; m < 4; ++m) { const int row = row0 + ai * 128 + m * 16; const f32x4 v0 = acc[ai][0][m][0] + b0, v1 = acc[ai][0][m][1] + b1;
                        float* d = DTA + (size_t)row * NH + cl0;
                        *(f32x4*)d = (f32x4){softplusf_(v0[0]), softplusf_(v0[1]), softplusf_(v0[2]), softplusf_(v0[3])}; *(f32x4*)(d + 4) = (f32x4){softplusf_(v1[0]), softplusf_(v1[1]), softplusf_(v1[2]), softplusf_(v1[3])}; } }
            return; }
        const bool is_rg = pn < 8, prompt = u.pm < MP / 256;
        const int ch0 = is_rg ? c0 : c0 - C_XBC, CW = is_rg ? DRNN : DXBC;
        const float* cw = rgw + (is_rg ? (ptrdiff_t)0 : (sdw - rgw)); const float* cb = rgb + (is_rg ? (ptrdiff_t)0 : (sdb - rgb)); const float* stp = st_rg + (is_rg ? (ptrdiff_t)0 : (st_sd - st_rg));
        if ((u.pm & 7) == 7 || !prompt) {
#pragma unroll
            for (int ai = 0; ai < 2; ++ai)
#pragma unroll
                for (int m = 0; m < 4; ++m) { const int row = row0 + ai * 128 + m * 16; int j = -1; size_t base = 0;
                    if (row < MP) { const int t = row & (SEQ - 1); if (t >= SEQ - 3) { j = t - (SEQ - 3); base = (size_t)(row >> 11) * 3; } }
                    else { const int r = row - MP, t = r & 3; if (t >= 1) { j = t - 1; base = (size_t)(r >> 2) * 3; } }
                    if (j >= 0) { const size_t oo = is_rg ? (row < MP ? O_PRGC : O_SRGC) : (row < MP ? O_PSC : O_SSC); float* so = out + oo + (base + j) * CW + ch0;
#pragma unroll
                        for (int bj = 0; bj < 2; ++bj) { *(f32x4*)(so + bj * 128) = acc[ai][bj][m][0]; *(f32x4*)(so + bj * 128 + 4) = acc[ai][bj][m][1]; } } } }
        const int tile = u.pm * 37 + u.pn;
        if (prompt) {
            if (fr >= 13) {
#pragma unroll
                for (int ai = 0; ai < 2; ++ai)
#pragma unroll
                    for (int bj = 0; bj < 2; ++bj)
#pragma unroll
                        for (int n = 0; n < 2; ++n) *(LAS f32x4*)(H + ((2 * ai + wr) * 3 + (fr - 13)) * 256 + bj * 128 + cl0 + 4 * n) = acc[ai][bj][3][n];
                if (wr == 1 && (u.pm & 7) != 7) { unsigned long long* hp = HALO + ((size_t)tile * 3 + (fr - 13)) * 128 + (cl0 >> 1);
#pragma unroll
                    for (int bj = 0; bj < 2; ++bj)
#pragma unroll
                        for (int n = 0; n < 2; ++n) { const f32x4 g = acc[1][bj][3][n];
                            __hip_atomic_store(hp + bj * 64 + 2 * n, ((unsigned long long)__float_as_uint(g[1]) << 32) | __float_as_uint(g[0]), __ATOMIC_RELAXED, __HIP_MEMORY_SCOPE_AGENT);
                            __hip_atomic_store(hp + bj * 64 + 2 * n + 1, ((unsigned long long)__float_as_uint(g[3]) << 32) | __float_as_uint(g[2]), __ATOMIC_RELAXED, __HIP_MEMORY_SCOPE_AGENT); } }
            }
            if (wr == 1 && (u.pm & 7) != 7) { asm volatile("s_waitcnt vmcnt(0)" ::: "memory");
                if (fr == 0 && fq == 0) __hip_atomic_fetch_add(HFLAG + tile, 1u, __ATOMIC_RELAXED, __HIP_MEMORY_SCOPE_AGENT); }
            asm volatile("s_waitcnt lgkmcnt(0)" ::: "memory"); __builtin_amdgcn_s_barrier(); asm volatile("" ::: "memory");
        }
        const size_t dso = is_rg ? WS_XCB : (ch0 < DSSM ? WS_XS : WS_BC); const int ld = is_rg ? DRNN : (ch0 < DSSM ? DSSM : 1024);
        bf16_t* dst = (bf16_t*)(ws + dso) + (is_rg ? ch0 : (ch0 < DSSM ? ch0 : ch0 - DSSM));
#pragma unroll
        for (int ai = 0; ai < 2; ++ai)
#pragma unroll
            for (int bj = 0; bj < 2; ++bj) {
                f32x4 hal[2];
                hal[0] = hal[1] = (f32x4){0.f, 0.f, 0.f, 0.f};
                if (prompt) { const int b = 2 * ai + wr;
                    if (b >= 1) { if (fr >= 13) {
#pragma unroll
                            for (int n = 0; n < 2; ++n) hal[n] = *(const LAS f32x4*)(H + ((b - 1) * 3 + (fr - 13)) * 256 + bj * 128 + cl0 + 4 * n); } }
                    else if ((u.pm & 7) != 0) { unsigned* fl = HFLAG + (tile - 37); unsigned sp = 0;
                        while ((unsigned)__builtin_amdgcn_readfirstlane(__hip_atomic_load(fl, __ATOMIC_RELAXED, __HIP_MEMORY_SCOPE_AGENT)) < 4u) { __builtin_amdgcn_s_sleep(2);
                            if ((++sp & 1023u) == 0u) { if (__hip_atomic_load(tmo, __ATOMIC_RELAXED, __HIP_MEMORY_SCOPE_AGENT) != 0u) break; if (sp > (1u << 22)) { __hip_atomic_store(tmo, 1u, __ATOMIC_RELAXED, __HIP_MEMORY_SCOPE_AGENT); break; } } }
                        if (fr >= 13) { const unsigned long long* hp = HALO + ((size_t)(tile - 37) * 3 + (fr - 13)) * 128 + (cl0 >> 1) + bj * 64;
#pragma unroll
                            for (int n = 0; n < 2; ++n) { const unsigned long long a2 = __hip_atomic_load(hp + 2 * n, __ATOMIC_RELAXED, __HIP_MEMORY_SCOPE_AGENT), b2 = __hip_atomic_load(hp + 2 * n + 1, __ATOMIC_RELAXED, __HIP_MEMORY_SCOPE_AGENT);
                                hal[n] = (f32x4){__uint_as_float((unsigned)a2), __uint_as_float((unsigned)(a2 >> 32)), __uint_as_float((unsigned)b2), __uint_as_float((unsigned)(b2 >> 32))}; } } } }
#pragma unroll
                for (int n = 0; n < 2; ++n) { const int ch = ch0 + bj * 128 + 4 * n;
                    const f32x4 w0 = *(const f32x4*)(cw + ch), w1 = *(const f32x4*)(cw + CW + ch), w2 = *(const f32x4*)(cw + 2 * CW + ch), w3 = *(const f32x4*)(cw + 3 * CW + ch), bb = *(const f32x4*)(cb + ch);
#pragma unroll
                    for (int m = 0; m < 4; ++m) { const int row = row0 + ai * 128 + m * 16; const f32x4 g = acc[ai][bj][m][n]; f32x4 p1, p2, p3;
                        if (prompt) { const f32x4 gp = (m == 0) ? hal[n] : acc[ai][bj][m > 0 ? m - 1 : 0][n];
#pragma unroll
                            for (int j = 0; j < 4; ++j) { p1[j] = dpp_ror1(fr == 15 ? gp[j] : g[j]); p2[j] = dpp_ror2(fr >= 14 ? gp[j] : g[j]); p3[j] = dpp_ror3(fr >= 13 ? gp[j] : g[j]); } }
                        else { const int t = fr & 3; const float* sp = stp + (size_t)((row - MP) >> 2) * 3 * CW + ch;
                            const f32x4 b0 = *(const f32x4*)sp, b1 = *(const f32x4*)(sp + CW), b2 = *(const f32x4*)(sp + 2 * CW);
#pragma unroll
                            for (int j = 0; j < 4; ++j) { const float r1 = dpp_ror1(g[j]), r2 = dpp_ror2(g[j]), r3 = dpp_ror3(g[j]);
                                p1[j] = t >= 1 ? r1 : b2[j]; p2[j] = t >= 2 ? r2 : (t == 1 ? b2[j] : b1[j]); p3[j] = t >= 3 ? r3 : (t == 2 ? b2[j] : (t == 1 ? b1[j] : b0[j])); } }
                        float o[4];
#pragma unroll
                        for (int j = 0; j < 4; ++j) { const float y = bb[j] + w0[j] * p3[j] + w1[j] * p2[j] + w2[j] * p1[j] + w3[j] * g[j]; o[j] = is_rg ? y : siluf_(y); }
                        u32x2 w; w.x = cvt_pk_bf16(o[0], o[1]); w.y = cvt_pk_bf16(o[2], o[3]);
                        *(u32x2*)(dst + (size_t)row * ld + bj * 128 + 4 * n) = w; }
                    asm volatile("" ::: "memory"); } }
    }
};
struct EpiGates {
    static constexpr bool PERM = false;
    unsigned* AB; const bf16_t* XCB; const float *ba, *bi, *sp8;
    __device__ __forceinline__ void operator()(const f32x4 (&acc)[2][2][4][2], const pg8::Unit& u, int wr, int wc, int fr, int fq) const {
        const int row0 = u.pm * 256 + wr * 64 + fr, ch0 = (u.pn >> 1) * 256 + (u.pn & 1) * 128 + wc * 32 + 4 * fq;
        const unsigned base = (unsigned)row0 * DRNN + ch0;
        u32x2 xw[2][2][4]; f32x4 bav[2], biv[2], spv[2];
#pragma unroll
        for (int n = 0; n < 2; ++n) { const int ch = ch0 + n * 16; bav[n] = *(const f32x4*)(ba + ch); biv[n] = *(const f32x4*)(bi + ch); spv[n] = *(const f32x4*)(sp8 + ch);
#pragma unroll
            for (int ai = 0; ai < 2; ++ai)
#pragma unroll
                for (int m = 0; m < 4; ++m) xw[n][ai][m] = *(const u32x2*)((const char*)XCB + (size_t)((base + (unsigned)((ai * 128 + m * 16) * DRNN + n * 16)) * 2u)); }
#pragma unroll
        for (int n = 0; n < 2; ++n) {
#pragma unroll
            for (int ai = 0; ai < 2; ++ai)
#pragma unroll
                for (int m = 0; m < 4; ++m) { const unsigned off = base + (unsigned)((ai * 128 + m * 16) * DRNN + n * 16);
                    const u32x2 x2 = xw[n][ai][m];
                    const float xc[4] = {bf_lo(x2.x), bf_hi(x2.x), bf_lo(x2.y), bf_hi(x2.y)};
                    const f32x4 r4 = acc[ai][0][m][n] + bav[n], i4 = acc[ai][1][m][n] + biv[n];
                    float av[4], bv[4];
#pragma unroll
                    for (int j = 0; j < 4; ++j) { const float gr = sigmoidf_(r4[j]), gi = sigmoidf_(i4[j]); const float la = -gr * spv[n][j];
                        av[j] = __expf(la); bv[j] = __builtin_amdgcn_sqrtf(neg_expm1_small(2.0f * la, av[j])) * gi * xc[j]; }
                    u32x4 pk; pk.x = cvt_pk_bf16(1.0f - av[0], bv[0]); pk.y = cvt_pk_bf16(1.0f - av[1], bv[1]); pk.z = cvt_pk_bf16(1.0f - av[2], bv[2]); pk.w = cvt_pk_bf16(1.0f - av[3], bv[3]);
                    *(u32x4*)((char*)AB + (size_t)off * 4u) = pk; } }
    }
};
struct EpiX1 {
    static constexpr bool PERM = true;
    const float *xp, *xs; bf16_t* X1;
    __device__ __forceinline__ void operator()(const f32x4 (&acc)[2][2][4][2], const pg8::Unit& u, int wr, int wc, int fr, int fq) const {
        const int row0 = u.pm * 256 + wr * 64 + fr, col0 = u.pn * 256 + wc * 32 + 8 * fq;
#pragma unroll
        for (int am = 0; am < 4; ++am) { const int ai = am >> 1, m0 = 2 * (am & 1); f32x4 r[2][2][2];
#pragma unroll
            for (int mm = 0; mm < 2; ++mm) { const int row = row0 + ai * 128 + (m0 + mm) * 16; const float* xin = (row < MP ? xp + (size_t)row * DM : xs + (size_t)(row - MP) * DM) + col0;
#pragma unroll
                for (int bj = 0; bj < 2; ++bj)
#pragma unroll
                    for (int n = 0; n < 2; ++n) r[mm][bj][n] = *(const f32x4*)(xin + bj * 128 + 4 * n); }
#pragma unroll
            for (int mm = 0; mm < 2; ++mm) { bf16_t* o = X1 + (size_t)(row0 + ai * 128 + (m0 + mm) * 16) * DM + col0;
#pragma unroll
                for (int bj = 0; bj < 2; ++bj) { const f32x4 v0 = acc[ai][bj][m0 + mm][0] + r[mm][bj][0], v1 = acc[ai][bj][m0 + mm][1] + r[mm][bj][1];
                    u32x4 w; w.x = cvt_pk_bf16(v0[0], v0[1]); w.y = cvt_pk_bf16(v0[2], v0[3]); w.z = cvt_pk_bf16(v1[0], v1[1]); w.w = cvt_pk_bf16(v1[2], v1[3]);
                    *(u32x4*)(o + bj * 128) = w; } } }
    }
};
struct EpiUpConv {
    static constexpr bool PERM = true;
    bf16_t* ACT; const float* rf; const unsigned* cmax; float* out; const float *cw, *cb, *stf; LAS float* H; unsigned long long* HALO; unsigned* HFLAG; unsigned* tmo;
    __device__ __forceinline__ void operator()(f32x4 (&acc)[2][2][4][2], const pg8::Unit& u, int wr, int wc, int fr, int fq) const {
        const int row0 = u.pm * 256 + wr * 64 + fr, cl0 = wc * 32 + 8 * fq, ch0 = u.pn * 128 + cl0;
        float sc[2][4];
#pragma unroll
        for (int ai = 0; ai < 2; ++ai)
#pragma unroll
            for (int m = 0; m < 4; ++m) sc[ai][m] = rf[row0 + ai * 128 + m * 16];
        {
            f32x4 sw[2][2];
#pragma unroll
            for (int bj = 0; bj < 2; ++bj)
#pragma unroll
                for (int n = 0; n < 2; ++n) { const u32x4 c = *(const u32x4*)(cmax + u.pn * 256 + bj * 128 + cl0 + 4 * n); sw[bj][n] = (f32x4){__uint_as_float(c.x), __uint_as_float(c.y), __uint_as_float(c.z), __uint_as_float(c.w)} * (1.004f / 127.0f); }
#pragma unroll
            for (int ai = 0; ai < 2; ++ai)
#pragma unroll
                for (int m = 0; m < 4; ++m)
#pragma unroll
                    for (int bj = 0; bj < 2; ++bj)
#pragma unroll
                        for (int n = 0; n < 2; ++n) { const i32x4 q = __builtin_bit_cast(i32x4, acc[ai][bj][m][n]); acc[ai][bj][m][n] = (f32x4){(float)q[0], (float)q[1], (float)q[2], (float)q[3]} * sw[bj][n] * sc[ai][m]; }
        }
        if ((u.pm & 7) == 7 || u.pm >= MP / 256) {
#pragma unroll
            for (int ai = 0; ai < 2; ++ai)
#pragma unroll
                for (int m = 0; m < 4; ++m) { const int row = row0 + ai * 128 + m * 16; float* so = nullptr;
                    if (row < MP) { const int t = row & (SEQ - 1); if (t >= SEQ - 2) so = out + O_PFC + ((size_t)(row >> 11) * 2 + (t - (SEQ - 2))) * DFF + ch0; }
                    else { const int r = row - MP, t = r & 3; if (t >= 2) so = out + O_SFC + ((size_t)(r >> 2) * 2 + (t - 2)) * DFF + ch0; }
                    if (so) { *(f32x4*)so = acc[ai][0][m][0]; *(f32x4*)(so + 4) = acc[ai][0][m][1]; } } }
        const bool prompt = u.pm < MP / 256;
        if (prompt) {
            if (fr >= 14) {
#pragma unroll
                for (int ai = 0; ai < 2; ++ai)
#pragma unroll
                    for (int n = 0; n < 2; ++n) *(LAS f32x4*)(H + ((2 * ai + wr) * 2 + (fr - 14)) * 128 + cl0 + 4 * n) = acc[ai][0][3][n];
                if (wr == 1 && (u.pm & 7) != 7) { unsigned long long* hp = HALO + ((size_t)(u.pm * 96 + u.pn) * 2 + (fr - 14)) * 64 + (cl0 >> 1);
#pragma unroll
                    for (int n = 0; n < 2; ++n) { const f32x4 g = acc[1][0][3][n];
                        __hip_atomic_store(hp + 2 * n, ((unsigned long long)__float_as_uint(g[1]) << 32) | __float_as_uint(g[0]), __ATOMIC_RELAXED, __HIP_MEMORY_SCOPE_AGENT);
                        __hip_atomic_store(hp + 2 * n + 1, ((unsigned long long)__float_as_uint(g[3]) << 32) | __float_as_uint(g[2]), __ATOMIC_RELAXED, __HIP_MEMORY_SCOPE_AGENT); } }
            }
            if (wr == 1 && (u.pm & 7) != 7) { asm volatile("s_waitcnt vmcnt(0)" ::: "memory");
                if (fr == 0 && fq == 0) __hip_atomic_fetch_add(HFLAG + u.pm * 96 + u.pn, 1u, __ATOMIC_RELAXED, __HIP_MEMORY_SCOPE_AGENT); }
            asm volatile("s_waitcnt lgkmcnt(0)" ::: "memory"); __builtin_amdgcn_s_barrier(); asm volatile("" ::: "memory");
        }
#pragma unroll
        for (int ai = 0; ai < 2; ++ai) {
            f32x4 hal[2]; hal[0] = hal[1] = (f32x4){0.f, 0.f, 0.f, 0.f};
            if (prompt) { const int b = 2 * ai + wr;
                if (b >= 1) { if (fr >= 14) {
#pragma unroll
                        for (int n = 0; n < 2; ++n) hal[n] = *(const LAS f32x4*)(H + ((b - 1) * 2 + (fr - 14)) * 128 + cl0 + 4 * n); } }
                else if ((u.pm & 7) != 0) { unsigned* fl = HFLAG + (u.pm - 1) * 96 + u.pn; unsigned sp = 0;
                    while ((unsigned)__builtin_amdgcn_readfirstlane(__hip_atomic_load(fl, __ATOMIC_RELAXED, __HIP_MEMORY_SCOPE_AGENT)) < 4u) { __builtin_amdgcn_s_sleep(2);
                        if ((++sp & 1023u) == 0u) { if (__hip_atomic_load(tmo, __ATOMIC_RELAXED, __HIP_MEMORY_SCOPE_AGENT) != 0u) break; if (sp > (1u << 22)) { __hip_atomic_store(tmo, 1u, __ATOMIC_RELAXED, __HIP_MEMORY_SCOPE_AGENT); break; } } }
                    if (fr >= 14) { const unsigned long long* hp = HALO + ((size_t)((u.pm - 1) * 96 + u.pn) * 2 + (fr - 14)) * 64 + (cl0 >> 1);
#pragma unroll
                        for (int n = 0; n < 2; ++n) { const unsigned long long a = __hip_atomic_load(hp + 2 * n, __ATOMIC_RELAXED, __HIP_MEMORY_SCOPE_AGENT), b2 = __hip_atomic_load(hp + 2 * n + 1, __ATOMIC_RELAXED, __HIP_MEMORY_SCOPE_AGENT);
                            hal[n] = (f32x4){__uint_as_float((unsigned)a), __uint_as_float((unsigned)(a >> 32)), __uint_as_float((unsigned)b2), __uint_as_float((unsigned)(b2 >> 32))}; } } } }
#pragma unroll
            for (int n = 0; n < 2; ++n) {
                const f32x4 w0 = *(const f32x4*)(cw + ch0 + 4 * n), w1 = *(const f32x4*)(cw + DFF + ch0 + 4 * n), w2 = *(const f32x4*)(cw + 2 * DFF + ch0 + 4 * n), bb = *(const f32x4*)(cb + ch0 + 4 * n);
#pragma unroll
                for (int m = 0; m < 4; ++m) { const int row = row0 + ai * 128 + m * 16; const f32x4 g = acc[ai][0][m][n], vv = acc[ai][1][m][n]; f32x4 p1, p2;
                    if (prompt) { const f32x4 gp = (m == 0) ? hal[n] : acc[ai][0][m > 0 ? m - 1 : 0][n];
#pragma unroll
                        for (int j = 0; j < 4; ++j) { p1[j] = dpp_ror1(fr == 15 ? gp[j] : g[j]); p2[j] = dpp_ror2(fr >= 14 ? gp[j] : g[j]); } }
                    else { const int t = fr & 3; const float* sp = stf + (size_t)((row - MP) >> 2) * 2 * DFF + ch0 + 4 * n;
                        f32x4 b0 = (f32x4){0.f, 0.f, 0.f, 0.f}, b1 = b0; if (t == 0) b0 = *(const f32x4*)sp; if (t <= 1) b1 = *(const f32x4*)(sp + DFF);
#pragma unroll
                        for (int j = 0; j < 4; ++j) { const float r1 = dpp_ror1(g[j]), r2 = dpp_ror2(g[j]); p1[j] = t >= 1 ? r1 : b1[j]; p2[j] = t >= 2 ? r2 : (t == 1 ? b1[j] : b0[j]); } }
                    float o[4];
#pragma unroll
                    for (int j = 0; j < 4; ++j) { const float y = bb[j] + w0[j] * p2[j] + w1[j] * p1[j] + w2[j] * g[j]; o[j] = gelu_tanh(y) * vv[j]; }
                    u32x2 w; w.x = cvt_pk_bf16(o[0], o[1]); w.y = cvt_pk_bf16(o[2], o[3]);
                    *(u32x2*)(ACT + (size_t)row * DFF + ch0 + 4 * n) = w; } } }
    }
};
struct EpiX2 {
    static constexpr bool PERM = false;
    const bf16_t* X1; bf16_t* X2; const float *sa, *sw;
    __device__ __forceinline__ void operator()(const f32x4 (&acc)[2][2][4][2], const pg8::Unit& u, int wr, int wc, int fr, int fq) const {
        const int row0 = u.pm * 256 + wr * 64 + fr, col0 = u.pn * 256 + wc * 32 + 4 * fq;
        f32x4 swv[2][2];
#pragma unroll
        for (int bj = 0; bj < 2; ++bj)
#pragma unroll
            for (int n = 0; n < 2; ++n) swv[bj][n] = *(const f32x4*)(sw + col0 + bj * 128 + n * 16);
        float sav[2][4];
#pragma unroll
        for (int ai = 0; ai < 2; ++ai)
#pragma unroll
            for (int m = 0; m < 4; ++m) sav[ai][m] = sa[row0 + ai * 128 + m * 16];
#pragma unroll
        for (int am = 0; am < 4; ++am) { const int ai = am >> 1, m0 = 2 * (am & 1); f32x4 r[2][2][2];
#pragma unroll
            for (int mm = 0; mm < 2; ++mm) { const size_t off = (size_t)(row0 + ai * 128 + (m0 + mm) * 16) * DM + col0;
#pragma unroll
                for (int bj = 0; bj < 2; ++bj)
#pragma unroll
                    for (int n = 0; n < 2; ++n) r[mm][bj][n] = ld_bf4(X1 + off + bj * 128 + n * 16); }
#pragma unroll
            for (int mm = 0; mm < 2; ++mm) { const size_t off = (size_t)(row0 + ai * 128 + (m0 + mm) * 16) * DM + col0;
#pragma unroll
                for (int bj = 0; bj < 2; ++bj)
#pragma unroll
                    for (int n = 0; n < 2; ++n) { const i32x4 q = __builtin_bit_cast(i32x4, acc[ai][bj][m0 + mm][n]);
                        const f32x4 v = (f32x4){(float)q[0], (float)q[1], (float)q[2], (float)q[3]} * swv[bj][n] * sav[ai][m0 + mm] + r[mm][bj][n];
                        u32x2 w; w.x = cvt_pk_bf16(v[0], v[1]); w.y = cvt_pk_bf16(v[2], v[3]); *(u32x2*)(X2 + off + bj * 128 + n * 16) = w; } } }
    }
};
struct EpiX1Q {
    static constexpr bool PERM = false;
    const float *xp, *xs; bf16_t* X1; const float *sa, *sw;
    __device__ __forceinline__ void operator()(const f32x4 (&acc)[2][2][4][2], const pg8::Unit& u, int wr, int wc, int fr, int fq) const {
        const int row0 = u.pm * 256 + wr * 64 + fr, col0 = u.pn * 256 + wc * 32 + 4 * fq;
        f32x4 swv[2][2];
#pragma unroll
        for (int bj = 0; bj < 2; ++bj)
#pragma unroll
            for (int n = 0; n < 2; ++n) swv[bj][n] = *(const f32x4*)(sw + col0 + bj * 128 + n * 16);
        float sav[2][4];
#pragma unroll
        for (int ai = 0; ai < 2; ++ai)
#pragma unroll
            for (int m = 0; m < 4; ++m) sav[ai][m] = sa[row0 + ai * 128 + m * 16];
#pragma unroll
        for (int am = 0; am < 4; ++am) { const int ai = am >> 1, m0 = 2 * (am & 1); f32x4 r[2][2][2];
#pragma unroll
            for (int mm = 0; mm < 2; ++mm) { const int row = row0 + ai * 128 + (m0 + mm) * 16; const float* xin = (row < MP ? xp + (size_t)row * DM : xs + (size_t)(row - MP) * DM) + col0;
#pragma unroll
                for (int bj = 0; bj < 2; ++bj)
#pragma unroll
                    for (int n = 0; n < 2; ++n) r[mm][bj][n] = *(const f32x4*)(xin + bj * 128 + n * 16); }
#pragma unroll
            for (int mm = 0; mm < 2; ++mm) { const size_t off = (size_t)(row0 + ai * 128 + (m0 + mm) * 16) * DM + col0;
#pragma unroll
                for (int bj = 0; bj < 2; ++bj)
#pragma unroll
                    for (int n = 0; n < 2; ++n) { const i32x4 q = __builtin_bit_cast(i32x4, acc[ai][bj][m0 + mm][n]);
                        const f32x4 v = (f32x4){(float)q[0], (float)q[1], (float)q[2], (float)q[3]} * swv[bj][n] * sav[ai][m0 + mm] + r[mm][bj][n];
                        u32x2 w; w.x = cvt_pk_bf16(v[0], v[1]); w.y = cvt_pk_bf16(v[2], v[3]); *(u32x2*)(X1 + off + bj * 128 + n * 16) = w; } } }
    }
};
struct EpiPart {
    static constexpr bool PERM = false;
    float* P;
    __device__ __forceinline__ void operator()(const f32x4 (&acc)[2][2][4][2], const pg8::Unit& u, int wr, int wc, int fr, int fq) const {
        float* base = P + ((size_t)(u.tl * 8 + u.ks) << 16) + (size_t)(wr * 64 + fr) * 256 + wc * 32 + 4 * fq;
#pragma unroll
        for (int ai = 0; ai < 2; ++ai)
#pragma unroll
            for (int m = 0; m < 4; ++m)
#pragma unroll
                for (int bj = 0; bj < 2; ++bj)
#pragma unroll
                    for (int n = 0; n < 2; ++n) *(f32x4*)(base + (size_t)(ai * 128 + m * 16) * 256 + bj * 128 + n * 16) = acc[ai][bj][m][n];
    }
};
struct EpiPartQ {
    static constexpr bool PERM = false;
    bf16_t* P; const float *sa, *sw;
    __device__ __forceinline__ void operator()(const f32x4 (&acc)[2][2][4][2], const pg8::Unit& u, int wr, int wc, int fr, int fq) const {
        bf16_t* base = P + ((size_t)(u.tl * 8 + u.ks) << 16) + (size_t)(wr * 64 + fr) * 256 + wc * 32 + 4 * fq;
        const int row0 = u.pm * 256 + wr * 64 + fr, col0 = u.pn * 256 + wc * 32 + 4 * fq;
        f32x4 swv[2][2];
#pragma unroll
        for (int bj = 0; bj < 2; ++bj)
#pragma unroll
            for (int n = 0; n < 2; ++n) swv[bj][n] = *(const f32x4*)(sw + col0 + bj * 128 + n * 16);
#pragma unroll
        for (int ai = 0; ai < 2; ++ai)
#pragma unroll
            for (int m = 0; m < 4; ++m) { const float sav = sa[row0 + ai * 128 + m * 16];
#pragma unroll
                for (int bj = 0; bj < 2; ++bj)
#pragma unroll
                    for (int n = 0; n < 2; ++n) { const i32x4 q = __builtin_bit_cast(i32x4, acc[ai][bj][m][n]);
                        const f32x4 v = (f32x4){(float)q[0], (float)q[1], (float)q[2], (float)q[3]} * swv[bj][n] * sav;
                        u32x2 o; o.x = cvt_pk_bf16(v[0], v[1]); o.y = cvt_pk_bf16(v[2], v[3]);
                        *(u32x2*)(base + (size_t)(ai * 128 + m * 16) * 256 + bj * 128 + n * 16) = o; } }
    }
};

__device__ __forceinline__ void p0_transpose_item(const float* W, int N, int k0, int n0, const float* gk, bf16_t* WT, int ldt, int dst_row0, LAS float* scr, int lane, unsigned* cmax = nullptr) {
    const int lq = lane >> 4, n4 = lane & 15; const bool inb = (n0 + 4 * n4) < N;
    f32x4 v[16];
#pragma unroll
    for (int i = 0; i < 16; ++i) v[i] = inb ? __builtin_nontemporal_load((const f32x4*)(W + (size_t)(k0 + 4 * i + lq) * N + n0 + 4 * n4)) : (f32x4){0.f, 0.f, 0.f, 0.f};
    if (gk) {
#pragma unroll
        for (int i = 0; i < 16; ++i) v[i] *= gk[k0 + 4 * i + lq]; }
#pragma unroll
    for (int i = 0; i < 16; ++i) { const int k = 4 * i + lq; *(LAS f32x4*)(scr + k * 64 + 4 * ((n4 ^ (2 * (k >> 3))) & 15)) = v[i]; }
    LDS_WAIT(); asm volatile("" ::: "memory");
    const int c = lane & 7, np = lane >> 3;
#pragma unroll
    for (int j = 0; j < 8; ++j) { const int n = np + 8 * j; const LAS float* sp = scr + (8 * c) * 64 + 4 * ((((n >> 2) ^ (2 * c)) & 15)) + (n & 3);
        u32x4 o; o.x = cvt_pk_bf16(sp[0 * 64], sp[1 * 64]); o.y = cvt_pk_bf16(sp[2 * 64], sp[3 * 64]); o.z = cvt_pk_bf16(sp[4 * 64], sp[5 * 64]); o.w = cvt_pk_bf16(sp[6 * 64], sp[7 * 64]);
        if (n0 + n < N) *(u32x4*)(WT + (size_t)(dst_row0 + n) * ldt + k0 + 8 * c) = o;
        if (cmax) { float mx = fmaxf(fmaxf(fmaxf(fabsf(sp[0 * 64]), fabsf(sp[1 * 64])), fmaxf(fabsf(sp[2 * 64]), fabsf(sp[3 * 64]))), fmaxf(fmaxf(fabsf(sp[4 * 64]), fabsf(sp[5 * 64])), fmaxf(fabsf(sp[6 * 64]), fabsf(sp[7 * 64]))));
            mx = fmaxf(mx, __shfl_xor(mx, 1)); mx = fmaxf(mx, __shfl_xor(mx, 2)); mx = fmaxf(mx, __shfl_xor(mx, 4));
            if (c == 0) atomicMax(cmax + dst_row0 + n, __float_as_uint(mx)); } }
    LDS_WAIT(); asm volatile("" ::: "memory");
}
__device__ __forceinline__ void p0_late_weights(Frame& F, int gw, int NGW) {
    LAS float* scr = (LAS float*)(F.lds + F.wave * 16384);
    constexpr int I_OUT = (DM / 64) * (DM / 64), I_UP = (DM / 64) * (2 * DFF / 64), I_DN = (DFF / 64) * (DM / 64);
    for (int it = gw; it < I_UP + I_DN + I_OUT; it += NGW) {
        int r = it;
        if (r < I_UP) { const int nblk = 2 * DFF / 64, kb = r / nblk, nb = r % nblk; const int n0 = 64 * nb, half = n0 / DFF, j = n0 % DFF;
            p0_transpose_item(F.in[25], 2 * DFF, 64 * kb, n0, F.in[24], WSP(bf16_t, WS_BT3), DM, (j / 128) * 256 + half * 128 + (j % 128), scr, F.lane, (unsigned*)(F.ws + WS_CTL) + CW_CMAX3); continue; } r -= I_UP;
        if (r < I_DN) { const int nblk = DM / 64, kb = r / nblk, nb = r % nblk; p0_transpose_item(F.in[28], DM, 64 * kb, 64 * nb, nullptr, WSP(bf16_t, WS_BT4), DFF, 64 * nb, scr, F.lane); continue; } r -= I_DN;
        { const int nblk = DM / 64, kb = r / nblk, nb = r % nblk; const int k0 = 64 * kb;
          const float* gk = k0 < DRNN ? F.in[16] : F.in[22] - DRNN;
          p0_transpose_item(F.in[23], DM, k0, 64 * nb, gk, WSP(bf16_t, WS_BT2), DM, 64 * nb, scr, F.lane); }
    }
}
constexpr int G1_PER = 26, G1_HI = 2, NGEMM1 = 8 * G1_PER + G1_HI, NSTREAM = 256 - NGEMM1;
__device__ __forceinline__ void p0_prologue(Frame& F) {
    LAS float* scr = (LAS float*)(F.lds + F.wave * 16384);
    const int gw = F.wave * F.G + blockIdx.x, NGW = F.G * 8;
    constexpr int NB_IN = (INC + 63) / 64;
    constexpr int I_IN = (DM / 64) * NB_IN, I_G = 16 * 4 * 4;
    for (int it = gw; it < I_IN + I_G; it += NGW) {
        int r = it;
        if (r < I_IN) { const int kb = r / NB_IN, nb = r % NB_IN; p0_transpose_item(F.in[8], INC, 64 * kb, 64 * nb, F.in[7], WSP(bf16_t, WS_BT1), DM, 64 * nb, scr, F.lane); continue; } r -= I_IN;
        { const int mat = r / 16, rr = r % 16, kb = rr / 4, nb = rr % 4, gate = mat / 8, h = mat % 8, n0 = 64 * nb, hc = n0 / 128, idx = n0 % 128;
          const float* W = (gate ? F.in[13] : F.in[11]) + (size_t)h * 65536;
          p0_transpose_item(W, 256, 64 * kb, n0, nullptr, WSP(bf16_t, WS_BTG), 256, ((h * 2 + hc) * 2 + gate) * 128 + idx, scr, F.lane); }
    }
    if (F.G != 256) p0_late_weights(F, gw, NGW);
    bf16_t* XB = WSP(bf16_t, WS_XB); float* rs1 = WSP(float, WS_RS1);
    for (int m = gw; m < M; m += NGW) {
        const float* xr = (m < MP ? F.in[0] + (size_t)m * DM : F.in[1] + (size_t)(m - MP) * DM);
        f32x4 v[16]; float ss = 0.f;
#pragma unroll
        for (int j = 0; j < 16; ++j) { v[j] = __builtin_nontemporal_load((const f32x4*)(xr + 4 * (F.lane + 64 * j))); ss += (v[j][0] * v[j][0] + v[j][1] * v[j][1]) + (v[j][2] * v[j][2] + v[j][3] * v[j][3]); }
        ss = wave_sum(ss);
        if (F.lane == 0) rs1[m] = rsqrtf(ss * (1.0f / DM) + EPS);
#pragma unroll
        for (int j = 0; j < 16; ++j) { u32x2 w; w.x = cvt_pk_bf16(v[j][0], v[j][1]); w.y = cvt_pk_bf16(v[j][2], v[j][3]); *(u32x2*)(XB + (size_t)m * DM + 4 * (F.lane + 64 * j)) = w; }
    }
    { float* sp8 = WSP(float, WS_SP8); const int gt = blockIdx.x * 512 + F.tid; if (gt < DRNN) sp8[gt] = 8.0f * softplusf_(-F.in[15][gt]); }
}

constexpr int SI_W = 2048, SI_B = SI_W + 128 * 272, SI_X = SI_B + 128 * 272, SI_XP = 144, SI_END = SI_X + 128 * SI_XP;
constexpr int SI_X2 = SI_END + 8 * 384 * 4;
static_assert(SI_X2 + 128 * SI_XP <= LDSCTL_OFF, "ssd intra LDS map");
typedef unsigned short u16x4 __attribute__((ext_vector_type(4)));
template <int PITCH>
__device__ __forceinline__ void tr_frags(unsigned a, bf16x8 (&f)[4]) {
    u16x4 r[8];
    asm volatile("ds_read_b64_tr_b16 %0, %8 offset:%9\n\tds_read_b64_tr_b16 %1, %8 offset:%10\n\tds_read_b64_tr_b16 %2, %8 offset:%11\n\tds_read_b64_tr_b16 %3, %8 offset:%12\n\t"
                 "ds_read_b64_tr_b16 %4, %8 offset:%13\n\tds_read_b64_tr_b16 %5, %8 offset:%14\n\tds_read_b64_tr_b16 %6, %8 offset:%15\n\tds_read_b64_tr_b16 %7, %8 offset:%16\n\ts_waitcnt lgkmcnt(0)"
                 : "=&v"(r[0]), "=&v"(r[1]), "=&v"(r[2]), "=&v"(r[3]), "=&v"(r[4]), "=&v"(r[5]), "=&v"(r[6]), "=&v"(r[7])
                 : "v"(a), "n"(0 * PITCH), "n"(4 * PITCH), "n"(32 * PITCH), "n"(36 * PITCH), "n"(64 * PITCH), "n"(68 * PITCH), "n"(96 * PITCH), "n"(100 * PITCH) : "memory");
#pragma unroll
    for (int ks = 0; ks < 4; ++ks) f[ks] = (bf16x8){(short)r[2 * ks][0], (short)r[2 * ks][1], (short)r[2 * ks][2], (short)r[2 * ks][3], (short)r[2 * ks + 1][0], (short)r[2 * ks + 1][1], (short)r[2 * ks + 1][2], (short)r[2 * ks + 1][3]};
}
struct SgPre { u32x4 x[2]; };
__device__ __forceinline__ void ssd_head_load(Frame& F, SgPre& P, int bc, int hd) {
    const int row0 = bc * 128, tid = F.tid; const bf16_t* XS = WSP(bf16_t, WS_XS);
#pragma unroll
    for (int k = 0; k < 2; ++k) { const int id = tid + 512 * k, r = id >> 3, c = id & 7; P.x[k] = *(const u32x4*)(XS + (size_t)(row0 + r) * DSSM + hd * 64 + 8 * c); }
}
__device__ __forceinline__ void ssd_group_unit(Frame& F, int bc, int g) {
    LAS float* SC = (LAS float*)(F.lds + SI_END);
    LAS bf16_t* Wl = (LAS bf16_t*)(F.lds + SI_W);
    const int row0 = bc * 128, w = F.wave, tid = F.tid, lane = F.lane, li = lane & 15, lq = lane >> 4;
    const unsigned ldsb = (unsigned)(size_t)F.lds;
    const unsigned tq = (unsigned)(8 * lq + (li >> 2)), tp = (unsigned)(4 * (li & 3));
    const bf16_t* BC = WSP(bf16_t, WS_BC);
    SgPre P; ssd_head_load(F, P, bc, 8 * g);
    { u32x4 bq[4];
#pragma unroll
      for (int k = 0; k < 4; ++k) { const int id = tid + 512 * k, r = id >> 4, c = id & 15; bq[k] = *(const u32x4*)(BC + (size_t)(row0 + r) * 1024 + g * 128 + 8 * c); }
      __syncthreads();
#pragma unroll
      for (int k = 0; k < 4; ++k) { const int id = tid + 512 * k, r = id >> 4, c = id & 15; *(LAS u32x4*)(F.lds + SI_B + r * 272 + 16 * c) = bq[k]; } }
    bf16x8 cf[4];
#pragma unroll
    for (int ks = 0; ks < 4; ++ks) cf[ks] = *(const bf16x8*)(BC + (size_t)(row0 + 16 * w + li) * 1024 + 512 + g * 128 + ks * 32 + 8 * lq);
    asm volatile("s_waitcnt lgkmcnt(0)" ::: "memory");
    __syncthreads();
    f32x4 Gr[8];
#pragma unroll
    for (int sb = 0; sb < 8; ++sb) { Gr[sb] = (f32x4){0.f, 0.f, 0.f, 0.f};
        if (sb <= w) {
#pragma unroll
            for (int ks = 0; ks < 4; ++ks) Gr[sb] = __builtin_amdgcn_mfma_f32_16x16x32_bf16(*(const LAS bf16x8*)(F.lds + SI_B + (16 * sb + li) * 272 + (ks * 32 + 8 * lq) * 2), cf[ks], Gr[sb], 0, 0, 0); } }
    { const int hdw = 8 * g + w; const float* DTA = WSP(float, WS_DTA);
      const float d0 = DTA[(size_t)(row0 + lane) * NH + hdw], d1 = DTA[(size_t)(row0 + 64 + lane) * NH + hdw];
      const float A = -__expf(F.in[20][hdw]);
      float a0 = d0 * A, a1 = d1 * A;
#pragma unroll
      for (int o = 1; o < 64; o <<= 1) { const float t0 = __shfl_up(a0, o), t1 = __shfl_up(a1, o); if (lane >= o) { a0 += t0; a1 += t1; } }
      a1 += __shfl(a0, 63);
      const float last = __shfl(a1, 63);
      LAS float* c = SC + w * 384;
      c[lane] = a0; c[64 + lane] = a1; c[128 + lane] = d0; c[192 + lane] = d1;
      c[256 + lane] = __expf(last - a0) * d0; c[320 + lane] = __expf(last - a1) * d1;
      float* CUM = WSP(float, WS_CUM);
      CUM[(size_t)(row0 + lane) * NH + hdw] = a0; CUM[(size_t)(row0 + 64 + lane) * NH + hdw] = a1;
      if (lane == 0) WSP(float, WS_DEC)[bc * NH + hdw] = __expf(last); }
    bf16x8 btr[4]; tr_frags<272>(ldsb + SI_B + tq * 272 + (16 * w + tp) * 2, btr);
#pragma unroll 1
    for (int hl = 0; hl < 8; ++hl) { const int hd = 8 * g + hl;
        const unsigned xb = (hl & 1) ? (unsigned)SI_X2 : (unsigned)SI_X;
#pragma unroll
        for (int k = 0; k < 2; ++k) { const int id = tid + 512 * k, r = id >> 3, c = id & 7; *(LAS u32x4*)(F.lds + xb + r * SI_XP + 16 * c) = P.x[k]; }
        LAS float* cumS = SC + hl * 384; LAS float* dtS = cumS + 128; LAS float* decS = cumS + 256;
        LDS_BARRIER();
        ssd_head_load(F, P, bc, hl < 7 ? hd + 1 : hd);
        bf16x8 xf[4][4];
#pragma unroll
        for (int pb = 0; pb < 4; ++pb) tr_frags<SI_XP>(ldsb + xb + tq * SI_XP + (pb * 16 + tp) * 2, xf[pb]);
        { const int t = 16 * w + li; const float cum_t = cumS[t];
#pragma unroll
          for (int sb = 0; sb < 8; ++sb) if (sb <= w) {
              const f32x4 cs = *(const LAS f32x4*)(cumS + 16 * sb + 4 * lq), ds = *(const LAS f32x4*)(dtS + 16 * sb + 4 * lq); float wv[4];
#pragma unroll
              for (int r = 0; r < 4; ++r) { const int s2 = 16 * sb + 4 * lq + r; wv[r] = (s2 <= t) ? Gr[sb][r] * __expf(cum_t - cs[r]) * ds[r] : 0.f; }
              u32x2 pw; pw.x = cvt_pk_bf16(wv[0], wv[1]); pw.y = cvt_pk_bf16(wv[2], wv[3]);
              *(LAS u32x2*)(Wl + t * 136 + 16 * sb + 4 * lq) = pw; }
          if ((w & 1) == 0) *(LAS u32x2*)(Wl + t * 136 + 16 * (w + 1) + 4 * lq) = (u32x2){0u, 0u}; }
        asm volatile("s_waitcnt lgkmcnt(0)" ::: "memory");
        { f32x4 ay[4];
#pragma unroll
          for (int pb = 0; pb < 4; ++pb) ay[pb] = (f32x4){0.f, 0.f, 0.f, 0.f};
          const int nks = (w >> 1) + 1;
#pragma unroll
          for (int ks = 0; ks < 4; ++ks) if (ks < nks) { const bf16x8 wf = *(const LAS bf16x8*)(Wl + (16 * w + li) * 136 + ks * 32 + 8 * lq);
#pragma unroll
              for (int pb = 0; pb < 4; ++pb) ay[pb] = __builtin_amdgcn_mfma_f32_16x16x32_bf16(xf[pb][ks], wf, ay[pb], 0, 0, 0); }
          bf16_t* YD = WSP(bf16_t, WS_YD) + (size_t)(row0 + 16 * w + li) * DSSM + hd * 64 + 4 * lq;
#pragma unroll
          for (int pb = 0; pb < 4; ++pb) { u32x2 o; o.x = cvt_pk_bf16(ay[pb][0], ay[pb][1]); o.y = cvt_pk_bf16(ay[pb][2], ay[pb][3]); *(u32x2*)(YD + pb * 16) = o; } }
        { bf16x8 bt[4];
#pragma unroll
          for (int ks = 0; ks < 4; ++ks) { const u32x4 raw = __builtin_bit_cast(u32x4, btr[ks]);
              const f32x4 d0 = *(const LAS f32x4*)(decS + ks * 32 + 8 * lq), d1 = *(const LAS f32x4*)(decS + ks * 32 + 8 * lq + 4);
              u32x4 sc; sc.x = cvt_pk_bf16(bf_lo(raw.x) * d0[0], bf_hi(raw.x) * d0[1]); sc.y = cvt_pk_bf16(bf_lo(raw.y) * d0[2], bf_hi(raw.y) * d0[3]);
              sc.z = cvt_pk_bf16(bf_lo(raw.z) * d1[0], bf_hi(raw.z) * d1[1]); sc.w = cvt_pk_bf16(bf_lo(raw.w) * d1[2], bf_hi(raw.w) * d1[3]);
              bt[ks] = __builtin_bit_cast(bf16x8, sc); }
          float* ST = WSP(float, WS_ST) + ((size_t)(bc * NH + hd) * 64 + li) * 128 + 16 * w + 4 * lq;
#pragma unroll
          for (int pb = 0; pb < 4; ++pb) { f32x4 as = (f32x4){0.f, 0.f, 0.f, 0.f};
#pragma unroll
              for (int ks = 0; ks < 4; ++ks) as = __builtin_amdgcn_mfma_f32_16x16x32_bf16(bt[ks], xf[pb][ks], as, 0, 0, 0);
              *(f32x4*)(ST + (size_t)pb * 16 * 128) = as; } }
    }
}
__device__ __forceinline__ void ssd_intra_all(Frame& F) {
    for (int u = blockIdx.x; u < NCH * NG; u += F.G) ssd_group_unit(F, u >> 2, u & 3);
    __syncthreads();
}
struct SsPre { f32x4 h0[4]; float dt[4]; bf16_t x[4]; };
struct SsBC { u32x2 bq[4][4], cq[4][4]; };
__device__ __forceinline__ void ssd_sample_load(Frame& F, SsPre& P, int s, int hd) {
    const int tid = F.tid, p = tid >> 3, nq = tid & 7, r0 = MP + 4 * s;
    const float* DTA = WSP(float, WS_DTA); const bf16_t* XS = WSP(bf16_t, WS_XS);
    const float* h0p = F.in[4] + (((size_t)s * NH + hd) * 64 + p) * 128 + 4 * nq;
#pragma unroll
    for (int j = 0; j < 4; ++j) P.h0[j] = __builtin_nontemporal_load((const f32x4*)(h0p + 32 * j));
#pragma unroll
    for (int t = 0; t < 4; ++t) { P.dt[t] = DTA[(size_t)(r0 + t) * NH + hd]; P.x[t] = XS[(size_t)(r0 + t) * DSSM + hd * 64 + p]; }
}
__device__ __forceinline__ void ssd_sample_loadbc(Frame& F, SsBC& Q, int s, int g) {
    const int nq = F.tid & 7, r0 = MP + 4 * s; const bf16_t* BC = WSP(bf16_t, WS_BC);
#pragma unroll
    for (int t = 0; t < 4; ++t) { const bf16_t* br = BC + (size_t)(r0 + t) * 1024 + g * 128 + 4 * nq;
#pragma unroll
        for (int j = 0; j < 4; ++j) { Q.bq[t][j] = *(const u32x2*)(br + 32 * j); Q.cq[t][j] = *(const u32x2*)(br + 512 + 32 * j); } }
}
__device__ __forceinline__ void ssd_sample_compute(Frame& F, const SsPre& P, const SsBC& Q, int s, int hd, const LAS float* scb, const LAS float* atab) {
    const int tid = F.tid, p = tid >> 3, nq = tid & 7, r0 = MP + 4 * s;
    const u32x2 (&bq)[4][4] = Q.bq; const u32x2 (&cq)[4][4] = Q.cq;
    const float A = atab[hd];
    float dt[4], cum[4], x[4]; float run = 0.f;
#pragma unroll
    for (int t = 0; t < 4; ++t) { dt[t] = P.dt[t]; run += dt[t] * A; cum[t] = run; x[t] = bf2f(P.x[t]); }
    float yoff[4];
#pragma unroll
    for (int t = 0; t < 4; ++t) { float a = 0.f;
#pragma unroll
        for (int j = 0; j < 4; ++j) a += (bf_lo(cq[t][j].x) * P.h0[j][0] + bf_hi(cq[t][j].x) * P.h0[j][1]) + (bf_lo(cq[t][j].y) * P.h0[j][2] + bf_hi(cq[t][j].y) * P.h0[j][3]);
        yoff[t] = a; }
#pragma unroll
    for (int o = 1; o < 8; o <<= 1) {
#pragma unroll
        for (int t = 0; t < 4; ++t) yoff[t] += __shfl_xor(yoff[t], o); }
    if (nq == 0) {
        float* YD = WSP(float, WS_YD);
#pragma unroll
        for (int t = 0; t < 4; ++t) { float y = __expf(cum[t]) * yoff[t];
#pragma unroll
            for (int s2 = 0; s2 < 4; ++s2) if (s2 <= t) y += scb[t * (t + 1) / 2 + s2] * __expf(cum[t] - cum[s2]) * dt[s2] * x[s2];
            YD[(size_t)(r0 + t) * DSSM + hd * 64 + p] = y; }
    }
    const float dec3 = __expf(cum[3]); float cx[4];
#pragma unroll
    for (int t = 0; t < 4; ++t) cx[t] = __expf(cum[3] - cum[t]) * dt[t] * x[t];
    float* hp = F.out + O_SSH + (((size_t)s * NH + hd) * 64 + p) * 128 + 4 * nq;
#pragma unroll
    for (int j = 0; j < 4; ++j) { f32x4 hn = P.h0[j] * dec3;
#pragma unroll
        for (int t = 0; t < 4; ++t) { hn[0] += bf_lo(bq[t][j].x) * cx[t]; hn[1] += bf_hi(bq[t][j].x) * cx[t]; hn[2] += bf_lo(bq[t][j].y) * cx[t]; hn[3] += bf_hi(bq[t][j].y) * cx[t]; }
        __builtin_nontemporal_store(hn, (f32x4*)(hp + 32 * j)); }
}
__device__ __forceinline__ void ssd_sample_all(Frame& F) {
    LAS float* atab = (LAS float*)F.lds;
    LAS float* scb = atab + 32;
    if (F.tid < NH) atab[F.tid] = -__expf(F.in[20][F.tid]);
    const bf16_t* BC = WSP(bf16_t, WS_BC);
    int start, count; const int c = blockIdx.x;
    if (F.G == 256) { if (c < 32) { count = 10; start = 10 * c; } else { const int i = c - 32; count = i < 192 ? 17 : 16; start = 320 + (i < 192 ? 17 * i : 17 * 192 + 16 * (i - 192)); } }
    else { const int per = (NSQ * NH + F.G - 1) / F.G; start = c * per; count = NSQ * NH - start; count = count < 0 ? 0 : (count > per ? per : count); }
    SsBC Q; int cur = -1;
#pragma unroll 1
    for (int b0 = 0; b0 < count; b0 += 32) { const int nb = count - b0 < 32 ? count - b0 : 32;
        __syncthreads();
        if (F.tid < nb * 10) { const int k = F.tid / 10, pr = F.tid % 10, u = start + b0 + k;
            const int t = pr < 1 ? 0 : pr < 3 ? 1 : pr < 6 ? 2 : 3, s2 = pr - t * (t + 1) / 2, r0 = MP + 4 * (u >> 5), g = (u & 31) >> 3;
            const bf16_t* cr = BC + (size_t)(r0 + t) * 1024 + 512 + g * 128; const bf16_t* br = BC + (size_t)(r0 + s2) * 1024 + g * 128; float a = 0.f;
#pragma unroll
            for (int q = 0; q < 16; ++q) { const u32x4 cv = *(const u32x4*)(cr + 8 * q), bv = *(const u32x4*)(br + 8 * q);
                a += (bf_lo(cv.x) * bf_lo(bv.x) + bf_hi(cv.x) * bf_hi(bv.x)) + (bf_lo(cv.y) * bf_lo(bv.y) + bf_hi(cv.y) * bf_hi(bv.y)) + (bf_lo(cv.z) * bf_lo(bv.z) + bf_hi(cv.z) * bf_hi(bv.z)) + (bf_lo(cv.w) * bf_lo(bv.w) + bf_hi(cv.w) * bf_hi(bv.w)); }
            scb[k * 16 + pr] = a; }
        __syncthreads();
        SsPre A, B; const int ub = start + b0, ulast = ub + nb - 1;
        ssd_sample_load(F, A, ub >> 5, ub & 31);
        FULL_FENCE();
#pragma unroll 1
        for (int k = 0; k < nb; k += 2) {
            const int u = ub + k, u1 = u + 1 < ulast ? u + 1 : ulast, u2 = u + 2 < ulast ? u + 2 : ulast;
            if ((u >> 3) != cur) { ssd_sample_loadbc(F, Q, u >> 5, (u & 31) >> 3); cur = u >> 3; }
            ssd_sample_load(F, B, u1 >> 5, u1 & 31);
            FULL_FENCE();
            ssd_sample_compute(F, A, Q, u >> 5, u & 31, scb + k * 16, atab);
            FULL_FENCE();
            if (k + 1 < nb) { if ((u1 >> 3) != cur) { ssd_sample_loadbc(F, Q, u1 >> 5, (u1 & 31) >> 3); cur = u1 >> 3; }
                ssd_sample_load(F, A, u2 >> 5, u2 & 31);
                FULL_FENCE();
                ssd_sample_compute(F, B, Q, u1 >> 5, u1 & 31, scb + (k + 1) * 16, atab);
                FULL_FENCE(); }
        }
    }
}
__device__ __forceinline__ void p4_scan(Frame& F) {
    const unsigned* AB = WSP(unsigned, WS_AB); const bf16_t* G2 = WSP(bf16_t, WS_G2); bf16_t* CAT = WSP(bf16_t, WS_CAT); float* SSQ = WSP(float, WS_SSQRG);
    LAS f32x2* carr = (LAS f32x2*)F.lds;
    for (int u = blockIdx.x; u < NB * 64; u += F.G) {
        const int b = u >> 6, slab = u & 63, cl = F.tid & 31, seg = F.tid >> 5, ch = slab * 32 + cl, rowb = b * SEQ + seg * 128;
        float Ap = 1.f, hl = 0.f;
#pragma unroll 1
        for (int tt = 0; tt < 128; tt += 32) { unsigned v[32];
#pragma unroll
            for (int k = 0; k < 32; ++k) v[k] = AB[(size_t)(rowb + tt + k) * DRNN + ch];
#pragma unroll
            for (int k = 0; k < 32; ++k) { const float a = 1.0f - bf_lo(v[k]); Ap *= a; hl = a * hl + bf_hi(v[k]); } }
        __syncthreads();
        carr[seg * 32 + cl] = (f32x2){Ap, hl};
        __syncthreads();
        float h = 0.f;
        for (int s2 = 0; s2 < seg; ++s2) { const f32x2 c = carr[s2 * 32 + cl]; h = c[0] * h + c[1]; }
#pragma unroll 1
        for (int tt = 0; tt < 128; tt += 32) { unsigned v[32]; float gt[32];
#pragma unroll
            for (int k = 0; k < 32; ++k) { v[k] = AB[(size_t)(rowb + tt + k) * DRNN + ch]; gt[k] = bf2f(G2[(size_t)(rowb + tt + k) * 4096 + ch]); }
            float q[32];
#pragma unroll
            for (int k = 0; k < 32; ++k) { h = (1.0f - bf_lo(v[k])) * h + bf_hi(v[k]); const float o = h * gt[k];
                CAT[(size_t)(rowb + tt + k) * DM + ch] = (bf16_t)(cvt_pk_bf16(o, 0.f) & 0xffffu); q[k] = o * o; }
#define SCAN_BFLY(HB) do { const bool up = (cl & (HB)) != 0; _Pragma("unroll") for (int k = 0; k < (HB); ++k) { const float send = up ? q[k] : q[k + (HB)], keep = up ? q[k + (HB)] : q[k]; q[k] = keep + __shfl_xor(send, (HB)); } } while (0)
            SCAN_BFLY(16); SCAN_BFLY(8); SCAN_BFLY(4); SCAN_BFLY(2); SCAN_BFLY(1);
#undef SCAN_BFLY
            SSQ[(size_t)(rowb + tt + cl) * 64 + slab] = q[0]; }
        if (seg == 15) F.out[O_PRGH + (size_t)b * DRNN + ch] = h;
    }
    { const size_t gt = (size_t)blockIdx.x * 512 + F.tid, NT = (size_t)F.G * 512;
      for (size_t it = gt; it < (size_t)NSQ * DRNN; it += NT) { const int s = (int)(it >> 11), ch = (int)(it & 2047); float h = F.in[2][it];
#pragma unroll
          for (int t = 0; t < 4; ++t) { const int row = MP + 4 * s + t; const unsigned v = AB[(size_t)row * DRNN + ch]; h = (1.0f - bf_lo(v)) * h + bf_hi(v);
              const float o = h * bf2f(G2[(size_t)row * 4096 + ch]); CAT[(size_t)row * DM + ch] = (bf16_t)(cvt_pk_bf16(o, 0.f) & 0xffffu);
              const float q = wave_sum(o * o);
              if (F.lane == 0) { SSQ[(size_t)row * 64 + 2 * (ch >> 6)] = q; SSQ[(size_t)row * 64 + 2 * (ch >> 6) + 1] = 0.f; } }
          F.out[O_SRGH + it] = h; } }
    { const float* ST = WSP(float, WS_ST); const float* DEC = WSP(float, WS_DEC); bf16_t* HPB = WSP(bf16_t, WS_HPB);
      const size_t gt = (size_t)blockIdx.x * 512 + F.tid, NT = (size_t)F.G * 512;
      for (size_t it = gt; it < (size_t)NB * NH * 64 * 32; it += NT) { const int b = (int)(it >> 16), rem = (int)(it & 65535), hd = rem >> 11, e = rem & 2047;
          f32x4 h = (f32x4){0.f, 0.f, 0.f, 0.f}; f32x4 stv[16]; float dcv[16];
#pragma unroll
          for (int c = 0; c < 16; ++c) { const int bc = b * 16 + c; stv[c] = __builtin_nontemporal_load((const f32x4*)(ST + ((size_t)(bc * NH + hd) * 8192) + 4 * e)); dcv[c] = DEC[bc * NH + hd]; }
#pragma unroll
          for (int c = 0; c < 16; ++c) { const int bc = b * 16 + c; const size_t o = ((size_t)(bc * NH + hd) * 8192) + 4 * e;
              u32x2 w; w.x = cvt_pk_bf16(h[0], h[1]); w.y = cvt_pk_bf16(h[2], h[3]); *(u32x2*)(HPB + o) = w;
              h = h * dcv[c] + stv[c]; }
          *(f32x4*)(F.out + O_PSH + ((size_t)(b * NH + hd) * 8192) + 4 * e) = h; } }
}

constexpr int P5_HT_OFF = 8 * 16640;
static_assert(P5_HT_OFF + 64 * 272 <= LDSCTL_OFF, "P5 LDS map");
__device__ __forceinline__ void p5_unit(Frame& F, int g, int bc) {
    const int w = F.wave, lane = F.lane, li = lane & 15, lq = lane >> 4, row0 = bc * 128, row = row0 + 16 * w + li;
    const bf16_t* BC = WSP(bf16_t, WS_BC); bf16_t* CAT = WSP(bf16_t, WS_CAT);
    LAS unsigned char* U = F.lds + w * 16640;
    bf16x8 cf[4];
#pragma unroll
    for (int ks = 0; ks < 4; ++ks) cf[ks] = *(const bf16x8*)(BC + (size_t)row * 1024 + 512 + g * 128 + ks * 32 + 8 * lq);
    float ss = 0.f;
    const bf16_t* HPB = WSP(bf16_t, WS_HPB); const bf16_t* XS = WSP(bf16_t, WS_XS); const bf16_t* YD = WSP(bf16_t, WS_YD); const float* CUM = WSP(float, WS_CUM); const bf16_t* G2 = WSP(bf16_t, WS_G2);
    LAS unsigned char* HT = F.lds + P5_HT_OFF;
    u32x4 hq[2];
#pragma unroll
    for (int k = 0; k < 2; ++k) { const int id = F.tid + 512 * k; hq[k] = *(const u32x4*)(HPB + (size_t)(bc * NH + 8 * g) * 8192 + (id >> 4) * 128 + 8 * (id & 15)); }
#pragma unroll 1
    for (int hl = 0; hl < 8; ++hl) { const int hd = 8 * g + hl;
        LDS_BARRIER();
#pragma unroll
        for (int k = 0; k < 2; ++k) { const int id = F.tid + 512 * k; *(LAS u32x4*)(HT + (id >> 4) * 272 + 16 * (id & 15)) = hq[k]; }
        u32x2 yw[4], zw[4], xw[4];
        const float ecr = CUM[(size_t)row * NH + hd], Dh = F.in[21][hd];
#pragma unroll
        for (int pb = 0; pb < 4; ++pb) { const int ch = hd * 64 + pb * 16 + 4 * lq;
            yw[pb] = __builtin_nontemporal_load((const u32x2*)(YD + (size_t)row * DSSM + ch)); zw[pb] = *(const u32x2*)(G2 + (size_t)row * 4096 + 2048 + ch); xw[pb] = *(const u32x2*)(XS + (size_t)row * DSSM + ch); }
        { const int hn = hl < 7 ? hd + 1 : hd;
#pragma unroll
          for (int k = 0; k < 2; ++k) { const int id = F.tid + 512 * k; hq[k] = *(const u32x4*)(HPB + (size_t)(bc * NH + hn) * 8192 + (id >> 4) * 128 + 8 * (id & 15)); } }
        LDS_BARRIER();
        const float ec = __expf(ecr);
#pragma unroll
        for (int pb = 0; pb < 4; ++pb) { f32x4 a = (f32x4){0.f, 0.f, 0.f, 0.f};
#pragma unroll
            for (int ks = 0; ks < 4; ++ks) a = __builtin_amdgcn_mfma_f32_16x16x32_bf16(*(const LAS bf16x8*)(HT + (pb * 16 + li) * 272 + (ks * 32 + 8 * lq) * 2), cf[ks], a, 0, 0, 0);
            const float xv[4] = {bf_lo(xw[pb].x), bf_hi(xw[pb].x), bf_lo(xw[pb].y), bf_hi(xw[pb].y)}; const float zv[4] = {bf_lo(zw[pb].x), bf_hi(zw[pb].x), bf_lo(zw[pb].y), bf_hi(zw[pb].y)}; float v[4];
            const float yv[4] = {bf_lo(yw[pb].x), bf_hi(yw[pb].x), bf_lo(yw[pb].y), bf_hi(yw[pb].y)};
#pragma unroll
            for (int r = 0; r < 4; ++r) { const float y = yv[r] + ec * a[r] + Dh * xv[r]; v[r] = y * zv[r]; ss += v[r] * v[r]; }
            u32x2 o; o.x = cvt_pk_bf16(v[0], v[1]); o.y = cvt_pk_bf16(v[2], v[3]);
            *(LAS u32x2*)(U + li * 1040 + (hl * 64 + pb * 16 + 4 * lq) * 2) = o; }
    }
    ss += __shfl_xor(ss, 16); ss += __shfl_xor(ss, 32);
    const float rs = rsqrtf(ss * (1.0f / 512.0f) + EPS);
    asm volatile("s_waitcnt lgkmcnt(0)" ::: "memory");
#pragma unroll 4
    for (int j = 0; j < 16; ++j) { const float rj = __shfl(rs, j); u32x4 v = *(const LAS u32x4*)(U + j * 1040 + lane * 16);
        v.x = cvt_pk_bf16(bf_lo(v.x) * rj, bf_hi(v.x) * rj); v.y = cvt_pk_bf16(bf_lo(v.y) * rj, bf_hi(v.y) * rj); v.z = cvt_pk_bf16(bf_lo(v.z) * rj, bf_hi(v.z) * rj); v.w = cvt_pk_bf16(bf_lo(v.w) * rj, bf_hi(v.w) * rj);
        *(u32x4*)(CAT + (size_t)(row0 + 16 * w + j) * DM + DRNN + g * 512 + lane * 8) = v; }
    asm volatile("s_waitcnt lgkmcnt(0)" ::: "memory");
}
__device__ __forceinline__ void p5_norms(Frame& F, bool rg_rows) {
    const int gw = F.wave * F.G + blockIdx.x, NGW = F.G * 8;
    if (rg_rows && gw < M) { const float* SSQ = WSP(float, WS_SSQRG); bf16_t* CAT = WSP(bf16_t, WS_CAT);
      const int rlast = gw + ((M - 1 - gw) / NGW) * NGW;
      float qa, qb; u32x4 ca[4], cb[4];
#define P5_RG_LOAD(q_, c_, r_) do { q_ = SSQ[(size_t)(r_) * 64 + F.lane]; _Pragma("unroll") for (int j = 0; j < 4; ++j) c_[j] = *(const u32x4*)(CAT + (size_t)(r_) * DM + 8 * (F.lane + 64 * j)); } while (0)
#define P5_RG_FIN(q_, c_, r_) do { const float rs = rsqrtf(wave_sum(q_) * (1.0f / DRNN) + EPS); _Pragma("unroll") for (int j = 0; j < 4; ++j) { u32x4 v = c_[j]; \
          v.x = cvt_pk_bf16(bf_lo(v.x) * rs, bf_hi(v.x) * rs); v.y = cvt_pk_bf16(bf_lo(v.y) * rs, bf_hi(v.y) * rs); v.z = cvt_pk_bf16(bf_lo(v.z) * rs, bf_hi(v.z) * rs); v.w = cvt_pk_bf16(bf_lo(v.w) * rs, bf_hi(v.w) * rs); \
          *(u32x4*)(CAT + (size_t)(r_) * DM + 8 * (F.lane + 64 * j)) = v; } } while (0)
      P5_RG_LOAD(qa, ca, gw);
#pragma unroll 1
      for (int row = gw; row <= rlast; row += 2 * NGW) {
          const int r1 = row + NGW < rlast ? row + NGW : rlast, r2 = row + 2 * NGW < rlast ? row + 2 * NGW : rlast;
          const bool two = row + NGW <= rlast;
          P5_RG_LOAD(qb, cb, r1);
          FULL_FENCE();
          P5_RG_FIN(qa, ca, row); FULL_FENCE();
          if (two) { P5_RG_LOAD(qa, ca, r2); FULL_FENCE(); P5_RG_FIN(qb, cb, r1); FULL_FENCE(); }
      }
#undef P5_RG_LOAD
#undef P5_RG_FIN
    }
    { const float* YD = WSP(float, WS_YD); const bf16_t* G2 = WSP(bf16_t, WS_G2); const bf16_t* XS = WSP(bf16_t, WS_XS); bf16_t* CAT = WSP(bf16_t, WS_CAT);
      for (int it = gw; it < MS * NG; it += NGW) { const int row = MP + (it >> 2), g = it & 3, ch = g * 512 + 8 * F.lane; const float Dh = F.in[21][ch >> 6];
          const f32x4 y0 = *(const f32x4*)(YD + (size_t)row * DSSM + ch), y1 = *(const f32x4*)(YD + (size_t)row * DSSM + ch + 4);
          const f32x4 z0 = ld_bf4(G2 + (size_t)row * 4096 + 2048 + ch), z1 = ld_bf4(G2 + (size_t)row * 4096 + 2048 + ch + 4);
          const u32x4 xw = *(const u32x4*)(XS + (size_t)row * DSSM + ch);
          const float xv[8] = {bf_lo(xw.x), bf_hi(xw.x), bf_lo(xw.y), bf_hi(xw.y), bf_lo(xw.z), bf_hi(xw.z), bf_lo(xw.w), bf_hi(xw.w)};
          float v[8]; float ss = 0.f;
#pragma unroll
          for (int e = 0; e < 8; ++e) { const float y = (e < 4 ? y0[e & 3] : y1[e & 3]) + Dh * xv[e]; const float z = e < 4 ? z0[e & 3] : z1[e & 3]; v[e] = y * z; ss += v[e] * v[e]; }
          const float rs = rsqrtf(wave_sum(ss) * (1.0f / 512.0f) + EPS);
          u32x4 o; o.x = cvt_pk_bf16(v[0] * rs, v[1] * rs); o.y = cvt_pk_bf16(v[2] * rs, v[3] * rs); o.z = cvt_pk_bf16(v[4] * rs, v[5] * rs); o.w = cvt_pk_bf16(v[6] * rs, v[7] * rs);
          *(u32x4*)(CAT + (size_t)row * DM + DRNN + ch) = o; } }
    for (int u = blockIdx.x; u < NCH * NG; u += F.G) p5_unit(F, u & 3, u >> 2);
}

constexpr int G3_BUSY = ((M / 256) * (2 * DFF / 256)) % 256;
static_assert(G3_BUSY > 0 && G3_BUSY < 256, "up GEMM tail");
constexpr int REM_FIRST = 512, REM_N = 32;
__device__ __forceinline__ void rem_table(Frame& F, LAS signed char* rem) {
    for (int i = F.tid; i < (M / 256) * 16; i += 512) rem[i] = -1;
    __syncthreads();
    if (F.G == 256 && F.tid < REM_N) { pg8::StaticOrder S; S.init(M, DM, F.G, 0); pg8::Unit u; S.tile_of(REM_FIRST + F.tid, u); rem[u.pm * 16 + u.pn] = (signed char)F.tid; }
    __syncthreads();
}
__device__ __forceinline__ void p7_row_load(const bf16_t* X1, int row, int lane, u32x2 (&w)[16]) {
#pragma unroll
    for (int j = 0; j < 16; ++j) w[j] = *(const u32x2*)(X1 + (size_t)row * DM + 256 * j + 4 * lane);
}
__device__ __forceinline__ void p7_row_finish(Frame& F, const LAS signed char* rem, int row, const u32x2 (&w)[16]) {
    const bf16_t* PART = WSP(bf16_t, WS_PART); bf16_t* X1 = WSP(bf16_t, WS_X1); unsigned char* X1Q = WSP(unsigned char, WS_X1B); float* RF3 = WSP(float, WS_RF3);
    bf16_t* xr = X1 + (size_t)row * DM; const float* xin = (row < MP ? F.in[0] + (size_t)row * DM : F.in[1] + (size_t)(row - MP) * DM);
    f32x4 v[16]; float ss = 0.f, mx = 0.f;
#pragma unroll
    for (int j = 0; j < 16; ++j) { const int c = 256 * j + 4 * F.lane; const int tl = rem[(row >> 8) * 16 + j];
        if (tl < 0) v[j] = (f32x4){bf_lo(w[j].x), bf_hi(w[j].x), bf_lo(w[j].y), bf_hi(w[j].y)};
        else { f32x4 a = *(const f32x4*)(xin + c);
#pragma unroll
            for (int ks = 0; ks < 8; ++ks) a += ld_bf4(PART + ((size_t)(tl * 8 + ks) << 16) + (row & 255) * 256 + 4 * F.lane);
            u32x2 q; q.x = cvt_pk_bf16(a[0], a[1]); q.y = cvt_pk_bf16(a[2], a[3]); *(u32x2*)(xr + c) = q;
            v[j] = (f32x4){bf_lo(q.x), bf_hi(q.x), bf_lo(q.y), bf_hi(q.y)}; }
        ss += (v[j][0] * v[j][0] + v[j][1] * v[j][1]) + (v[j][2] * v[j][2] + v[j][3] * v[j][3]);
        mx = fmaxf(mx, fmaxf(fmaxf(fabsf(v[j][0]), fabsf(v[j][1])), fmaxf(fabsf(v[j][2]), fabsf(v[j][3])))); }
    ss = wave_sum(ss);
#pragma unroll
    for (int o = 1; o < 64; o <<= 1) mx = fmaxf(mx, __shfl_xor(mx, o));
    mx = fmaxf(mx, 1e-30f);
    if (F.lane == 0) RF3[row] = rsqrtf(ss * (1.0f / DM) + EPS) * mx * (1.0f / 127.0f);
    const float inv = 127.0f / mx;
#pragma unroll
    for (int j = 0; j < 16; ++j) *(unsigned*)(X1Q + (size_t)row * DM + 256 * j + 4 * F.lane) = q8_pack4(v[j][0], v[j][1], v[j][2], v[j][3], inv);
}
__device__ __forceinline__ void p7_x1_rows(Frame& F) {
    LAS signed char* rem = (LAS signed char*)F.lds; rem_table(F, rem);
    const bf16_t* X1 = WSP(bf16_t, WS_X1);
    const int gw = F.wave * F.G + blockIdx.x, NGW = F.G * 8;
    if (gw >= M) return;
    const int rlast = gw + ((M - 1 - gw) / NGW) * NGW;
    u32x2 wa[16], wb[16];
    p7_row_load(X1, gw, F.lane, wa);
#pragma unroll 1
    for (int row = gw; row <= rlast; row += 2 * NGW) {
        const int r1 = row + NGW < rlast ? row + NGW : rlast, r2 = row + 2 * NGW < rlast ? row + 2 * NGW : rlast;
        p7_row_load(X1, r1, F.lane, wb); FULL_FENCE();
        p7_row_finish(F, rem, row, wa); FULL_FENCE();
        if (row + NGW <= rlast) { p7_row_load(X1, r2, F.lane, wa); FULL_FENCE(); p7_row_finish(F, rem, r1, wb); FULL_FENCE(); }
    }
}
__device__ __forceinline__ void pf_row_finish(Frame& F, const LAS signed char* rem, int row, const u32x2 (&w)[16], const f32x4 (&gfv)[16]) {
    const bf16_t* PART = WSP(bf16_t, WS_PART); const bf16_t* X1 = WSP(bf16_t, WS_X1);
    float* o = F.out + (size_t)row * DM; f32x4 v[16]; float ss = 0.f;
#pragma unroll
    for (int j = 0; j < 16; ++j) { const int c = 256 * j + 4 * F.lane; const int tl = rem[(row >> 8) * 16 + j];
        if (tl < 0) v[j] = (f32x4){bf_lo(w[j].x), bf_hi(w[j].x), bf_lo(w[j].y), bf_hi(w[j].y)};
        else { f32x4 a = ld_bf4(X1 + (size_t)row * DM + c);
#pragma unroll
            for (int ks = 0; ks < 8; ++ks) a += ld_bf4(PART + ((size_t)(tl * 8 + ks) << 16) + (row & 255) * 256 + 4 * F.lane);
            v[j] = a; }
        ss += (v[j][0] * v[j][0] + v[j][1] * v[j][1]) + (v[j][2] * v[j][2] + v[j][3] * v[j][3]); }
    const float rs = rsqrtf(wave_sum(ss) * (1.0f / DM) + EPS);
#pragma unroll
    for (int j = 0; j < 16; ++j) *(f32x4*)(o + 256 * j + 4 * F.lane) = v[j] * rs * gfv[j];
}
__device__ __forceinline__ void p_final(Frame& F) {
    LAS signed char* rem = (LAS signed char*)F.lds; rem_table(F, rem);
    const bf16_t* X2B = WSP(bf16_t, WS_X2B); const float* gf = F.in[29];
    const int gw = F.wave * F.G + blockIdx.x, NGW = F.G * 8;
    if (gw >= M) return;
    f32x4 gfv[16];
#pragma unroll
    for (int j = 0; j < 16; ++j) gfv[j] = *(const f32x4*)(gf + 256 * j + 4 * F.lane);
    const int rlast = gw + ((M - 1 - gw) / NGW) * NGW;
    u32x2 wa[16], wb[16];
    p7_row_load(X2B, gw, F.lane, wa);
#pragma unroll 1
    for (int row = gw; row <= rlast; row += 2 * NGW) {
        const int r1 = row + NGW < rlast ? row + NGW : rlast, r2 = row + 2 * NGW < rlast ? row + 2 * NGW : rlast;
        p7_row_load(X2B, r1, F.lane, wb); FULL_FENCE();
        pf_row_finish(F, rem, row, wa, gfv); FULL_FENCE();
        if (row + NGW <= rlast) { p7_row_load(X2B, r2, F.lane, wa); FULL_FENCE(); pf_row_finish(F, rem, r1, wb, gfv); FULL_FENCE(); }
    }
}

constexpr int NPH = 12;
__global__ void __launch_bounds__(512, 2) mk_fwd(Args args) {
    extern __shared__ __attribute__((aligned(16))) unsigned char lds_raw[];
    Frame F;
    F.lds = (LAS unsigned char*)lds_raw; F.tid = threadIdx.x; F.lane = F.tid & 63; F.wave = __builtin_amdgcn_readfirstlane(F.tid >> 6); F.G = gridDim.x;
#pragma unroll
    for (int i = 0; i < 30; ++i) F.in[i] = args.in[i];
    F.out = args.out; F.ws = args.ws;
    volatile LAS unsigned* MISC = (volatile LAS unsigned*)(F.lds + LDSCTL_OFF);
    if (F.tid < 64) MISC[F.tid] = 0u;
    __syncthreads();
    unsigned* ctl = (unsigned*)(F.ws + WS_CTL);
    XcdBarrier bar = xcd_barrier_post(ctl + CW_BAR + args.li * XCD_BAR_WORDS, MISC + 8);
    const int lo = args.ph_lo, hi = args.ph_hi;
#ifndef PH_MASK
#define PH_MASK 0xfff
#endif
#define IN(k) (((PH_MASK >> (k)) & 1) && lo <= (k) && (k) < hi)
#define SEAM(k) do { if (IN(k) && IN((k) + 1)) xcd_barrier(bar); } while (0)

    if (IN(0)) { p0_prologue(F); } SEAM(0);
    if (IN(1)) {
        const bool roles = (F.G == 256);
        const int x = (int)blockIdx.x & 7, j = (int)blockIdx.x >> 3; const bool is_gemm = !roles || j < G1_PER + (x < G1_HI ? 1 : 0);
        if (!is_gemm) { const int sidx = (j == G1_PER) ? x - G1_HI : (8 - G1_HI) + (j - G1_PER - 1) * 8 + x; p0_late_weights(F, sidx * 8 + F.wave, NSTREAM * 8); }
        else { pg8::Gemm g{WSP(bf16_t, WS_XB), WSP(bf16_t, WS_BT1), M, N1P, DM, DM, DM}; pg8::StaticOrder S0; S0.init(M, N1P, roles ? NGEMM1 : F.G, (int)blockIdx.x);
            pg8::ChunkOrder S{S0, roles ? G1_PER : ((F.G & 7) == 0 ? F.G >> 3 : 0), roles ? G1_HI : 0};
            EpiProjConv E{F.ws, F.out, F.in[9], F.in[10], F.in[17], F.in[18], F.in[19], F.in[3], F.in[5], (LAS float*)(F.lds + RING_BYTES)};
            pg8::gemm_phase<EpiProjConv, pg8::GeomPlain, pg8::ChunkOrder, true>(F.lds, g, S, E); } } SEAM(1);
    if (IN(3)) {
#ifndef P3_REP
#define P3_REP 0
#endif
        const bool sample_first = (((int)blockIdx.x >> 3) & 1) != 0;
        if (sample_first) { ssd_sample_all(F); __syncthreads(); }
        { pg8::Gemm g{WSP(bf16_t, WS_XCB), WSP(bf16_t, WS_BTG), M, 16 * 256, 256, DRNN, 256}; pg8::StaticOrder S; S.init(M, 16 * 256, F.G, (int)blockIdx.x);
          EpiGates E{WSP(unsigned, WS_AB), WSP(bf16_t, WS_XCB), F.in[12], F.in[14], WSP(float, WS_SP8)};
          pg8::gemm_phase<EpiGates, pg8::GeomGates, pg8::StaticOrder, true>(F.lds, g, S, E);
          if (P3_REP == 1) { pg8::gemm_phase<EpiGates, pg8::GeomGates, pg8::StaticOrder, true>(F.lds, g, S, E); pg8::gemm_phase<EpiGates, pg8::GeomGates, pg8::StaticOrder, true>(F.lds, g, S, E); pg8::gemm_phase<EpiGates, pg8::GeomGates, pg8::StaticOrder, true>(F.lds, g, S, E); }
        }
        ssd_intra_all(F);
        if (P3_REP == 2) { ssd_intra_all(F); ssd_intra_all(F); ssd_intra_all(F); }
        if (!sample_first) ssd_sample_all(F);
        if (P3_REP == 3) { ssd_sample_all(F); ssd_sample_all(F); ssd_sample_all(F); }
    } SEAM(3);
    if (IN(4)) { p4_scan(F); } SEAM(4);
    if (IN(5)) {
        rotq_rows_i8<2>(WSP(bf16_t, WS_BT2), WSP(unsigned char, WS_BT2Q), WSP(float, WS_SW2), DM, F.wave * F.G + (int)blockIdx.x, F.G * 8, F.lane);
        p5_norms(F, false);
        xcd_barrier(bar);
        rotq_rows_i8<2, true>(WSP(bf16_t, WS_CAT), WSP(unsigned char, WS_CATQ), WSP(float, WS_SA2), M, F.wave * F.G + (int)blockIdx.x, F.G * 8, F.lane, WSP(float, WS_SSQRG)); } SEAM(5);
    if (IN(6)) { pg8::Gemm g{WSP(bf16_t, WS_CATQ), WSP(bf16_t, WS_BT2Q), M, DM, DM / 2, DM / 2, DM / 2}; pg8::StaticOrder S; S.init(M, DM, F.G, (int)blockIdx.x);
        const bool split = (F.G == 256); if (split) S.limit = REM_FIRST;
        EpiX1Q E{F.in[0], F.in[1], WSP(bf16_t, WS_X1), WSP(float, WS_SA2), WSP(float, WS_SW2)};
        pg8::gemm_phase<EpiX1Q, pg8::GeomPlain, pg8::StaticOrder, true, true>(F.lds, g, S, E);
        if (split) { pg8::Gemm g2{WSP(bf16_t, WS_CATQ), WSP(bf16_t, WS_BT2Q), M, DM, DM / 16, DM / 2, DM / 2}; pg8::SplitOrder S2{S, REM_FIRST, REM_N, (int)blockIdx.x}; EpiPartQ E2{WSP(bf16_t, WS_PART), WSP(float, WS_SA2), WSP(float, WS_SW2)};
            pg8::gemm_phase<EpiPartQ, pg8::GeomSplit, pg8::SplitOrder, true, true>(F.lds, g2, S2, E2); } } SEAM(6);
    if (IN(7)) { p7_x1_rows(F);
        quant_rows_i8(WSP(bf16_t, WS_BT3), WSP(unsigned char, WS_BT3Q), ctl + CW_CMAX3, 2 * DFF, DM, (size_t)blockIdx.x * 512 + F.tid, (size_t)F.G * 512);
        if (F.G != 256) rotq_rows_i8(WSP(bf16_t, WS_BT4), WSP(unsigned char, WS_BT4Q), WSP(float, WS_SW4), DM, blockIdx.x * 8 + F.wave, F.G * 8, F.lane); } SEAM(7);
    if (IN(8)) { pg8::Gemm g{WSP(bf16_t, WS_X1B), WSP(bf16_t, WS_BT3Q), M, 2 * DFF, DM / 2, DM / 2, DM / 2}; pg8::StaticOrder S; S.init(M, 2 * DFF, F.G, (int)blockIdx.x);
        EpiUpConv E{WSP(bf16_t, WS_ACT), WSP(float, WS_RF3), ctl + CW_CMAX3, F.out, F.in[26], F.in[27], F.in[6], (LAS float*)(F.lds + RING_BYTES), WSP(unsigned long long, WS_HALO), ctl + CW_HFLAG, ctl + CW_TMO};
        pg8::gemm_phase<EpiUpConv, pg8::GeomPlain, pg8::StaticOrder, true, true>(F.lds, g, S, E);
        if (F.G == 256 && blockIdx.x >= G3_BUSY) rotq_rows_i8(WSP(bf16_t, WS_BT4), WSP(unsigned char, WS_BT4Q), WSP(float, WS_SW4), DM, ((int)blockIdx.x - G3_BUSY) * 8 + F.wave, (256 - G3_BUSY) * 8, F.lane); } SEAM(8);
    if (IN(9)) { rotq_rows_i8(WSP(bf16_t, WS_ACT), WSP(unsigned char, WS_ACTQ), WSP(float, WS_SA4), M, F.wave * F.G + (int)blockIdx.x, F.G * 8, F.lane); } SEAM(9);
    if (IN(10)) { pg8::Gemm g{WSP(bf16_t, WS_ACTQ), WSP(bf16_t, WS_BT4Q), M, DM, DFF / 2, DFF / 2, DFF / 2}; pg8::StaticOrder S; S.init(M, DM, F.G, (int)blockIdx.x);
        const bool split = (F.G == 256); if (split) S.limit = REM_FIRST;
        EpiX2 E{WSP(bf16_t, WS_X1), WSP(bf16_t, WS_X2B), WSP(float, WS_SA4), WSP(float, WS_SW4)};
        pg8::gemm_phase<EpiX2, pg8::GeomPlain, pg8::StaticOrder, true, true>(F.lds, g, S, E);
        if (split) { pg8::Gemm g2{WSP(bf16_t, WS_ACTQ), WSP(bf16_t, WS_BT4Q), M, DM, DFF / 16, DFF / 2, DFF / 2}; pg8::SplitOrder S2{S, REM_FIRST, REM_N, (int)blockIdx.x}; EpiPartQ E2{WSP(bf16_t, WS_PART), WSP(float, WS_SA4), WSP(float, WS_SW4)};
            pg8::gemm_phase<EpiPartQ, pg8::GeomSplit, pg8::SplitOrder, true, true>(F.lds, g2, S2, E2); } } SEAM(10);
    if (IN(11)) { p_final(F); }
#undef IN
#undef SEAM
}

extern "C" void kernel_launch(void* const* d_in, const int* in_sizes, int n_in, void* d_out, int out_size, void* d_ws, size_t ws_size, hipStream_t stream) {
    static int grid = 0;
    if (grid == 0) {
        if (n_in != 30 || (size_t)out_size != O_END || ws_size < WS_END) { fprintf(stderr, "kernel_launch: unexpected shapes (n_in %d out %d ws %zu need %zu)\n", n_in, out_size, ws_size, (size_t)WS_END); grid = -1; return; }
        int dev = 0, cus = 0, per_cu = 0;
        if (hipGetDevice(&dev) != hipSuccess || hipDeviceGetAttribute(&cus, hipDeviceAttributeMultiprocessorCount, dev) != hipSuccess) { grid = -1; return; }
        if (hipFuncSetAttribute((const void*)mk_fwd, hipFuncAttributeMaxDynamicSharedMemorySize, LDS_BYTES) != hipSuccess) { fprintf(stderr, "kernel_launch: hipFuncSetAttribute failed\n"); grid = -1; return; }
        if (hipOccupancyMaxActiveBlocksPerMultiprocessor(&per_cu, (const void*)mk_fwd, 512, LDS_BYTES) != hipSuccess || per_cu < 1) { fprintf(stderr, "kernel_launch: occupancy query says %d\n", per_cu); }
        (void)hipGetLastError();
        grid = cus;
    }
    if (grid < 0) return;
    (void)hipMemsetAsync((char*)d_ws + WS_CTL, 0, CTL_BYTES, stream);
    Args a{};
    for (int i = 0; i < 30; ++i) a.in[i] = (const float*)d_in[i];
    a.out = (float*)d_out; a.ws = (unsigned char*)d_ws;
#if PROBE_HI > PROBE_LO
    { const int cuts[5][3] = {{0, PROBE_HI, 0}, {PROBE_LO, PROBE_HI, 1}, {PROBE_LO, PROBE_HI, 1}, {PROBE_LO, PROBE_HI, 1}, {PROBE_HI, NPH, 0}};
      for (int li = 0; li < 5; ++li) { if (cuts[li][0] >= cuts[li][1]) continue; a.ph_lo = cuts[li][0]; a.ph_hi = cuts[li][1]; a.li = li; a.rep = cuts[li][2];
          hipLaunchKernelGGL(mk_fwd, dim3(grid), dim3(512), LDS_BYTES, stream, a); } }
#else
    a.ph_lo = 0; a.ph_hi = NPH; a.li = 0; a.rep = 0;
    hipLaunchKernelGGL(mk_fwd, dim3(grid), dim3(512), LDS_BYTES, stream, a);
#endif
}
```
